# Optimizing an MI355X kernel written in HIP

```python
import math
import jax, jax.numpy as jnp
from jax import lax
import numpy as np

D_MODEL = 4096
BATCH = 8
SEQ = 2048
DEPTH = 1

MIX_WIDTH = D_MODEL
POOL_WIDTH = MIX_WIDTH // 2
SSM_WIDTH = MIX_WIDTH - POOL_WIDTH
POOL_WINDOWS = (2, 4, 8, 16)
POOL_GROUPS = len(POOL_WINDOWS)
POOL_GROUP_WIDTH = POOL_WIDTH // POOL_GROUPS
SSM_GROUP_CH = 16
SSM_GROUPS = SSM_WIDTH // SSM_GROUP_CH
SSM_STATE = 64
D_FF = ((8 * D_MODEL // 3 + 255) // 256) * 256
DT_MIN = 1e-3
DT_MAX = 1e-1
NORM_EPS = 1e-6

kernel_name = "macaron_pool_s5_hybrid_block"


def rms_norm(x, g):
    xf = x.astype(jnp.float32)
    y = xf * lax.rsqrt(jnp.mean(xf * xf, axis=-1, keepdims=True) + NORM_EPS)
    return (y * g.astype(jnp.float32)).astype(x.dtype)


def swiglu_ffn(h, w_gate, w_up, w_down):
    return (jax.nn.silu(h @ w_gate) * (h @ w_up)) @ w_down


def causal_multiscale_pool(z, w_pool, pool_scale):
    b, s, _ = z.shape
    zf = z.astype(jnp.float32).reshape(b, s, POOL_GROUPS, POOL_GROUP_WIDTH)
    cs = jnp.cumsum(zf, axis=1)
    t = jnp.arange(s)
    diffs = []
    for g, w in enumerate(POOL_WINDOWS):
        c = cs[:, :, g]
        lagged = jnp.pad(c[:, : s - w], ((0, 0), (w, 0), (0, 0)))
        cnt = jnp.minimum(t + 1, w).astype(jnp.float32)[None, :, None]
        diffs.append((c - lagged) / cnt - zf[:, :, g])
    d = jnp.stack(diffs, axis=2).astype(z.dtype)
    out = jnp.einsum("bsgc,gcd->bsgd", d, w_pool).reshape(b, s, POOL_WIDTH)
    return out * pool_scale


def _ssm_combine(e1, e2):
    a1, b1 = e1
    a2, b2 = e2
    return a1 * a2, a2 * b1 + b2


def s5_mixer(z, lam_re, lam_im, log_dt, b_re, b_im, c_re, c_im, d_skip, w_glu, b_glu):
    b, s, _ = z.shape
    u = z.astype(jnp.float32).reshape(b, s, SSM_GROUPS, SSM_GROUP_CH)
    lam = lax.complex(lam_re.astype(jnp.float32), lam_im.astype(jnp.float32))
    dt = jnp.exp(log_dt.astype(jnp.float32))[:, None]
    lam_bar = jnp.exp(lam * dt)
    b_mat = lax.complex(b_re.astype(jnp.float32), b_im.astype(jnp.float32))
    b_bar = ((lam_bar - 1.0) / lam)[:, :, None] * b_mat
    c_mat = lax.complex(c_re.astype(jnp.float32), c_im.astype(jnp.float32))
    bu = jnp.einsum("bsgh,gph->bsgp", u.astype(jnp.complex64), b_bar)
    a = jnp.broadcast_to(lam_bar, bu.shape)
    _, states = lax.associative_scan(_ssm_combine, (a, bu), axis=1)
    y = jnp.einsum("ghp,bsgp->bsgh", c_mat, states).real
    y = y + d_skip.astype(jnp.float32).reshape(SSM_GROUPS, SSM_GROUP_CH) * u
    y = jax.nn.gelu(y.reshape(b, s, SSM_WIDTH)).astype(z.dtype)
    return y * jax.nn.sigmoid(y @ w_glu + b_glu)


def setup_inputs(seed: int = 0) -> dict:
    key = jax.random.key(seed)
    ks = jax.random.split(key, 32)
    f32 = jnp.float32
    nrm = lambda k, shape, scale: jax.random.normal(k, shape, f32) * scale
    gain = lambda k, n: 1.0 + 0.02 * jax.random.normal(k, (n,), f32)
    n_idx = jnp.arange(SSM_STATE, dtype=f32)[None, :]
    return {
        "x": jax.random.normal(ks[0], (BATCH, SEQ, D_MODEL), f32),
        "ffn1_norm": gain(ks[1], D_MODEL),
        "ffn1_gate": nrm(ks[2], (D_MODEL, D_FF), D_MODEL ** -0.5),
        "ffn1_up": nrm(ks[3], (D_MODEL, D_FF), D_MODEL ** -0.5),
        "ffn1_down": nrm(ks[4], (D_FF, D_MODEL), D_FF ** -0.5),
        "mix_norm": gain(ks[5], D_MODEL),
        "w_in": nrm(ks[6], (D_MODEL, MIX_WIDTH), D_MODEL ** -0.5),
        "w_pool": nrm(ks[7], (POOL_GROUPS, POOL_GROUP_WIDTH, POOL_GROUP_WIDTH), POOL_GROUP_WIDTH ** -0.5),
        "pool_scale": gain(ks[8], POOL_WIDTH),
        "lam_re": -0.5 + 0.01 * jax.random.normal(ks[9], (SSM_GROUPS, SSM_STATE), f32),
        "lam_im": math.pi * n_idx + 0.01 * jax.random.normal(ks[10], (SSM_GROUPS, SSM_STATE), f32),
        "log_dt": jax.random.uniform(ks[11], (SSM_GROUPS,), f32, math.log(DT_MIN), math.log(DT_MAX)),
        "b_re": nrm(ks[12], (SSM_GROUPS, SSM_STATE, SSM_GROUP_CH), (2.0 * SSM_GROUP_CH) ** -0.5),
        "b_im": nrm(ks[13], (SSM_GROUPS, SSM_STATE, SSM_GROUP_CH), (2.0 * SSM_GROUP_CH) ** -0.5),
        "c_re": nrm(ks[14], (SSM_GROUPS, SSM_GROUP_CH, SSM_STATE), (2.0 * SSM_STATE) ** -0.5),
        "c_im": nrm(ks[15], (SSM_GROUPS, SSM_GROUP_CH, SSM_STATE), (2.0 * SSM_STATE) ** -0.5),
        "d_skip": jax.random.normal(ks[16], (SSM_WIDTH,), f32),
        "w_glu": nrm(ks[17], (SSM_WIDTH, SSM_WIDTH), SSM_WIDTH ** -0.5),
        "b_glu": nrm(ks[18], (SSM_WIDTH,), 0.01),
        "pool_out_norm": gain(ks[19], POOL_WIDTH),
        "ssm_out_norm": gain(ks[20], SSM_WIDTH),
        "w_out": nrm(ks[21], (MIX_WIDTH, D_MODEL), MIX_WIDTH ** -0.5),
        "ffn2_norm": gain(ks[22], D_MODEL),
        "ffn2_gate": nrm(ks[23], (D_MODEL, D_FF), D_MODEL ** -0.5),
        "ffn2_up": nrm(ks[24], (D_MODEL, D_FF), D_MODEL ** -0.5),
        "ffn2_down": nrm(ks[25], (D_FF, D_MODEL), D_FF ** -0.5),
        "final_norm": gain(ks[26], D_MODEL),
    }


def reference(x, ffn1_norm, ffn1_gate, ffn1_up, ffn1_down, mix_norm, w_in, w_pool, pool_scale,
              lam_re, lam_im, log_dt, b_re, b_im, c_re, c_im, d_skip, w_glu, b_glu,
              pool_out_norm, ssm_out_norm, w_out, ffn2_norm, ffn2_gate, ffn2_up, ffn2_down,
              final_norm):
    h = x
    for _ in range(DEPTH):
        h = h + 0.5 * swiglu_ffn(rms_norm(h, ffn1_norm), ffn1_gate, ffn1_up, ffn1_down)
        z = rms_norm(h, mix_norm) @ w_in
        z_pool = z[..., :POOL_WIDTH]
        z_ssm = z[..., POOL_WIDTH:]
        y_pool = causal_multiscale_pool(z_pool, w_pool, pool_scale)
        y_ssm = s5_mixer(z_ssm, lam_re, lam_im, log_dt, b_re, b_im, c_re, c_im,
                         d_skip, w_glu, b_glu)
        merged = jnp.concatenate(
            [rms_norm(y_pool, pool_out_norm), rms_norm(y_ssm, ssm_out_norm)], axis=-1)
        h = h + merged @ w_out
        h = h + 0.5 * swiglu_ffn(rms_norm(h, ffn2_norm), ffn2_gate, ffn2_up, ffn2_down)
    return rms_norm(h, final_norm)
```

```cpp
#include <hip/hip_runtime.h>
#include <cstdio>
#include <cstdint>

#define LAS __attribute__((address_space(3)))
#define GAS __attribute__((address_space(1)))
typedef unsigned short bf16_t;
typedef short bf16x8 __attribute__((ext_vector_type(8)));
typedef float f32x4 __attribute__((ext_vector_type(4)));
typedef float f32x2 __attribute__((ext_vector_type(2)));
typedef unsigned u32x4 __attribute__((ext_vector_type(4)));
typedef unsigned u32x2 __attribute__((ext_vector_type(2)));

#ifndef MK_N_LAUNCHES
#define MK_N_LAUNCHES 1
#endif
#ifndef PG8_SP2
#define PG8_SP2 true
#endif
#ifndef PG8_ALIGN
#define PG8_ALIGN true
#endif
#ifndef EPI_TWICE
#define EPI_TWICE 0
#endif
#ifndef DUP_MFMA
#define DUP_MFMA 0
#endif
#ifndef PG8_SPLIT
#define PG8_SPLIT 0
#endif
#ifndef MMA_NM8
#define MMA_NM8 1
#endif
#ifndef MMA_NM
#define MMA_NM 1
#endif
#ifndef MMA_PIN
#define MMA_PIN 1
#endif

constexpr int BATCH = 8, SEQ = 2048, D = 4096, M = BATCH * SEQ, FF = 11008;
constexpr int PW = 2048, SW = 2048, PGW = 512;
constexpr int SG = 128, SH = 16, SP = 64;
constexpr int CL = 64, CR = M / CL;
constexpr int AK = CL * SH + 2 * SP;
constexpr float NORM_EPS = 1e-6f;

constexpr size_t MiB = 1u << 20;
constexpr size_t WS_CTL = 0, CTL_ZERO_BYTES = 65536;
constexpr size_t WS_WGU1 = 1 * MiB, WS_WD1 = 173 * MiB, WS_WGU2 = 259 * MiB, WS_WD2 = 431 * MiB;
constexpr size_t WS_WIN = 517 * MiB, WS_WOUT = 549 * MiB, WS_WGLU = 581 * MiB, WS_WPOOL = 589 * MiB;
constexpr size_t WS_KL = 591 * MiB;
constexpr size_t WS_WC = 599 * MiB;
constexpr size_t WS_WS = 631 * MiB;
constexpr size_t WS_LP = 663 * MiB;
constexpr size_t WS_XN = 664 * MiB;
constexpr size_t WS_H = 792 * MiB;
constexpr size_t WS_ZPOOL = 792 * MiB;
constexpr size_t WS_AS5 = 856 * MiB;
constexpr size_t WS_DPOOL = 928 * MiB;
constexpr size_t WS_Y = 992 * MiB;
constexpr size_t WS_YPOOL = 1056 * MiB;
constexpr size_t WS_YSSM = WS_ZPOOL;
constexpr size_t WS_X2Q = 88 * MiB;
constexpr size_t WS_X2Q_OLD = 968 * MiB;
constexpr size_t WS_X1 = 1136 * MiB;
constexpr size_t WS_X2 = 1264 * MiB;
constexpr size_t WS_PS = 1392 * MiB;
constexpr size_t WS_PS2 = 1394 * MiB;
constexpr size_t WS_WINP = 1396 * MiB;
constexpr size_t WS_END = 1412 * MiB;
static_assert(WS_H + (size_t)M * FF * 2 <= WS_X1 && WS_YPOOL + (size_t)M * PW * 2 <= WS_H + (size_t)M * FF * 2, "ws map");
constexpr int CW_TMO = 0, CW_CODE = 1, CW_BAR = 4096;

constexpr int RING_OFF = 0, RING_BYTES = 131072;
constexpr int LDSCTL_OFF = RING_BYTES, MISC_OFF = LDSCTL_OFF + 320;
constexpr int LDS_BYTES = 147456;
constexpr int EPI_LDS_OFF = RING_BYTES + 1024;
constexpr int NWAVES = 8;

#define RLX_AGENT __ATOMIC_RELAXED, __HIP_MEMORY_SCOPE_AGENT
#define LDS_WAIT() asm volatile("s_waitcnt lgkmcnt(0)" ::: "memory")
#define VM_WAIT() asm volatile("s_waitcnt vmcnt(0)" ::: "memory")
#ifndef F16
#define F16 1
#endif
typedef _Float16 f16x2 __attribute__((ext_vector_type(2)));
typedef _Float16 f16x8 __attribute__((ext_vector_type(8)));
__device__ __forceinline__ unsigned cvt_pk_truebf16(float lo, float hi) { unsigned r; asm volatile("v_cvt_pk_bf16_f32 %0, %1, %2" : "=v"(r) : "v"(lo), "v"(hi)); return r; }
#ifndef DOWN1_BF16
#define DOWN1_BF16 1
#endif
#if F16
__device__ __forceinline__ unsigned cvt_pk_bf16(float lo, float hi) { return __builtin_bit_cast(unsigned, __builtin_convertvector((f32x2){lo, hi}, f16x2)); }
__device__ __forceinline__ unsigned f2bf(float f) { return (unsigned)__builtin_bit_cast(unsigned short, (_Float16)f); }
__device__ __forceinline__ unsigned pk2(float lo, float hi) { return cvt_pk_bf16(lo, hi); }
__device__ __forceinline__ float bf_lo(unsigned w) { return (float)__builtin_bit_cast(f16x2, w).x; }
__device__ __forceinline__ float bf_hi(unsigned w) { return (float)__builtin_bit_cast(f16x2, w).y; }
#else
__device__ __forceinline__ unsigned cvt_pk_bf16(float lo, float hi) { unsigned r; asm volatile("v_cvt_pk_bf16_f32 %0, %1, %2" : "=v"(r) : "v"(lo), "v"(hi)); return r; }
__device__ __forceinline__ unsigned f2bf(float f) { unsigned u = __builtin_bit_cast(unsigned, f); return (u + 0x7fffu + ((u >> 16) & 1u)) >> 16; }
__device__ __forceinline__ unsigned pk2(float lo, float hi) { return f2bf(lo) | (f2bf(hi) << 16); }
__device__ __forceinline__ float bf_lo(unsigned w) { return __builtin_bit_cast(float, w << 16); }
__device__ __forceinline__ float bf_hi(unsigned w) { return __builtin_bit_cast(float, w & 0xffff0000u); }
#endif
#ifndef EMU_FP8
#define EMU_FP8 0
#endif
#ifndef INT8_GU1
#define INT8_GU1 1
#endif
#ifndef INT8_GU2
#define INT8_GU2 2
#endif
#ifndef FP8_DOWN2
#define FP8_DOWN2 1
#endif
__device__ __forceinline__ float q8(float x) { unsigned u = __builtin_bit_cast(unsigned, x); u += 0x7FFFFu + ((u >> 20) & 1u); u &= 0xFFF00000u; return __builtin_bit_cast(float, u); }
__device__ __forceinline__ float clamp448(float x) { return __builtin_fminf(__builtin_fmaxf(x, -448.f), 448.f); }
__device__ __forceinline__ unsigned pk4_fp8(float a, float b, float c, float d) { int r = 0; r = __builtin_amdgcn_cvt_pk_fp8_f32(clamp448(a), clamp448(b), r, false); r = __builtin_amdgcn_cvt_pk_fp8_f32(clamp448(c), clamp448(d), r, true); return (unsigned)r; }
static_assert(INT8_GU1 == 1 && INT8_GU2 == 2, "WS_X2Q placement assumes int8 FFN1 gate/up weights and a 64 MiB int8 h2");
constexpr float H8_SCALE = 8.0f, W8_SCALE = 4096.0f;
constexpr float AQ1_SCALE = 31.75f;
constexpr float AQ_SCALE = 21.96f, WQ_SCALE = 2032.0f;
__device__ __forceinline__ unsigned pk4_i8(float a, float b, float c, float d) { const int ia = (int)__builtin_rintf(__builtin_fminf(__builtin_fmaxf(a, -127.f), 127.f)), ib = (int)__builtin_rintf(__builtin_fminf(__builtin_fmaxf(b, -127.f), 127.f)), ic = (int)__builtin_rintf(__builtin_fminf(__builtin_fmaxf(c, -127.f), 127.f)), id = (int)__builtin_rintf(__builtin_fminf(__builtin_fmaxf(d, -127.f), 127.f));
    return ((unsigned)ia & 0xffu) | (((unsigned)ib & 0xffu) << 8) | (((unsigned)ic & 0xffu) << 16) | ((unsigned)id << 24); }
__device__ __forceinline__ float qint8(float x) { return __builtin_rintf(__builtin_fminf(__builtin_fmaxf(x, -127.f), 127.f)); }
__device__ __forceinline__ float fast_sigmoid(float x) { return __builtin_amdgcn_rcpf(1.0f + __builtin_amdgcn_exp2f(-1.4426950408889634f * x)); }
__device__ __forceinline__ float silu_f(float x) { return x * fast_sigmoid(x); }
__device__ __forceinline__ float gelu_tanh_f(float x) { const float z = 0.7978845608028654f * (x + 0.044715f * x * x * x); return x * fast_sigmoid(2.0f * z); }
__device__ __forceinline__ float wave_sum(float v) {
#pragma unroll
    for (int o = 1; o < 64; o <<= 1) v += __shfl_xor(v, o);
    return v;
}

namespace pg8 {
constexpr int BM = 256, BK = 64, HALF = 128, HTB = HALF * BK * 2, STAGE_BYTES = 8 * HTB, NXCD = 8, WGM = 8;
__host__ __device__ __forceinline__ int lds_byte(int r, int c) { const int st = (r >> 4) * 2 + (c >> 5), rr = r & 15, cc = c & 31, ob = rr * 64 + cc * 2; return st * 1024 + (ob ^ (((ob >> 9) & 1) << 5)); }
__host__ __device__ __forceinline__ void stage_rc(int b, int& R, int& C) { const int st = b / 1024, sb = b % 1024, swz = sb ^ (((sb >> 9) & 1) << 5); R = (st >> 1) * 16 + swz / 64; C = (st & 1) * 32 + (swz % 64) / 2; }
__host__ __device__ __forceinline__ int perm32(int rho) { const int n = rho >> 4, i = rho & 15; return 8 * (i >> 2) + 4 * n + (i & 3); }

struct Unit { int pm, pn, g; };

struct TileOrder {
    int nM, nN, nwg, G, c, wgm;
    __device__ __forceinline__ void init(int Mr, int Nc, int G_, int c_, int wgm_) { nM = Mr / BM; nN = Nc / BM; nwg = nM * nN; G = G_; c = c_; wgm = wgm_; }
    __device__ __forceinline__ bool next(int i, Unit& u) const {
        const long L = (long)i * G + c; if (L >= nwg) return false;
        int wgid = (int)L; { const int q = nwg / NXCD, r = nwg % NXCD, xcd = wgid % NXCD, off = wgid / NXCD; wgid = (xcd < r ? xcd * (q + 1) : r * (q + 1) + (xcd - r) * q) + off; }
        const int nig = wgm * nN, gid = wgid / nig, fm = gid * wgm, gsz = (nM - fm) < wgm ? (nM - fm) : wgm;
        u.pm = fm + ((wgid % nig) % gsz); u.pn = (wgid % nig) / gsz; u.g = 0; return true;
    }
};

struct PlainGemm {
    static constexpr bool TWOSEG = false, KSKIP = false;
    int tmid = -1;
    const char* A; const char* Bt; int lda, ldb; int nt; long kstepA, kstepB, hstepA, hstepB; TileOrder ord;
    __device__ __forceinline__ void init(const void* A_, const void* Bt_, int Mr, int Nc, int K, int lda_, int ldb_, int G, int c, int wgm = WGM) {
        A = (const char*)A_; Bt = (const char*)Bt_; lda = lda_; ldb = ldb_; nt = K / BK; kstepA = kstepB = BK * 2; hstepA = (long)HALF * lda * 2; hstepB = (long)HALF * ldb * 2; ord.init(Mr, Nc, G, c, wgm); }
    __device__ __forceinline__ void init_tiledA(const void* A_, const void* Bt_, int Mr, int Nc, int K, int ldb_, int G, int c, int wgm) {
        init(A_, Bt_, Mr, Nc, K, 64, ldb_, G, c, wgm); kstepA = (long)Mr * 64 * 2; hstepA = (long)HALF * 64 * 2; }
    __device__ __forceinline__ void init_tiledAB(const void* A_, const void* Bt_, int Mr, int Nc, int K, int G, int c, int wgm) {
        init(A_, Bt_, Mr, Nc, K, 64, 64, G, c, wgm); kstepA = (long)Mr * 64 * 2; hstepA = (long)HALF * 64 * 2; kstepB = (long)Nc * 64 * 2; hstepB = (long)HALF * 64 * 2; }
    __device__ __forceinline__ void reverse_k() { A += (long)(nt - 1) * kstepA; Bt += (long)(nt - 1) * kstepB; kstepA = -kstepA; kstepB = -kstepB; }
    __device__ __forceinline__ bool next(int i, Unit& u) const { return ord.next(i, u); }
    __device__ __forceinline__ const char* a_base(const Unit& u) const { return A + (size_t)u.pm * 2 * hstepA; }
    __device__ __forceinline__ const char* b_base(const Unit& u) const { return Bt + (size_t)u.pn * 2 * hstepB; }
    __device__ __forceinline__ unsigned voffA(int R, int C) const { return (unsigned)(R * lda + C) * 2u; }
    __device__ __forceinline__ unsigned voffB(int R, int C) const { return (unsigned)(R * ldb + C) * 2u; }
    int ks; long kstepB2, hstepB2;
    __device__ __forceinline__ const char* b_base2(const Unit&) const { return Bt; }
    __device__ __forceinline__ unsigned voffB2(int, int) const { return 0u; }
};
struct PoolGemm {
    static constexpr int tmid = -1;
    static constexpr bool TWOSEG = false, KSKIP = false;
    const char* A; const char* Bt; int nt; long kstepA, kstepB, hstepA, hstepB; int G, c;
    __device__ __forceinline__ void init(const void* A_, const void* Bt_, int G_, int c_) { A = (const char*)A_; Bt = (const char*)Bt_; nt = PGW / BK; kstepA = kstepB = BK * 2; hstepA = (long)HALF * PW * 2; hstepB = (long)HALF * PGW * 2; G = G_; c = c_; }
    __device__ __forceinline__ bool next(int i, Unit& u) const { const int L = i * G + c; if (L >= 512) return false; u.pm = L >> 3; u.g = (L >> 1) & 3; u.pn = L & 1; return true; }
    __device__ __forceinline__ const char* a_base(const Unit& u) const { return A + ((size_t)u.pm * BM * PW + (size_t)u.g * PGW) * 2; }
    __device__ __forceinline__ const char* b_base(const Unit& u) const { return Bt + ((size_t)u.g * PGW * PGW + (size_t)u.pn * BM * PGW) * 2; }
    __device__ __forceinline__ unsigned voffA(int R, int C) const { return (unsigned)(R * PW + C) * 2u; }
    __device__ __forceinline__ unsigned voffB(int R, int C) const { return (unsigned)(R * PGW + C) * 2u; }
    int ks; long kstepB2, hstepB2;
    __device__ __forceinline__ const char* b_base2(const Unit&) const { return Bt; }
    __device__ __forceinline__ unsigned voffB2(int, int) const { return 0u; }
};
struct CombGemm {
    static constexpr bool TWOSEG = false, KSKIP = false; static constexpr int tmid = -1;
    const char* A; const char* Bt; int nt; long kstepA, kstepB, hstepA, hstepB; int G, c;
    __device__ __forceinline__ void init(const void* A_, const void* Bt_, int G_, int c_) { A = (const char*)A_; Bt = (const char*)Bt_; nt = PGW / BK; kstepA = kstepB = BK * 2; hstepA = (long)HALF * PGW * 2; hstepB = (long)HALF * PW * 2; G = G_; c = c_; }
    __device__ __forceinline__ bool next(int i, Unit& u) const { const int L = i * G + c; if (c < 0 || L >= 128) return false; u.g = L >> 5; u.pm = (L >> 4) & 1; u.pn = L & 15; return true; }
    __device__ __forceinline__ const char* a_base(const Unit& u) const { return A + ((size_t)u.g * PGW * PGW + (size_t)u.pm * BM * PGW) * 2; }
    __device__ __forceinline__ const char* b_base(const Unit& u) const { return Bt + ((size_t)u.pn * BM * PW + (size_t)u.g * PGW) * 2; }
    __device__ __forceinline__ unsigned voffA(int R, int C) const { return (unsigned)(R * PGW + C) * 2u; }
    __device__ __forceinline__ unsigned voffB(int R, int C) const { return (unsigned)(R * PW + C) * 2u; }
    int ks; long kstepB2, hstepB2;
    __device__ __forceinline__ const char* b_base2(const Unit&) const { return Bt; }
    __device__ __forceinline__ unsigned voffB2(int, int) const { return 0u; }
};
struct S5CarryGemm {
    static constexpr int tmid = -1;
    static constexpr bool TWOSEG = false, KSKIP = false;
    const char* A; const char* Bt; int nt; long kstepA, kstepB, hstepA, hstepB; int G, c;
    __device__ __forceinline__ void init(const void* A_, const void* Bt_, int G_, int c_) { A = (const char*)A_; Bt = (const char*)Bt_; nt = (CL * SH) / BK; kstepA = kstepB = BK * 2; hstepA = (long)HALF * AK * 2; hstepB = 0; G = G_; c = c_; }
    __device__ __forceinline__ bool next(int i, Unit& u) const { const int L = i * G + c; if (L >= SG) return false; u.pm = 0; u.pn = 0; u.g = L; return true; }
    __device__ __forceinline__ const char* a_base(const Unit& u) const { return A + (size_t)u.g * CR * AK * 2; }
    __device__ __forceinline__ const char* b_base(const Unit& u) const { return Bt + (size_t)u.g * 128 * 1024 * 2; }
    __device__ __forceinline__ unsigned voffA(int R, int C) const { return (unsigned)(R * AK + C) * 2u; }
    __device__ __forceinline__ unsigned voffB(int R, int C) const { return (unsigned)(R * 1024 + C) * 2u; }
    int ks; long kstepB2, hstepB2;
    __device__ __forceinline__ const char* b_base2(const Unit&) const { return Bt; }
    __device__ __forceinline__ unsigned voffB2(int, int) const { return 0u; }
};
#ifndef S5_KSKIP
#define S5_KSKIP 1
#endif
struct S5OutGemm {
    static constexpr int tmid = -1;
    static constexpr bool TWOSEG = true, KSKIP = S5_KSKIP != 0;
    __device__ __forceinline__ int ks_of(const Unit& u) const { return 4 * (u.pn + 1); }
    const char* A; const char* KLt; const char* WCt; int nt; long kstepA, kstepB, hstepA, hstepB; int ks; long kstepB2, hstepB2; int G, c;
    __device__ __forceinline__ void init(const void* A_, const void* KL_, const void* WC_, int G_, int c_) { A = (const char*)A_; KLt = (const char*)KL_; WCt = (const char*)WC_; nt = AK / BK; kstepA = BK * 2; hstepA = (long)HALF * AK * 2;
        kstepB = -2048; hstepB = 4096; ks = (CL * SH) / BK; kstepB2 = BK * 2; hstepB2 = (long)HALF * 128 * 2; G = G_; c = c_; }
    __device__ __forceinline__ bool next(int i, Unit& u) const { const int L = i * G + c; if (L >= SG * 4) return false; u.pm = 0; u.g = L >> 2; u.pn = (KSKIP && (i & 1)) ? 3 - (L & 3) : (L & 3); return true; }
    __device__ __forceinline__ const char* a_base(const Unit& u) const { return A + (size_t)u.g * CR * AK * 2; }
    __device__ __forceinline__ const char* b_base(const Unit& u) const { return KLt + (size_t)u.g * 65536 + (size_t)(16 * u.pn + 60) * 512; }
    __device__ __forceinline__ const char* b_base2(const Unit& u) const { return WCt + ((size_t)u.g * 1024 * 128 + (size_t)u.pn * BM * 128) * 2; }
    __device__ __forceinline__ unsigned voffA(int R, int C) const { return (unsigned)(R * AK + C) * 2u; }
    __device__ __forceinline__ unsigned voffB(int R, int C) const { return (unsigned)((((R >> 4) - (C >> 4) + 3) * 256) + (R & 15) * 16 + (C & 15)) * 2u; }
    __device__ __forceinline__ unsigned voffB2(int R, int C) const { return (unsigned)(R * 128 + C) * 2u; }
};

typedef f32x4 Acc[2][2][4][2];
#ifndef WIDE8
#define WIDE8 1
#endif
#ifndef WT_EPI
#define WT_EPI 1
#endif
#if WT_EPI
__device__ __forceinline__ void st16_wt(const void* base, unsigned byte_off, u32x4 v) { __builtin_amdgcn_raw_buffer_store_b128(v, __builtin_amdgcn_make_buffer_rsrc((void*)base, 0, 0x7fffffff, 0x00020000), (int)byte_off, 0, 16); }
#define ST16(base, byte_off, v) st16_wt((base), (unsigned)(byte_off), (v))
#else
#define ST16(base, byte_off, v) (*(u32x4*)((unsigned char*)(base) + (size_t)(unsigned)(byte_off)) = (v))
#endif
#ifndef XP_EPI
#define XP_EPI 1
#endif
constexpr int XP_OFF = EPI_LDS_OFF + 6144;
static_assert(XP_OFF + 8192 <= LDS_BYTES, "lds map");
__device__ __forceinline__ u32x4 xp_to_rows(LAS unsigned char* slot, int fr, int fq, int lane, u32x4 w) { *(LAS u32x4*)(slot + (fr * 4 + fq) * 16) = w; return *(const LAS u32x4*)(slot + lane * 16); }
__device__ __forceinline__ u32x4 xp_to_frag(LAS unsigned char* slot, int fr, int fq, int lane, u32x4 w) { *(LAS u32x4*)(slot + lane * 16) = w; return *(const LAS u32x4*)(slot + (fr * 4 + fq) * 16); }

__device__ __forceinline__ void row_rstd8(const float* ps, int pm, int pm0, int wr, int fr, int fq, LAS unsigned char* lds, float (&rs)[8]);
#ifndef H_TILED
#define H_TILED 1
#endif
#ifndef POOL_PREMUL
#define POOL_PREMUL 1
#endif
#ifndef DOWN_REVK
#define DOWN_REVK 0
#endif
#ifndef WD_TILED
#define WD_TILED 1
#endif
__device__ __forceinline__ f32x4 swg4(f32x4 g, f32x4 u, float c1, float c2) {
    const f32x4 t = g * c1;
    f32x4 e; e[0] = __builtin_amdgcn_exp2f(t[0]); e[1] = __builtin_amdgcn_exp2f(t[1]); e[2] = __builtin_amdgcn_exp2f(t[2]); e[3] = __builtin_amdgcn_exp2f(t[3]);
    const f32x4 d = e + 1.0f;
    f32x4 rc; rc[0] = __builtin_amdgcn_rcpf(d[0]); rc[1] = __builtin_amdgcn_rcpf(d[1]); rc[2] = __builtin_amdgcn_rcpf(d[2]); rc[3] = __builtin_amdgcn_rcpf(d[3]);
    return ((g * u) * c2) * rc;
}
template <bool RSTD, bool F8OUT = false, bool INTACC = false, bool HBF16 = false> struct EpiSwiGLU {
    static constexpr bool PERM = true, AFTER_DRAIN = false, IDEMPOTENT = true;
    bf16_t* H; const float* ps; int pm0; float qs;
    __device__ __forceinline__ void operator()(const Acc& acc, const Unit& u, int wr, int wc, int fr, int fq, LAS unsigned char* lds, int tid) const {
        const int row0 = u.pm * BM + wr * 64 + fr, col0 = u.pn * HALF + wc * 32 + 8 * fq;
        const int lane = tid & 63, rowT = u.pm * BM + wr * 64 + (lane >> 2), colT = u.pn * HALF + wc * 32 + 8 * (lane & 3); LAS unsigned char* const xslot = lds + XP_OFF + (wr * 4 + wc) * 1024; (void)rowT; (void)colT; (void)xslot;
        float rs[8]; u32x2 w8prev = {0u, 0u}; (void)w8prev;
        if constexpr (RSTD) row_rstd8(ps, u.pm, pm0, wr, fr, fq, lds, rs);
#pragma unroll
        for (int ai = 0; ai < 2; ++ai)
#pragma unroll
            for (int m = 0; m < 4; ++m) {
                f32x4 g0 = acc[ai][0][m][0], g1 = acc[ai][0][m][1], u0 = acc[ai][1][m][0], u1 = acc[ai][1][m][1];
                if constexpr (INTACC) {
                    typedef int i32x4v __attribute__((ext_vector_type(4)));
                    g0 = __builtin_convertvector(__builtin_bit_cast(i32x4v, g0), f32x4); g1 = __builtin_convertvector(__builtin_bit_cast(i32x4v, g1), f32x4);
                    u0 = __builtin_convertvector(__builtin_bit_cast(i32x4v, u0), f32x4); u1 = __builtin_convertvector(__builtin_bit_cast(i32x4v, u1), f32x4); }
                const float r = RSTD ? rs[ai * 4 + m] * qs : (INTACC ? qs : 1.0f);
                const float c1 = -1.4426950408889634f * r, c2 = r * r * (F8OUT ? H8_SCALE : 1.0f);
#define SWG(gv, uv) (((gv) * (uv)) * c2 * __builtin_amdgcn_rcpf(1.0f + __builtin_amdgcn_exp2f((gv) * c1)))
#define HQ(x) ((EMU_FP8 && RSTD) ? q8(x) : (x))
#define PK16(a, b) (HBF16 ? cvt_pk_truebf16(a, b) : cvt_pk_bf16(a, b))
                u32x4 w;
                const f32x4 o0 = swg4(g0, u0, c1, c2), o1 = swg4(g1, u1, c1, c2);
                if constexpr (!F8OUT) {
                w.x = PK16(HQ(o0[0]), HQ(o0[1])); w.y = PK16(HQ(o0[2]), HQ(o0[3]));
                w.z = PK16(HQ(o1[0]), HQ(o1[1])); w.w = PK16(HQ(o1[2]), HQ(o1[3])); }
#undef PK16
#undef HQ
                if constexpr (F8OUT) {
                    u32x2 w8; w8.x = pk4_fp8(o0[0], o0[1], o0[2], o0[3]); w8.y = pk4_fp8(o1[0], o1[1], o1[2], o1[3]);
#if WIDE8
                    if ((m & 1) == 0) { w8prev = w8; continue; }
                    const u32x2 sx = __builtin_amdgcn_permlane16_swap(w8prev.x, w8.x, false, false), sy = __builtin_amdgcn_permlane16_swap(w8prev.y, w8.y, false, false);
                    const u32x4 w16 = {sx.x, sy.x, sx.y, sy.y}; const int rst = row0 + ai * HALF + (m - 1 + (fq & 1)) * 16, cst = col0 & ~8;
                    *(u32x4*)((unsigned char*)H + ((size_t)(cst >> 7) * M + rst) * 128 + (cst & 127)) = w16; continue; }
#else
                    *(u32x2*)((unsigned char*)H + ((size_t)(col0 >> 7) * M + (row0 + ai * HALF + m * 16)) * 128 + (col0 & 127)) = w8; continue; }
#endif
#if H_TILED
                if (XP_EPI) ST16(H, (((unsigned)(colT >> 6) * M + (rowT + ai * HALF + m * 16)) * 64 + (colT & 63)) * 2u, xp_to_rows(xslot, fr, fq, lane, w));
                else ST16(H, (((unsigned)(col0 >> 6) * M + (row0 + ai * HALF + m * 16)) * 64 + (col0 & 63)) * 2u, w); }
#else
                *(u32x4*)(H + (size_t)(row0 + ai * HALF + m * 16) * FF + col0) = w; }
#endif
#undef SWG
    }
};
struct EpiResF32 {
    static constexpr bool PERM = false, AFTER_DRAIN = false, IDEMPOTENT = false;
    const float* base; float* out; float alpha;
    __device__ __forceinline__ void operator()(const Acc& acc, const Unit& u, int wr, int wc, int fr, int fq, LAS unsigned char* lds, int tid) const {
        const int row0 = u.pm * BM + wr * 64 + fr, col0 = u.pn * BM + wc * 32 + 4 * fq;
#pragma unroll
        for (int ai = 0; ai < 2; ++ai)
#pragma unroll
            for (int m = 0; m < 4; ++m) { const size_t off = (size_t)(row0 + ai * HALF + m * 16) * D + col0;
#pragma unroll
                for (int bj = 0; bj < 2; ++bj)
#pragma unroll
                    for (int n = 0; n < 2; ++n) { const f32x4 b = *(const f32x4*)(base + off + bj * HALF + n * 16); *(f32x4*)(out + off + bj * HALF + n * 16) = b + acc[ai][bj][m][n] * alpha; } }
    }
};
__device__ __forceinline__ void row_rstd8(const float* ps, int pm, int pm0, int wr, int fr, int fq, LAS unsigned char* lds, float (&rs)[8]) {
    if (pm == pm0) {
        const LAS float* RS = (const LAS float*)(lds + EPI_LDS_OFF + 4096);
#pragma unroll
        for (int ai = 0; ai < 2; ++ai)
#pragma unroll
            for (int m = 0; m < 4; ++m) rs[ai * 4 + m] = RS[ai * HALF + wr * 64 + m * 16 + fr];
        return; }
    f32x4 p[8];
#pragma unroll
    for (int ai = 0; ai < 2; ++ai)
#pragma unroll
        for (int m = 0; m < 4; ++m) p[ai * 4 + m] = *(const f32x4*)(ps + (size_t)(pm * BM + ai * HALF + wr * 64 + m * 16 + fr) * 16 + 4 * fq);
#pragma unroll
    for (int i = 0; i < 8; ++i) { float t = (p[i].x + p[i].y) + (p[i].z + p[i].w); t += __shfl_xor(t, 16); t += __shfl_xor(t, 32); rs[i] = 1.0f / sqrtf(t * (1.f / D) + NORM_EPS); }
}
template <bool BASE_F32, int QOUT = 0, bool ROWSC = false> struct EpiResNorm {
    static constexpr bool PERM = true, AFTER_DRAIN = false, IDEMPOTENT = false;
    const void* base; float alpha; bf16_t* xb; float* ps; void* xq;
    __device__ __forceinline__ void operator()(const Acc& acc, const Unit& u, int wr, int wc, int fr, int fq, LAS unsigned char* lds, int tid) const {
        const int row0 = u.pm * BM + wr * 64 + fr, col0 = u.pn * BM + wc * 32 + 8 * fq;
        const int lane = tid & 63, rowT = XP_EPI ? u.pm * BM + wr * 64 + (lane >> 2) : row0, colT = XP_EPI ? u.pn * BM + wc * 32 + 8 * (lane & 3) : col0; LAS unsigned char* const xslot = lds + XP_OFF + (wr * 4 + wc) * 1024;
        LAS float* P = (LAS float*)(lds + EPI_LDS_OFF);
#pragma unroll
        for (int ai = 0; ai < 2; ++ai)
#pragma unroll
            for (int mp = 0; mp < 2; ++mp) {
                f32x4 bv[2][2][2]; u32x4 bq[2][2]; (void)bq; u32x2 qprev[2] = {{0u, 0u}, {0u, 0u}}; (void)qprev;
#pragma unroll
                for (int mm = 0; mm < 2; ++mm) { const size_t off = (size_t)(rowT + ai * HALF + (2 * mp + mm) * 16) * D + colT;
#pragma unroll
                    for (int bj = 0; bj < 2; ++bj) {
                        if constexpr (BASE_F32) { bv[mm][bj][0] = *(const f32x4*)((const float*)base + off + bj * HALF); bv[mm][bj][1] = *(const f32x4*)((const float*)base + off + bj * HALF + 4); }
                        else { bq[mm][bj] = *(const u32x4*)((const bf16_t*)base + off + bj * HALF); } } }
#pragma unroll
                for (int mm = 0; mm < 2; ++mm) {
#pragma unroll
                    for (int bj = 0; bj < 2; ++bj) {
                        if constexpr (BASE_F32) { if (XP_EPI) { bv[mm][bj][0] = __builtin_bit_cast(f32x4, xp_to_frag(xslot, fr, fq, lane, __builtin_bit_cast(u32x4, bv[mm][bj][0]))); bv[mm][bj][1] = __builtin_bit_cast(f32x4, xp_to_frag(xslot, fr, fq, lane, __builtin_bit_cast(u32x4, bv[mm][bj][1]))); } }
                        else { const u32x4 q = XP_EPI ? xp_to_frag(xslot, fr, fq, lane, bq[mm][bj]) : bq[mm][bj];
                            bv[mm][bj][0] = (f32x4){bf_lo(q.x), bf_hi(q.x), bf_lo(q.y), bf_hi(q.y)}; bv[mm][bj][1] = (f32x4){bf_lo(q.z), bf_hi(q.z), bf_lo(q.w), bf_hi(q.w)}; } } }
#pragma unroll
                for (int mm = 0; mm < 2; ++mm) { const int m = 2 * mp + mm; const size_t off = (size_t)(row0 + ai * HALF + m * 16) * D + col0, offT = (size_t)(rowT + ai * HALF + m * 16) * D + colT; float ss = 0.f;
#pragma unroll
                    for (int bj = 0; bj < 2; ++bj) {
                        float al = alpha; if constexpr (ROWSC) al *= ((const LAS float*)(lds + EPI_LDS_OFF + 4096))[ai * HALF + wr * 64 + m * 16 + fr];
                        const f32x4 h0 = bv[mm][bj][0] + acc[ai][bj][m][0] * al, h1 = bv[mm][bj][1] + acc[ai][bj][m][1] * al;
                        ss += (h0[0] * h0[0] + h0[1] * h0[1]) + (h0[2] * h0[2] + h0[3] * h0[3]) + (h1[0] * h1[0] + h1[1] * h1[1]) + (h1[2] * h1[2] + h1[3] * h1[3]);
                        u32x4 w; w.x = cvt_pk_bf16(h0[0], h0[1]); w.y = cvt_pk_bf16(h0[2], h0[3]); w.z = cvt_pk_bf16(h1[0], h1[1]); w.w = cvt_pk_bf16(h1[2], h1[3]);
                        ST16(xb, (unsigned)(offT + bj * HALF) * 2u, XP_EPI ? xp_to_rows(xslot, fr, fq, lane, w) : w);
                        if constexpr (QOUT == 1) { u32x4 q; q.x = cvt_pk_bf16(qint8(h0[0] * AQ_SCALE), qint8(h0[1] * AQ_SCALE)); q.y = cvt_pk_bf16(qint8(h0[2] * AQ_SCALE), qint8(h0[3] * AQ_SCALE));
                            q.z = cvt_pk_bf16(qint8(h1[0] * AQ_SCALE), qint8(h1[1] * AQ_SCALE)); q.w = cvt_pk_bf16(qint8(h1[2] * AQ_SCALE), qint8(h1[3] * AQ_SCALE));
                            *(u32x4*)((bf16_t*)xq + off + bj * HALF) = q; }
                        if constexpr (QOUT == 2) { u32x2 q; q.x = pk4_i8(h0[0] * AQ_SCALE, h0[1] * AQ_SCALE, h0[2] * AQ_SCALE, h0[3] * AQ_SCALE); q.y = pk4_i8(h1[0] * AQ_SCALE, h1[1] * AQ_SCALE, h1[2] * AQ_SCALE, h1[3] * AQ_SCALE);
#if WIDE8
                            if (mm == 0) qprev[bj] = q;
                            else { const u32x2 sx = __builtin_amdgcn_permlane16_swap(qprev[bj].x, q.x, false, false), sy = __builtin_amdgcn_permlane16_swap(qprev[bj].y, q.y, false, false);
                                const u32x4 q16 = {sx.x, sy.x, sx.y, sy.y}; const size_t ost = (size_t)(row0 + ai * HALF + (2 * mp + (fq & 1)) * 16) * D + (col0 & ~8);
                                *(u32x4*)((unsigned char*)xq + ost + bj * HALF) = q16; } } }
#else
                            *(u32x2*)((unsigned char*)xq + off + bj * HALF) = q; } }
#endif
                    ss += __shfl_xor(ss, 16); ss += __shfl_xor(ss, 32);
                    if (fq == 0) P[(ai * HALF + wr * 64 + m * 16 + fr) * 4 + wc] = ss; } }
        LDS_WAIT(); __builtin_amdgcn_s_barrier(); asm volatile("" ::: "memory");
        if (tid < BM) { const f32x4 q = *(const LAS f32x4*)(P + tid * 4); ps[(size_t)(u.pm * BM + tid) * 16 + u.pn] = (q.x + q.y) + (q.z + q.w); }
    }
};
__device__ __forceinline__ void rstd_table(const float* ps, int pm, LAS unsigned char* lds, int tid) {
    if (pm >= 0 && tid < BM) { const f32x4* p = (const f32x4*)(ps + (size_t)(pm * BM + tid) * 16); const f32x4 a = p[0], b = p[1], c = p[2], d = p[3];
        const float t = (((a.x + a.y) + (a.z + a.w)) + ((b.x + b.y) + (b.z + b.w))) + (((c.x + c.y) + (c.z + c.w)) + ((d.x + d.y) + (d.z + d.w)));
        ((LAS float*)(lds + EPI_LDS_OFF + 4096))[tid] = 1.0f / sqrtf(t * (1.f / D) + NORM_EPS); }
    __syncthreads();
}
__device__ __forceinline__ void rstd2_table(const float* ps2, int pm, LAS unsigned char* lds, int tid) {
    if (pm >= 0 && tid < BM) { const f32x4* p = (const f32x4*)(ps2 + (size_t)(pm * BM + tid) * 16); const f32x4 a = p[0], b = p[1], c = p[2], d = p[3];
        const float tp = ((a.x + a.y) + (a.z + a.w)) + ((b.x + b.y) + (b.z + b.w)), ts = ((c.x + c.y) + (c.z + c.w)) + ((d.x + d.y) + (d.z + d.w));
        const float rp = 1.0f / sqrtf(tp * (1.f / PW) + NORM_EPS), rs = 1.0f / sqrtf(ts * (1.f / SW) + NORM_EPS);
        ((LAS float*)(lds + EPI_LDS_OFF + 4096))[tid] = rs; ((LAS float*)(lds + EPI_LDS_OFF + 5120))[tid] = rp / rs; }
    __syncthreads();
}
struct EpiZ {
    static constexpr bool PERM = true, AFTER_DRAIN = false, IDEMPOTENT = false;
    bf16_t* zpool; bf16_t* as5; const float* ps; int pm0;
    __device__ __forceinline__ void operator()(const Acc& acc, const Unit& u, int wr, int wc, int fr, int fq, LAS unsigned char* lds, int tid) const {
        const int row0 = u.pm * BM + wr * 64 + fr;
        float rs[8]; row_rstd8(ps, u.pm, pm0, wr, fr, fq, lds, rs);
#pragma unroll
        for (int ai = 0; ai < 2; ++ai)
#pragma unroll
            for (int m = 0; m < 4; ++m) { const int row = row0 + ai * HALF + m * 16;
#pragma unroll
                for (int bj = 0; bj < 2; ++bj) { const f32x4 v0 = acc[ai][bj][m][0] * rs[ai * 4 + m], v1 = acc[ai][bj][m][1] * rs[ai * 4 + m];
                    u32x4 w; w.x = cvt_pk_bf16(v0[0], v0[1]); w.y = cvt_pk_bf16(v0[2], v0[3]); w.z = cvt_pk_bf16(v1[0], v1[1]); w.w = cvt_pk_bf16(v1[2], v1[3]);
                    const int col = u.pn * BM + bj * HALF + wc * 32 + 8 * fq;
                    if (u.pn < 8) ST16(zpool, ((unsigned)row * PW + col) * 2u, w);
                    else { const int cs = col - PW, g = cs >> 4, h0 = cs & 15; ST16(as5, (unsigned)((g * CR + (row >> 6)) * AK + (row & 63) * SH + h0) * 2u, w); } } }
    }
};
__device__ __forceinline__ void tile_row_ss(float (&ss8)[8], float* ps, int pm, int slot, int wr, int wc, int fr, int fq, LAS unsigned char* lds, int tid) {
    LAS float* P = (LAS float*)(lds + EPI_LDS_OFF);
#pragma unroll
    for (int i = 0; i < 8; ++i) { float t = ss8[i]; t += __shfl_xor(t, 16); t += __shfl_xor(t, 32); if (fq == 0) P[((i >> 2) * HALF + wr * 64 + (i & 3) * 16 + fr) * 4 + wc] = t; }
    LDS_WAIT(); __builtin_amdgcn_s_barrier(); asm volatile("" ::: "memory");
    if (tid < BM) { const f32x4 q = *(const LAS f32x4*)(P + tid * 4); ps[(size_t)(pm * BM + tid) * 16 + slot] = (q.x + q.y) + (q.z + q.w); }
}
struct EpiPool {
    static constexpr bool PERM = true, AFTER_DRAIN = false, IDEMPOTENT = false;
    bf16_t* O; const float* scale; float* ps2;
    __device__ __forceinline__ void operator()(const Acc& acc, const Unit& u, int wr, int wc, int fr, int fq, LAS unsigned char* lds, int tid) const {
        const int row0 = u.pm * BM + wr * 64 + fr, col0 = u.g * PGW + u.pn * BM + wc * 32 + 8 * fq;
        f32x4 sv[2][2];
#pragma unroll
        for (int bj = 0; bj < 2; ++bj)
#pragma unroll
            for (int n = 0; n < 2; ++n) sv[bj][n] = *(const f32x4*)(scale + col0 + bj * HALF + 4 * n);
        float ss8[8];
#pragma unroll
        for (int ai = 0; ai < 2; ++ai)
#pragma unroll
            for (int m = 0; m < 4; ++m) { bf16_t* rowp = O + (size_t)(row0 + ai * HALF + m * 16) * D + col0; float ss = 0.f;
#pragma unroll
                for (int bj = 0; bj < 2; ++bj) { const f32x4 v0 = acc[ai][bj][m][0] * sv[bj][0], v1 = acc[ai][bj][m][1] * sv[bj][1];
                    ss += (v0[0] * v0[0] + v0[1] * v0[1]) + (v0[2] * v0[2] + v0[3] * v0[3]) + (v1[0] * v1[0] + v1[1] * v1[1]) + (v1[2] * v1[2] + v1[3] * v1[3]);
                    u32x4 w; w.x = cvt_pk_bf16(v0[0], v0[1]); w.y = cvt_pk_bf16(v0[2], v0[3]); w.z = cvt_pk_bf16(v1[0], v1[1]); w.w = cvt_pk_bf16(v1[2], v1[3]);
                    *(u32x4*)(rowp + bj * HALF) = w; }
                ss8[ai * 4 + m] = ss; }
        tile_row_ss(ss8, ps2, u.pm, u.g * 2 + u.pn, wr, wc, fr, fq, lds, tid);
    }
};
struct EpiComb {
    static constexpr bool PERM = true, AFTER_DRAIN = false, IDEMPOTENT = false;
    bf16_t* O; const float* gain;
    __device__ __forceinline__ void operator()(const Acc& acc, const Unit& u, int wr, int wc, int fr, int fq, LAS unsigned char* lds, int tid) const {
        const int row0 = u.g * PGW + u.pm * BM + wr * 64 + fr, col0 = u.pn * BM + wc * 32 + 8 * fq;
        f32x4 gv[2][2];
#pragma unroll
        for (int bj = 0; bj < 2; ++bj)
#pragma unroll
            for (int n = 0; n < 2; ++n) gv[bj][n] = *(const f32x4*)(gain + col0 + bj * HALF + 4 * n);
#pragma unroll
        for (int ai = 0; ai < 2; ++ai)
#pragma unroll
            for (int m = 0; m < 4; ++m) { bf16_t* rowp = O + (size_t)(row0 + ai * HALF + m * 16) * D + col0;
#pragma unroll
                for (int bj = 0; bj < 2; ++bj) { const f32x4 v0 = acc[ai][bj][m][0] * gv[bj][0], v1 = acc[ai][bj][m][1] * gv[bj][1];
                    u32x4 w; w.x = cvt_pk_bf16(v0[0], v0[1]); w.y = cvt_pk_bf16(v0[2], v0[3]); w.z = cvt_pk_bf16(v1[0], v1[1]); w.w = cvt_pk_bf16(v1[2], v1[3]);
                    *(u32x4*)(rowp + bj * HALF) = w; } }
    }
};
struct EpiS5Y {
    static constexpr bool PERM = true, AFTER_DRAIN = false, IDEMPOTENT = false;
    bf16_t* Y;
    __device__ __forceinline__ void operator()(const Acc& acc, const Unit& u, int wr, int wc, int fr, int fq, LAS unsigned char* lds, int tid) const {
        const int cr0 = wr * 64 + fr, h0 = 8 * (fq & 1);
#pragma unroll
        for (int ai = 0; ai < 2; ++ai)
#pragma unroll
            for (int m = 0; m < 4; ++m) { const int cr = cr0 + ai * HALF + m * 16;
#pragma unroll
                for (int bj = 0; bj < 2; ++bj) { const f32x4 v0 = acc[ai][bj][m][0], v1 = acc[ai][bj][m][1];
                    u32x4 w; w.x = cvt_pk_bf16(gelu_tanh_f(v0[0]), gelu_tanh_f(v0[1])); w.y = cvt_pk_bf16(gelu_tanh_f(v0[2]), gelu_tanh_f(v0[3]));
                    w.z = cvt_pk_bf16(gelu_tanh_f(v1[0]), gelu_tanh_f(v1[1])); w.w = cvt_pk_bf16(gelu_tanh_f(v1[2]), gelu_tanh_f(v1[3]));
                    const int j = u.pn * 16 + bj * 8 + wc * 2 + (fq >> 1);
                    ST16(Y, ((unsigned)(cr * CL + j) * SW + u.g * SH + h0) * 2u, w); } }
    }
};
struct EpiGLU {
    static constexpr bool PERM = true, AFTER_DRAIN = false, IDEMPOTENT = false;
    const bf16_t* Y; bf16_t* O; const float* bias; float* ps2;
    __device__ __forceinline__ void operator()(const Acc& acc, const Unit& u, int wr, int wc, int fr, int fq, LAS unsigned char* lds, int tid) const {
        const int row0 = u.pm * BM + wr * 64 + fr, col0 = u.pn * BM + wc * 32 + 8 * fq;
        f32x4 bv[2][2];
#pragma unroll
        for (int bj = 0; bj < 2; ++bj)
#pragma unroll
            for (int n = 0; n < 2; ++n) bv[bj][n] = *(const f32x4*)(bias + col0 + bj * HALF + 4 * n);
        float ss8[8];
#pragma unroll
        for (int ai = 0; ai < 2; ++ai)
#pragma unroll
            for (int m = 0; m < 4; ++m) { const int row = row0 + ai * HALF + m * 16; float ss = 0.f;
#pragma unroll
                for (int bj = 0; bj < 2; ++bj) { const f32x4 v0 = acc[ai][bj][m][0] + bv[bj][0], v1 = acc[ai][bj][m][1] + bv[bj][1];
                    const u32x4 yv = *(const u32x4*)(Y + (size_t)row * SW + col0 + bj * HALF);
                    float o[8]; o[0] = bf_lo(yv.x) * fast_sigmoid(v0[0]); o[1] = bf_hi(yv.x) * fast_sigmoid(v0[1]); o[2] = bf_lo(yv.y) * fast_sigmoid(v0[2]); o[3] = bf_hi(yv.y) * fast_sigmoid(v0[3]);
                    o[4] = bf_lo(yv.z) * fast_sigmoid(v1[0]); o[5] = bf_hi(yv.z) * fast_sigmoid(v1[1]); o[6] = bf_lo(yv.w) * fast_sigmoid(v1[2]); o[7] = bf_hi(yv.w) * fast_sigmoid(v1[3]);
                    ss += (o[0] * o[0] + o[1] * o[1]) + (o[2] * o[2] + o[3] * o[3]) + (o[4] * o[4] + o[5] * o[5]) + (o[6] * o[6] + o[7] * o[7]);
                    u32x4 w; w.x = cvt_pk_bf16(o[0], o[1]); w.y = cvt_pk_bf16(o[2], o[3]); w.z = cvt_pk_bf16(o[4], o[5]); w.w = cvt_pk_bf16(o[6], o[7]);
                    ST16(O, ((unsigned)row * D + SW + col0 + bj * HALF) * 2u, w); }
                ss8[ai * 4 + m] = ss; }
        tile_row_ss(ss8, ps2, u.pm, 8 + u.pn, wr, wc, fr, fq, lds, tid);
    }
};
struct EpiCarry {
    static constexpr bool PERM = false, AFTER_DRAIN = true, IDEMPOTENT = false;
    bf16_t* as5; const float* lp;
    __device__ __forceinline__ void fused(const Acc& acc, const Unit& u, int wr, int wc, int fr, int fq, LAS unsigned char* lds, int wid, int lane) const {
        LAS float* S = (LAS float*)lds;
#pragma unroll
        for (int ai = 0; ai < 2; ++ai)
#pragma unroll
            for (int m = 0; m < 4; ++m) { const int r = ai * HALF + wr * 64 + m * 16 + fr;
#pragma unroll
                for (int n = 0; n < 2; ++n) *(LAS f32x4*)(S + r * 128 + wc * 32 + n * 16 + 4 * fq) = acc[ai][0][m][n]; }
        LDS_WAIT(); __builtin_amdgcn_s_barrier(); asm volatile("" ::: "memory");
        const int b = wid, p = lane;
        const f32x2 L = *(const f32x2*)(lp + ((size_t)u.g * SP + p) * 2);
        float xr = 0.f, xi = 0.f;
        bf16_t* dst = as5 + (size_t)(u.g * CR + b * 32) * AK + CL * SH;
        for (int c = 0; c < 32; ++c) {
            const float sr = S[(b * 32 + c) * 128 + p], si = S[(b * 32 + c) * 128 + 64 + p];
            dst[(size_t)c * AK + p] = (bf16_t)f2bf(xr); dst[(size_t)c * AK + 64 + p] = (bf16_t)f2bf(xi);
            const float nr = L.x * xr - L.y * xi + sr, ni = L.x * xi + L.y * xr + si; xr = nr; xi = ni; }
    }
};

typedef int i32x4 __attribute__((ext_vector_type(4)));
typedef int i32x8 __attribute__((ext_vector_type(8)));
__device__ __forceinline__ i32x8 cat8(bf16x8 a, bf16x8 b) { return __builtin_shufflevector(__builtin_bit_cast(i32x4, a), __builtin_bit_cast(i32x4, b), 0, 1, 2, 3, 4, 5, 6, 7); }
template <class Epi, class Prob, bool ALIGN_EPI, bool SP2, int MODE = 0>
__device__ __forceinline__ void gemm_phase(LAS unsigned char* lds, const Prob& S, const Epi& E) {
    const int tid = threadIdx.x, wid = __builtin_amdgcn_readfirstlane(tid >> 6), lane = tid & 63, wr = wid >> 2, wc = wid & 3, fr = lane & 15, fq = lane >> 4;
    constexpr bool FP8 = (MODE == 1);
    int nt = S.nt, ksu = Prob::TWOSEG ? S.ks : 0; long skipA = 0;
    unsigned voffA0, voffB0, voffB20;
    { int R, C; stage_rc(tid * 16, R, C); const int Rb = Epi::PERM ? ((R & ~31) + perm32(R & 31)) : R;
      voffA0 = S.voffA(R, C); voffB0 = S.voffB(Rb, C); voffB20 = Prob::TWOSEG ? S.voffB2(Rb, C) : 0u; }
    const long dA = (long)S.voffA(64, 0) - (long)S.voffA(0, 0), dB = (long)S.voffB(64, 0) - (long)S.voffB(0, 0), dB2 = Prob::TWOSEG ? ((long)S.voffB2(64, 0) - (long)S.voffB2(0, 0)) : 0;
    const long kstepA = S.kstepA, kstepB = S.kstepB, hstepA = S.hstepA, hstepB = S.hstepB;
    const unsigned ldsw = (unsigned)wid * 1024u;
    const int aoff = lds_byte(wr * 64 + fr, fq * 8), boff = lds_byte(wc * 32 + fr, fq * 8);
#define PG8_SA(b, h) (((b) * 2 + (h)) * HTB)
#define PG8_SB(b, h) ((4 + (b) * 2 + (h)) * HTB)
#define PG8_STAGE(bufoff, gbase, v0, d) do { const unsigned _v0 = (v0); const char* _g0 = (const char*)(gbase); const char* _g1 = _g0 + (d); asm volatile("" : "+s"(_g0), "+s"(_g1)); \
        __builtin_amdgcn_global_load_lds((const unsigned*)(_g0 + _v0), (LAS unsigned*)(lds + (bufoff) + ldsw), 16, 0, 0); \
        __builtin_amdgcn_global_load_lds((const unsigned*)(_g1 + _v0), (LAS unsigned*)(lds + (bufoff) + ldsw + 8192), 16, 0, 0); } while (0)
#define PG8_STA(bufoff, gbase) PG8_STAGE(bufoff, gbase, voffA0, dA)
#define PG8_LDA(dst, b, h) do { _Pragma("unroll") for (int m = 0; m < 4; ++m) { if constexpr (FP8) { dst##8[m].lo = *(const LAS i32x4*)(lds + PG8_SA(b, h) + aoff + m * 2048); dst##8[m].hi = *(const LAS i32x4*)(lds + PG8_SA(b, h) + aoff + m * 2048 + 1024); } \
        else { _Pragma("unroll") for (int k = 0; k < 2; ++k) dst[m][k] = *(const LAS bf16x8*)(lds + PG8_SA(b, h) + aoff + m * 2048 + k * 1024); } } } while (0)
#define PG8_LDB(dst, b, h) do { _Pragma("unroll") for (int n = 0; n < 2; ++n) { if constexpr (FP8) { dst##8[n].lo = *(const LAS i32x4*)(lds + PG8_SB(b, h) + boff + n * 2048); dst##8[n].hi = *(const LAS i32x4*)(lds + PG8_SB(b, h) + boff + n * 2048 + 1024); } \
        else { _Pragma("unroll") for (int k = 0; k < 2; ++k) dst[n][k] = *(const LAS bf16x8*)(lds + PG8_SB(b, h) + boff + n * 2048 + k * 1024); } } } while (0)
#define PG8_MMA(ai, bj, At, Bt) do { __builtin_amdgcn_s_setprio(1); \
        if constexpr (FP8) { _Pragma("unroll") for (int o_ = 0; o_ < 8; ++o_) { const int m = MMA_NM8 ? (o_ & 3) : (o_ >> 1), n = MMA_NM8 ? (o_ >> 2) : (o_ & 1); \
            acc[ai][bj][m][n] = __builtin_amdgcn_mfma_scale_f32_16x16x128_f8f6f4(Bt##8[n], At##8[m], acc[ai][bj][m][n], 0, 0, 0, 0x7F7F7F7F, 0, 0x7F7F7F7F); if (MMA_PIN) __builtin_amdgcn_sched_barrier(0); } } \
        else if constexpr (MODE == 2) { _Pragma("unroll") for (int o_ = 0; o_ < 8; ++o_) _Pragma("unroll") for (int k = 0; k < 2; ++k) { const int m = MMA_NM ? (o_ & 3) : (o_ >> 1), n = MMA_NM ? (o_ >> 2) : (o_ & 1); \
            acc[ai][bj][m][n] = __builtin_bit_cast(f32x4, __builtin_amdgcn_mfma_i32_16x16x64_i8(__builtin_bit_cast(i32x4, Bt[n][k]), __builtin_bit_cast(i32x4, At[m][k]), __builtin_bit_cast(i32x4, acc[ai][bj][m][n]), 0, 0, 0)); if (MMA_PIN) __builtin_amdgcn_sched_barrier(0); } } \
        else { _Pragma("unroll") for (int o_ = 0; o_ < 8; ++o_) _Pragma("unroll") for (int k = 0; k < 2; ++k) { const int m = MMA_NM ? (o_ & 3) : (o_ >> 1), n = MMA_NM ? (o_ >> 2) : (o_ & 1); \
            acc[ai][bj][m][n] = (F16 && MODE != 3) ? __builtin_amdgcn_mfma_f32_16x16x32_f16(__builtin_bit_cast(f16x8, Bt[n][k]), __builtin_bit_cast(f16x8, At[m][k]), acc[ai][bj][m][n], 0, 0, 0) \
                                    : __builtin_amdgcn_mfma_f32_16x16x32_bf16(Bt[n][k], At[m][k], acc[ai][bj][m][n], 0, 0, 0); if (MMA_PIN) __builtin_amdgcn_sched_barrier(0); \
            if (DUP_MFMA) dummy[(m * 2 + n) & 3] = __builtin_amdgcn_mfma_f32_16x16x32_bf16(Bt[n][k], At[m][k], dummy[(m * 2 + n) & 3], 0, 0, 0); } } \
        __builtin_amdgcn_s_setprio(0); } while (0)
#define PG8_WAIT_V(n) asm volatile("s_waitcnt vmcnt(" #n ")" ::: "memory")
#define PG8_WAIT_L(n) asm volatile("s_waitcnt lgkmcnt(" #n ")" ::: "memory")
#define PG8_BAR __builtin_amdgcn_s_barrier()
#define PG8_SCHED __builtin_amdgcn_sched_barrier(0)
    Unit cur, nxt; int ui = 0;
    if (!S.next(0, cur)) return;
    f32x4 acc[2][2][4][2];
#pragma unroll
    for (int a = 0; a < 2; ++a)
#pragma unroll
        for (int b = 0; b < 2; ++b)
#pragma unroll
            for (int m = 0; m < 4; ++m)
#pragma unroll
                for (int n = 0; n < 2; ++n) acc[a][b][m][n] = (f32x4){0.f, 0.f, 0.f, 0.f};
    bf16x8 At[4][2], B0[2][2], B1[2][2]; i32x8 At8[4], B08[2], B18[2];
    f32x4 dummy[4] = {{0.f, 0.f, 0.f, 0.f}, {0.f, 0.f, 0.f, 0.f}, {0.f, 0.f, 0.f, 0.f}, {0.f, 0.f, 0.f, 0.f}};
    const char* cA = S.a_base(cur); const char* cB = S.b_base(cur); const char* cB2 = Prob::TWOSEG ? S.b_base2(cur) : cB;
    if constexpr (Prob::KSKIP) { ksu = S.ks_of(cur); nt = ksu + (S.nt - S.ks); skipA = (long)(S.ks - ksu) * S.kstepA; }
    if constexpr (SP2) {
        PG8_STAGE(PG8_SB(0, 0), cB, voffB0, dB); PG8_STAGE(PG8_SB(0, 1), cB + hstepB, voffB0, dB); PG8_STA(PG8_SA(0, 0), cA); PG8_STA(PG8_SA(0, 1), cA + hstepA);
        if (wr == 1) PG8_BAR;
        PG8_WAIT_V(2); PG8_BAR;
        PG8_STAGE(PG8_SB(1, 0), cB + kstepB, voffB0, dB); PG8_STA(PG8_SA(1, 0), cA + kstepA); PG8_STAGE(PG8_SB(1, 1), cB + hstepB + kstepB, voffB0, dB);
        PG8_WAIT_V(6); PG8_BAR;
    } else {
        PG8_STAGE(PG8_SB(0, 0), cB, voffB0, dB); PG8_STA(PG8_SA(0, 0), cA); PG8_STAGE(PG8_SB(0, 1), cB + hstepB, voffB0, dB); PG8_STA(PG8_SA(0, 1), cA + hstepA);
        if (wr == 1) PG8_BAR;
        PG8_WAIT_V(4); PG8_BAR;
        PG8_STAGE(PG8_SB(1, 0), cB + kstepB, voffB0, dB); PG8_STA(PG8_SA(1, 0), cA + kstepA); PG8_STAGE(PG8_SB(1, 1), cB + hstepB + kstepB, voffB0, dB);
        PG8_WAIT_V(6); PG8_BAR;
    }
    for (;;) {
        const bool has_next = S.next(ui + 1, nxt);
        const char* nA = has_next ? S.a_base(nxt) : cA; const char* nB = has_next ? S.b_base(nxt) : cB; const char* nB2 = (Prob::TWOSEG && has_next) ? S.b_base2(nxt) : cB2;
        for (int t = 0; t < nt; t += 2) {
            asm volatile("" : "+v"(voffA0), "+v"(voffB0), "+v"(voffB20));
            if (S.tmid >= 0 && t == S.tmid) {
                const LAS float* RAT = (const LAS float*)(lds + EPI_LDS_OFF + 5120);
#pragma unroll
                for (int ai = 0; ai < 2; ++ai)
#pragma unroll
                    for (int m = 0; m < 4; ++m) { const float r = RAT[ai * HALF + wr * 64 + m * 16 + fr];
#pragma unroll
                        for (int bj = 0; bj < 2; ++bj)
#pragma unroll
                            for (int n = 0; n < 2; ++n) acc[ai][bj][m][n] = acc[ai][bj][m][n] * r; } }
            const bool last = (t == nt - 2);
            const char* a1 = cA + (long)(t + 1) * kstepA + ((Prob::KSKIP && t >= ksu) ? skipA : 0);
            const char* a2; const char* b2; long kb = kstepB, hb = hstepB, db = dB; unsigned vb0 = voffB0;
            if (last) { a2 = nA; b2 = nB; }
            else { a2 = cA + (long)(t + 2) * kstepA + ((Prob::KSKIP && t + 2 >= ksu) ? skipA : 0);
                   if (Prob::TWOSEG && t + 2 >= ksu) { b2 = cB2 + (long)(t + 2 - ksu) * S.kstepB2; kb = S.kstepB2; hb = S.hstepB2; vb0 = voffB20; db = dB2; }
                   else b2 = cB + (long)(t + 2) * kstepB; }
            const char* a3 = a2 + kstepA; const char* b3 = b2 + kb;
            if constexpr (SP2) {
            PG8_LDB(B0, 0, 0); PG8_LDB(B1, 0, 1); PG8_SCHED; PG8_LDA(At, 0, 0); PG8_STA(PG8_SA(1, 1), a1 + hstepA);
            PG8_WAIT_V(8); PG8_WAIT_L(0); PG8_BAR; PG8_MMA(0, 0, At, B0); PG8_MMA(0, 1, At, B1); PG8_BAR; PG8_SCHED;
#if PG8_SPLIT
            PG8_LDA(At, 0, 1); PG8_STAGE(PG8_SB(0, 0), b2, vb0, db);
            PG8_WAIT_V(4); PG8_WAIT_L(0); PG8_BAR; PG8_MMA(1, 0, At, B0); PG8_SCHED; PG8_STAGE(PG8_SB(0, 1), b2 + hb, vb0, db); PG8_SCHED; PG8_MMA(1, 1, At, B1); PG8_SCHED; PG8_STA(PG8_SA(0, 0), a2); PG8_BAR; PG8_SCHED;
#else
            PG8_LDA(At, 0, 1); PG8_STAGE(PG8_SB(0, 0), b2, vb0, db); PG8_STAGE(PG8_SB(0, 1), b2 + hb, vb0, db); PG8_STA(PG8_SA(0, 0), a2);
            PG8_WAIT_V(8); PG8_WAIT_L(0); PG8_BAR; PG8_MMA(1, 0, At, B0); PG8_MMA(1, 1, At, B1); PG8_BAR; PG8_SCHED;
#endif
            PG8_LDB(B0, 1, 0); PG8_LDB(B1, 1, 1); PG8_SCHED; PG8_LDA(At, 1, 0); PG8_STA(PG8_SA(0, 1), a2 + hstepA);
            PG8_WAIT_V(8); PG8_WAIT_L(0); PG8_BAR; PG8_MMA(0, 0, At, B0); PG8_MMA(0, 1, At, B1); PG8_BAR; PG8_SCHED;
#if PG8_SPLIT
            PG8_LDA(At, 1, 1); PG8_STAGE(PG8_SB(1, 0), b3, vb0, db);
            PG8_WAIT_V(4); PG8_WAIT_L(0); PG8_BAR; PG8_MMA(1, 0, At, B0); PG8_SCHED; PG8_STAGE(PG8_SB(1, 1), b3 + hb, vb0, db); PG8_SCHED; PG8_MMA(1, 1, At, B1); PG8_SCHED; PG8_STA(PG8_SA(1, 0), a3); PG8_BAR; PG8_SCHED;
#else
            PG8_LDA(At, 1, 1); PG8_STAGE(PG8_SB(1, 0), b3, vb0, db); PG8_STAGE(PG8_SB(1, 1), b3 + hb, vb0, db); PG8_STA(PG8_SA(1, 0), a3);
            PG8_WAIT_V(8); PG8_WAIT_L(0); PG8_BAR; PG8_MMA(1, 0, At, B0); PG8_MMA(1, 1, At, B1); PG8_BAR; PG8_SCHED;
#endif
            } else {
            PG8_LDB(B0, 0, 0); PG8_SCHED; PG8_LDA(At, 0, 0); PG8_STA(PG8_SA(1, 1), a1 + hstepA);
            PG8_WAIT_L(8); PG8_BAR; PG8_WAIT_L(0); PG8_MMA(0, 0, At, B0); PG8_BAR; PG8_SCHED;
            PG8_LDB(B1, 0, 1); PG8_STAGE(PG8_SB(0, 0), b2, vb0, db);
            PG8_BAR; PG8_WAIT_L(0); PG8_MMA(0, 1, At, B1); PG8_BAR;
            PG8_LDA(At, 0, 1); PG8_STA(PG8_SA(0, 0), a2);
            PG8_BAR; PG8_WAIT_L(0); PG8_MMA(1, 0, At, B0); PG8_BAR; PG8_SCHED;
            PG8_STAGE(PG8_SB(0, 1), b2 + hb, vb0, db);
            PG8_WAIT_V(6); PG8_BAR; PG8_MMA(1, 1, At, B1); PG8_BAR;
            PG8_LDB(B0, 1, 0); PG8_SCHED; PG8_LDA(At, 1, 0); PG8_STA(PG8_SA(0, 1), a2 + hstepA);
            PG8_WAIT_L(8); PG8_BAR; PG8_WAIT_L(0); PG8_MMA(0, 0, At, B0); PG8_BAR; PG8_SCHED;
            PG8_LDB(B1, 1, 1); PG8_STAGE(PG8_SB(1, 0), b3, vb0, db);
            PG8_BAR; PG8_WAIT_L(0); PG8_MMA(0, 1, At, B1); PG8_BAR;
            PG8_LDA(At, 1, 1); PG8_STA(PG8_SA(1, 0), a3);
            PG8_BAR; PG8_WAIT_L(0); PG8_MMA(1, 0, At, B0); PG8_BAR; PG8_SCHED;
            PG8_STAGE(PG8_SB(1, 1), b3 + hb, vb0, db);
            PG8_WAIT_V(6); PG8_BAR; PG8_MMA(1, 1, At, B1); PG8_BAR;
            }
        }
        if constexpr (ALIGN_EPI) { if (wr == 0) PG8_BAR; }
        if constexpr (!Epi::AFTER_DRAIN) {
            int tz = threadIdx.x; asm volatile("" : "+v"(tz)); const int lz = tz & 63;
            E(acc, cur, wr, wc, lz & 15, lz >> 4, lds, tz);
            if (EPI_TWICE && Epi::IDEMPOTENT) E(acc, cur, wr, wc, lz & 15, lz >> 4, lds, tz); }
        if (!has_next) break;
#pragma unroll
        for (int a = 0; a < 2; ++a)
#pragma unroll
            for (int b = 0; b < 2; ++b)
#pragma unroll
                for (int m = 0; m < 4; ++m)
#pragma unroll
                    for (int n = 0; n < 2; ++n) acc[a][b][m][n] = (f32x4){0.f, 0.f, 0.f, 0.f};
        cur = nxt; cA = nA; cB = nB; cB2 = nB2; ++ui;
        if constexpr (Prob::KSKIP) { ksu = S.ks_of(cur); nt = ksu + (S.nt - S.ks); skipA = (long)(S.ks - ksu) * S.kstepA; }
        if constexpr (ALIGN_EPI) { if (wr == 1) PG8_BAR; }
    }
    if (DUP_MFMA) asm volatile("" :: "v"(dummy[0]), "v"(dummy[1]), "v"(dummy[2]), "v"(dummy[3]));
    PG8_WAIT_V(0);
    if constexpr (!ALIGN_EPI) { if (wr == 0) PG8_BAR; }
    PG8_BAR;
    if constexpr (Epi::AFTER_DRAIN) { E.fused(acc, cur, wr, wc, fr, fq, lds, wid, lane); }
#undef PG8_SA
#undef PG8_SB
#undef PG8_STAGE
#undef PG8_STA
#undef PG8_LDA
#undef PG8_LDB
#undef PG8_MMA
#undef PG8_WAIT_V
#undef PG8_WAIT_L
#undef PG8_BAR
#undef PG8_SCHED
}
}

#define XB_TMO      128
#define XB_XCNT(j)  (256  + 64 * (j))
#define XB_XSUB(j)  (1280 + 64 * (j))
#define XB_XGEN(j)  (2304 + 64 * (j))
#define XB_TOP      3328
#define XB_TOPGEN   3392
#define XCD_BAR_WORDS 3456
#define XB_SPIN_CAP (1u << 18)
__device__ __forceinline__ unsigned xb_ld(unsigned* p)              { return __hip_atomic_load(p, __ATOMIC_RELAXED, __HIP_MEMORY_SCOPE_AGENT); }
__device__ __forceinline__ unsigned xb_add(unsigned* p, unsigned v) { return __hip_atomic_fetch_add(p, v, __ATOMIC_RELAXED, __HIP_MEMORY_SCOPE_AGENT); }
__device__ __forceinline__ unsigned xb_xcc_id() { return (unsigned)__builtin_amdgcn_s_getreg((3 << 11) | 20) & 0xFu; }
#define XB_SPIN(cond, bar) do { unsigned _sp = 0; while (cond) { __builtin_amdgcn_s_sleep(1); \
    if ((++_sp & 255u) == 0u) { if (xb_ld(&(bar)[XB_TMO])) break; if (_sp > XB_SPIN_CAP) { atomicAdd(&(bar)[XB_TMO], 1u); break; } } } } while (0)
struct XcdBarrier { unsigned* bar; unsigned x; volatile LAS unsigned* st; };
__device__ __forceinline__ XcdBarrier xcd_barrier_post(unsigned* bar, volatile LAS unsigned* st) {
    XcdBarrier b; b.bar = bar; b.x = xb_xcc_id(); b.st = st;
    if (threadIdx.x == 0) (void)xb_add(&bar[XB_XCNT(b.x)], 1u);
    return b;
}
__device__ __forceinline__ void xcd_barrier_complete(unsigned* bar, unsigned x, unsigned& nloc, unsigned& nx) {
    const unsigned G = gridDim.x * gridDim.y * gridDim.z;
    unsigned sum, cnt, mine, sp = 0u;
    for (;;) {
        sum = 0u; cnt = 0u; mine = 0u;
#pragma unroll
        for (unsigned j = 0; j < 16; ++j) { const unsigned c = xb_ld(&bar[XB_XCNT(j)]); sum += c; cnt += (c > 0u) ? 1u : 0u; mine = (j == x) ? c : mine; }
        if (sum == G) break;
        __builtin_amdgcn_s_sleep(1);
        if ((++sp & 255u) == 0u) { if (xb_ld(&bar[XB_TMO])) break; if (sp > XB_SPIN_CAP) { atomicAdd(&bar[XB_TMO], 1u); break; } }
    }
    nloc = mine > 0u ? mine : 1u; nx = cnt > 0u ? cnt : 1u;
}
__device__ __forceinline__ void xcd_barrier(const XcdBarrier& b) {
    asm volatile("s_waitcnt vmcnt(0)" ::: "memory");
    __syncthreads();
    if (threadIdx.x == 0) {
        unsigned* bar = b.bar;
        __builtin_amdgcn_s_waitcnt(0);
        unsigned nloc = b.st[0], nx = b.st[1];
        if (nloc == 0u) { xcd_barrier_complete(bar, b.x, nloc, nx); b.st[0] = nloc; b.st[1] = nx; }
        const unsigned old = xb_add(&bar[XB_XSUB(b.x)], 1u);
        const unsigned gen = old / nloc;
        if (old + 1u == (gen + 1u) * nloc) {
            __builtin_amdgcn_fence(__ATOMIC_RELEASE, "agent");
            asm volatile("s_waitcnt vmcnt(0)" ::: "memory");
            const unsigned og = xb_add(&bar[XB_TOP], 1u);
            const unsigned tg = og / nx;
            if (og + 1u == (tg + 1u) * nx) xb_add(&bar[XB_TOPGEN], 1u);
            else XB_SPIN(xb_ld(&bar[XB_TOPGEN]) == tg, bar);
            __builtin_amdgcn_fence(__ATOMIC_ACQUIRE, "agent");
            xb_add(&bar[XB_XGEN(b.x)], 1u);
            asm volatile("s_waitcnt vmcnt(0)" ::: "memory");
        } else {
            XB_SPIN(xb_ld(&bar[XB_XGEN(b.x)]) == gen, bar);
            __builtin_amdgcn_fence(__ATOMIC_ACQUIRE, "agent");
            asm volatile("s_waitcnt vmcnt(0)" ::: "memory");
        }
    }
    __syncthreads();
}

enum In { I_X = 0, I_N1, I_G1, I_U1, I_D1, I_MIXN, I_WIN, I_WPOOL, I_PSCALE, I_LRE, I_LIM, I_LOGDT, I_BRE, I_BIM, I_CRE, I_CIM, I_DSKIP, I_WGLU, I_BGLU, I_PON, I_SON, I_WOUT, I_N2, I_G2, I_U2, I_D2, I_FN, N_IN };
struct Args { const float* in[N_IN]; float* out; unsigned char* ws; int ph_lo, ph_hi, li, pad; };
struct Frame {
    LAS unsigned char* lds; volatile LAS unsigned* MISC; unsigned* ctl;
    int tid, lane, wave, vcu, G;
};

#ifndef P0_KFAST
#define P0_KFAST 1
#endif
#define P0_DECODE(item, dim) const int kb = P0_KFAST ? (item) % (dim) : (item) / (dim), nb = P0_KFAST ? (item) / (dim) : (item) % (dim)
#define P0_DIM(K_, N_) (P0_KFAST ? (K_) / 128 : (N_) / 256)
__device__ __forceinline__ void p0_item_load(const float* W, int ld, int item, int nblk, int wave, int lane, f32x4 (&v)[16]) {
    P0_DECODE(item, nblk);
    const float* src = W + (size_t)(128 * kb + 16 * wave) * ld + 256 * nb + 4 * lane;
#pragma unroll
    for (int r = 0; r < 16; ++r) v[r] = __builtin_nontemporal_load((const f32x4*)(src + (size_t)r * ld));
}
typedef const __attribute__((address_space(4))) float* CFP;
__device__ __forceinline__ CFP scalar_gain_ptr(const float* gain, int k0, int wave) { const unsigned long long a = (unsigned long long)(gain + k0 + 16 * wave);
    return (CFP)(((unsigned long long)(unsigned)__builtin_amdgcn_readfirstlane((int)(a >> 32)) << 32) | (unsigned long long)(unsigned)__builtin_amdgcn_readfirstlane((int)(unsigned)a)); }
__device__ __forceinline__ void p0_item_store(const f32x4 (&v)[16], int K, bf16_t* WT, const float* gain, int rs, int ro, int item, int nblk, LAS unsigned* T, int tid, int wave, int lane, int qf = 0) {
    P0_DECODE(item, nblk); const int k0 = 128 * kb, n0 = 256 * nb; const CFP gs = scalar_gain_ptr(gain, k0, wave);
#pragma unroll
    for (int i = 0; i < 8; ++i) { const int kp = 8 * wave + i;
        float ge = 1.f, go = 1.f; if (gain) { ge = gs[2 * i]; go = gs[2 * i + 1]; }
        if (INT8_GU2 == 1 && qf == 2) { ge *= WQ_SCALE; go *= WQ_SCALE; }
#define WQ(x) ((INT8_GU2 == 1 && qf == 2) ? qint8(x) : ((EMU_FP8 && qf == 1) ? q8(x) : (x)))
        if (qf == 4) { u32x4 wb; wb.x = cvt_pk_truebf16(v[2 * i].x * ge, v[2 * i + 1].x * go); wb.y = cvt_pk_truebf16(v[2 * i].y * ge, v[2 * i + 1].y * go); wb.z = cvt_pk_truebf16(v[2 * i].z * ge, v[2 * i + 1].z * go); wb.w = cvt_pk_truebf16(v[2 * i].w * ge, v[2 * i + 1].w * go);
            *(LAS u32x4*)(T + kp * 256 + 4 * (lane ^ ((kp >> 2) & 7))) = wb; continue; }
        u32x4 w; w.x = cvt_pk_bf16(WQ(v[2 * i].x * ge), WQ(v[2 * i + 1].x * go)); w.y = cvt_pk_bf16(WQ(v[2 * i].y * ge), WQ(v[2 * i + 1].y * go)); w.z = cvt_pk_bf16(WQ(v[2 * i].z * ge), WQ(v[2 * i + 1].z * go)); w.w = cvt_pk_bf16(WQ(v[2 * i].w * ge), WQ(v[2 * i + 1].w * go));
#undef WQ
        *(LAS u32x4*)(T + kp * 256 + 4 * (lane ^ ((kp >> 2) & 7))) = w; }
    LDS_WAIT(); __builtin_amdgcn_s_barrier(); asm volatile("" ::: "memory");
    const int q = tid & 15;
#pragma unroll
    for (int j = 0; j < 8; ++j) { const int n = (tid >> 4) + 32 * j; const LAS unsigned* r = T + (4 * q) * 256 + 4 * ((n >> 2) ^ (q & 7)) + (n & 3);
        u32x4 w; w.x = r[0]; w.y = r[256]; w.z = r[512]; w.w = r[768];
        const int ng = n0 + n, drow = (ng >> 7) * rs + (ng & 127) + ro;
        if (rs == 0) *(GAS u32x4*)(WT + ((size_t)((k0 + 8 * q) >> 6) * ro + ng) * 64 + ((k0 + 8 * q) & 63)) = w;
        else *(GAS u32x4*)(WT + (size_t)drow * K + k0 + 8 * q) = w; }
    LDS_WAIT(); __builtin_amdgcn_s_barrier(); asm volatile("" ::: "memory");
}
__device__ __forceinline__ void p0_item_store_fp8(const f32x4 (&v)[16], int K, unsigned char* WT, int item, int nblk, LAS unsigned* T, int tid, int wave, int lane) {
    P0_DECODE(item, nblk); const int k0 = 128 * kb, n0 = 256 * nb;
#pragma unroll
    for (int i = 0; i < 4; ++i) { const int kq = 4 * wave + i;
        u32x4 w; w.x = pk4_fp8(v[4 * i].x * W8_SCALE, v[4 * i + 1].x * W8_SCALE, v[4 * i + 2].x * W8_SCALE, v[4 * i + 3].x * W8_SCALE);
        w.y = pk4_fp8(v[4 * i].y * W8_SCALE, v[4 * i + 1].y * W8_SCALE, v[4 * i + 2].y * W8_SCALE, v[4 * i + 3].y * W8_SCALE);
        w.z = pk4_fp8(v[4 * i].z * W8_SCALE, v[4 * i + 1].z * W8_SCALE, v[4 * i + 2].z * W8_SCALE, v[4 * i + 3].z * W8_SCALE);
        w.w = pk4_fp8(v[4 * i].w * W8_SCALE, v[4 * i + 1].w * W8_SCALE, v[4 * i + 2].w * W8_SCALE, v[4 * i + 3].w * W8_SCALE);
        *(LAS u32x4*)(T + kq * 256 + 4 * (lane ^ ((kq >> 2) & 7))) = w; }
    LDS_WAIT(); __builtin_amdgcn_s_barrier(); asm volatile("" ::: "memory");
    const int q = tid & 7;
#pragma unroll
    for (int j = 0; j < 4; ++j) { const int n = (tid >> 3) + 64 * j; const LAS unsigned* r = T + (4 * q) * 256 + 4 * ((n >> 2) ^ (q & 7)) + (n & 3);
        u32x4 w; w.x = r[0]; w.y = r[256]; w.z = r[512]; w.w = r[768];
        *(GAS u32x4*)(WT + (size_t)(n0 + n) * K + k0 + 16 * q) = w; }
    LDS_WAIT(); __builtin_amdgcn_s_barrier(); asm volatile("" ::: "memory");
}
__device__ __forceinline__ void p0_item_store_i8(const f32x4 (&v)[16], int K, unsigned char* WT, const float* gain, int rs, int ro, int item, int nblk, LAS unsigned* T, int tid, int wave, int lane) {
    P0_DECODE(item, nblk); const int k0 = 128 * kb, n0 = 256 * nb; const CFP gs = scalar_gain_ptr(gain, k0, wave);
#pragma unroll
    for (int i = 0; i < 4; ++i) { const int kq = 4 * wave + i;
        float g0 = WQ_SCALE, g1 = WQ_SCALE, g2 = WQ_SCALE, g3 = WQ_SCALE;
        if (gain) { g0 *= gs[4 * i]; g1 *= gs[4 * i + 1]; g2 *= gs[4 * i + 2]; g3 *= gs[4 * i + 3]; }
        u32x4 w; w.x = pk4_i8(v[4 * i].x * g0, v[4 * i + 1].x * g1, v[4 * i + 2].x * g2, v[4 * i + 3].x * g3);
        w.y = pk4_i8(v[4 * i].y * g0, v[4 * i + 1].y * g1, v[4 * i + 2].y * g2, v[4 * i + 3].y * g3);
        w.z = pk4_i8(v[4 * i].z * g0, v[4 * i + 1].z * g1, v[4 * i + 2].z * g2, v[4 * i + 3].z * g3);
        w.w = pk4_i8(v[4 * i].w * g0, v[4 * i + 1].w * g1, v[4 * i + 2].w * g2, v[4 * i + 3].w * g3);
        *(LAS u32x4*)(T + kq * 256 + 4 * (lane ^ ((kq >> 2) & 7))) = w; }
    LDS_WAIT(); __builtin_amdgcn_s_barrier(); asm volatile("" ::: "memory");
    const int q = tid & 7;
#pragma unroll
    for (int j = 0; j < 4; ++j) { const int n = (tid >> 3) + 64 * j; const LAS unsigned* r = T + (4 * q) * 256 + 4 * ((n >> 2) ^ (q & 7)) + (n & 3);
        u32x4 w; w.x = r[0]; w.y = r[256]; w.z = r[512]; w.w = r[768];
        const int ng = n0 + n, drow = (ng >> 7) * rs + (ng & 127) + ro;
        *(GAS u32x4*)(WT + (size_t)drow * K + k0 + 16 * q) = w; }
    LDS_WAIT(); __builtin_amdgcn_s_barrier(); asm volatile("" ::: "memory");
}
struct TDesc { const float* src; bf16_t* dst; const float* gain; const float* gain2; int K, N, rs, ro, first, pad, ld, pad2; };
constexpr int N_TDESC = 13;

__device__ __forceinline__ void rms_row_to_bf16(const float* xrow, const float* gain, bf16_t* orow, int lane) {
    const GAS f32x4* xr = (const GAS f32x4*)xrow + lane;
    f32x4 v[16]; float s = 0.f;
#pragma unroll
    for (int j = 0; j < 16; ++j) { v[j] = xr[64 * j]; s += (v[j].x * v[j].x + v[j].y * v[j].y) + (v[j].z * v[j].z + v[j].w * v[j].w); }
    const float rstd = 1.0f / sqrtf(wave_sum(s) * (1.f / D) + NORM_EPS);
    const GAS f32x4* gr = (const GAS f32x4*)gain + lane;
    GAS u32x2* o8 = (GAS u32x2*)orow + lane;
#pragma unroll
    for (int j = 0; j < 16; ++j) { const f32x4 g = gr[64 * j]; u32x2 w; w.x = cvt_pk_bf16(v[j].x * rstd * g.x, v[j].y * rstd * g.y); w.y = cvt_pk_bf16(v[j].z * rstd * g.z, v[j].w * rstd * g.w); o8[64 * j] = w; }
}
__device__ __forceinline__ void rms_row_to_i8(const float* xrow, const float* gain, unsigned char* orow, int lane) {
    const GAS f32x4* xr = (const GAS f32x4*)xrow + lane;
    f32x4 v[16]; float s = 0.f;
#pragma unroll
    for (int j = 0; j < 16; ++j) { v[j] = xr[64 * j]; s += (v[j].x * v[j].x + v[j].y * v[j].y) + (v[j].z * v[j].z + v[j].w * v[j].w); }
    const float rstd = AQ1_SCALE / sqrtf(wave_sum(s) * (1.f / D) + NORM_EPS);
    const GAS f32x4* gr = (const GAS f32x4*)gain + lane;
    GAS unsigned* o4 = (GAS unsigned*)orow + lane;
#pragma unroll
    for (int j = 0; j < 16; ++j) { const f32x4 g = gr[64 * j]; o4[64 * j] = pk4_i8(v[j].x * rstd * g.x, v[j].y * rstd * g.y, v[j].z * rstd * g.z, v[j].w * rstd * g.w); }
}
__device__ __forceinline__ void norm_phase_i8(Frame& F, const float* src, const float* gain, unsigned char* dst) {
    const int gw = F.vcu * NWAVES + F.wave, NGW = F.G * NWAVES;
    LAS f32x4* GL = (LAS f32x4*)(F.lds + RING_OFF);
    __syncthreads();
    for (int e = F.tid; e < D / 4; e += NWAVES * 64) GL[e] = ((const f32x4*)gain)[e];
    __syncthreads();
    f32x4 vn[16];
    int m = gw;
    if (m < M) { const GAS f32x4* xr = (const GAS f32x4*)(src + (size_t)m * D) + F.lane;
#pragma unroll
        for (int j = 0; j < 16; ++j) vn[j] = xr[64 * j]; }
#define XN_ROW(m_, more_) do { f32x4 v[16]; \
        _Pragma("unroll") for (int j = 0; j < 16; ++j) v[j] = vn[j]; \
        if (more_) { const GAS f32x4* xr = (const GAS f32x4*)(src + (size_t)((m_) + NGW) * D) + F.lane; \
            _Pragma("unroll") for (int j = 0; j < 16; ++j) vn[j] = xr[64 * j]; } \
        asm volatile("" ::: "memory");        \
        float s = 0.f; \
        _Pragma("unroll") for (int j = 0; j < 16; ++j) s += (v[j].x * v[j].x + v[j].y * v[j].y) + (v[j].z * v[j].z + v[j].w * v[j].w); \
        const float rstd = AQ1_SCALE / sqrtf(wave_sum(s) * (1.f / D) + NORM_EPS); \
        GAS unsigned* o4 = (GAS unsigned*)(dst + (size_t)(m_) * D) + F.lane; \
        _Pragma("unroll") for (int j = 0; j < 16; ++j) { const f32x4 gj = GL[64 * j + F.lane]; o4[64 * j] = pk4_i8(v[j].x * rstd * gj.x, v[j].y * rstd * gj.y, v[j].z * rstd * gj.z, v[j].w * rstd * gj.w); } } while (0)
    constexpr int RPW = M / (256 * NWAVES);
    if (NGW == 256 * NWAVES) {
#pragma unroll
        for (int r = 0; r < RPW; ++r) XN_ROW(gw + r * NGW, r + 1 < RPW);
    } else { for (; m < M; m += NGW) XN_ROW(m, m + NGW < M); }
#undef XN_ROW
}
__device__ __forceinline__ void norm_phase_bf16(Frame& F, const float* src, const float* gain, bf16_t* dst) {
    const int gw = F.vcu * NWAVES + F.wave, NGW = F.G * NWAVES;
    for (int m = gw; m < M; m += NGW) rms_row_to_bf16(src + (size_t)m * D, gain, dst + (size_t)m * D, F.lane);
}
__device__ __forceinline__ void norm_phase_final(Frame& F, const bf16_t* h, const float* ps, const float* gain, float* out) {
    const int gw = F.vcu * NWAVES + F.wave, NGW = F.G * NWAVES;
    int tz = threadIdx.x; asm volatile("" : "+v"(tz)); const int ln = tz & 63;
    LAS f32x4* GL = (LAS f32x4*)(F.lds + RING_OFF);
    __syncthreads();
    for (int e = tz; e < D / 4; e += NWAVES * 64) GL[e] = ((const f32x4*)gain)[e];
    __syncthreads();
    u32x4 vn[8]; float pvn = 0.f;
    if (gw < M) { const GAS u32x4* hr = (const GAS u32x4*)(h + (size_t)gw * D) + ln;
#pragma unroll
        for (int j = 0; j < 8; ++j) vn[j] = hr[64 * j];
        pvn = (ln < 16) ? ps[(size_t)gw * 16 + ln] : 0.f; }
#define FN_ROW(m_, more_) do { \
        u32x4 v[8]; const float pv = pvn; \
        _Pragma("unroll") for (int j = 0; j < 8; ++j) v[j] = vn[j]; \
        if (more_) { const GAS u32x4* hr = (const GAS u32x4*)(h + (size_t)((m_) + NGW) * D) + ln; \
            _Pragma("unroll") for (int j = 0; j < 8; ++j) vn[j] = hr[64 * j]; \
            pvn = (ln < 16) ? ps[(size_t)((m_) + NGW) * 16 + ln] : 0.f; } \
        asm volatile("" ::: "memory");        \
        const float rstd = 1.0f / sqrtf(wave_sum(pv) * (1.f / D) + NORM_EPS); \
        GAS f32x4* o = (GAS f32x4*)(out + (size_t)(m_) * D) + 2 * ln; \
        _Pragma("unroll") for (int j = 0; j < 8; ++j) { const f32x4 ga = GL[(64 * j + ln) * 2], gb = GL[(64 * j + ln) * 2 + 1]; \
            o[128 * j] = (f32x4){bf_lo(v[j].x) * rstd * ga.x, bf_hi(v[j].x) * rstd * ga.y, bf_lo(v[j].y) * rstd * ga.z, bf_hi(v[j].y) * rstd * ga.w}; \
            o[128 * j + 1] = (f32x4){bf_lo(v[j].z) * rstd * gb.x, bf_hi(v[j].z) * rstd * gb.y, bf_lo(v[j].w) * rstd * gb.z, bf_hi(v[j].w) * rstd * gb.w}; } } while (0)
    constexpr int RPW = M / (256 * NWAVES);
    if (NGW == 256 * NWAVES) {
#pragma unroll 1
        for (int r0 = 0; r0 < RPW; r0 += 4) {
#pragma unroll
            for (int rr = 0; rr < 4; ++rr) FN_ROW(gw + (r0 + rr) * NGW, r0 + rr + 1 < RPW); }
    } else { for (int m = gw; m < M; m += NGW) FN_ROW(m, m + NGW < M); }
#undef FN_ROW
}
__device__ __forceinline__ void norm_phase_merged(Frame& F, const bf16_t* yp, const bf16_t* ys, const float* gp, const float* gs, bf16_t* dst) {
    const int gw = F.vcu * NWAVES + F.wave, NGW = F.G * NWAVES;
    for (int m = gw; m < M; m += NGW) {
#pragma unroll
        for (int half = 0; half < 2; ++half) {
            const GAS u32x4* src = (const GAS u32x4*)((half ? ys : yp) + (size_t)m * PW) + F.lane; const float* gn = half ? gs : gp;
            u32x4 v[4]; float s = 0.f;
#pragma unroll
            for (int j = 0; j < 4; ++j) { v[j] = src[64 * j];
                const float a0 = bf_lo(v[j].x), a1 = bf_hi(v[j].x), a2 = bf_lo(v[j].y), a3 = bf_hi(v[j].y), a4 = bf_lo(v[j].z), a5 = bf_hi(v[j].z), a6 = bf_lo(v[j].w), a7 = bf_hi(v[j].w);
                s += (a0 * a0 + a1 * a1) + (a2 * a2 + a3 * a3) + (a4 * a4 + a5 * a5) + (a6 * a6 + a7 * a7); }
            const float rstd = 1.0f / sqrtf(wave_sum(s) * (1.f / PW) + NORM_EPS);
            GAS u32x4* o = (GAS u32x4*)(dst + (size_t)m * D + half * PW) + F.lane;
#pragma unroll
            for (int j = 0; j < 4; ++j) { const GAS f32x4* g4 = (const GAS f32x4*)(gn + (64 * j + F.lane) * 8); const f32x4 ga = g4[0], gb = g4[1];
                u32x4 w; w.x = cvt_pk_bf16(bf_lo(v[j].x) * rstd * ga.x, bf_hi(v[j].x) * rstd * ga.y); w.y = cvt_pk_bf16(bf_lo(v[j].y) * rstd * ga.z, bf_hi(v[j].y) * rstd * ga.w);
                w.z = cvt_pk_bf16(bf_lo(v[j].z) * rstd * gb.x, bf_hi(v[j].z) * rstd * gb.y); w.w = cvt_pk_bf16(bf_lo(v[j].w) * rstd * gb.z, bf_hi(v[j].w) * rstd * gb.w);
                o[64 * j] = w; }
        }
    }
}
__device__ __forceinline__ void unpack8(const u32x4 v, float (&f)[8]) { f[0] = bf_lo(v.x); f[1] = bf_hi(v.x); f[2] = bf_lo(v.y); f[3] = bf_hi(v.y); f[4] = bf_lo(v.z); f[5] = bf_hi(v.z); f[6] = bf_lo(v.w); f[7] = bf_hi(v.w); }
__device__ __forceinline__ void pool_diff_phase(Frame& F, const bf16_t* z, bf16_t* d, int first_wg, int n_wg) {
    const int gw = (F.vcu - first_wg) * NWAVES + F.wave, NGW = n_wg * NWAVES;
    if (F.vcu < first_wg || F.vcu >= first_wg + n_wg) return;
    for (int it = gw; it < (M / 32) * 4; it += NGW) {
        const int g = it & 3, run = it >> 2, tok0 = run * 32, t0 = tok0 & (SEQ - 1), w = 2 << g;
        const GAS u32x4* zp = (const GAS u32x4*)(z + (size_t)tok0 * PW + g * PGW) + F.lane;
        GAS u32x4* dp = (GAS u32x4*)(d + (size_t)tok0 * PW + g * PGW) + F.lane;
        float sum[8];
#pragma unroll
        for (int e = 0; e < 8; ++e) sum[e] = 0.f;
        for (int s = 1; s < w; ++s) { if (t0 - s >= 0) { float f[8]; unpack8(zp[-(long)s * (PW / 8)], f);
#pragma unroll
            for (int e = 0; e < 8; ++e) sum[e] += f[e]; } }
        for (int r = 0; r < 32; ++r) {
            const int t = t0 + r; float f[8]; unpack8(zp[(long)r * (PW / 8)], f);
#pragma unroll
            for (int e = 0; e < 8; ++e) sum[e] += f[e];
            const int cnt = (t + 1 < w) ? (t + 1) : w; const float inv = 1.0f / (float)cnt;
            u32x4 o; o.x = cvt_pk_bf16(sum[0] * inv - f[0], sum[1] * inv - f[1]); o.y = cvt_pk_bf16(sum[2] * inv - f[2], sum[3] * inv - f[3]);
            o.z = cvt_pk_bf16(sum[4] * inv - f[4], sum[5] * inv - f[5]); o.w = cvt_pk_bf16(sum[6] * inv - f[6], sum[7] * inv - f[7]);
            dp[(long)r * (PW / 8)] = o;
            if (t - w + 1 >= 0) { float q[8]; unpack8(zp[(long)(r - w + 1) * (PW / 8)], q);
#pragma unroll
                for (int e = 0; e < 8; ++e) sum[e] -= q[e]; }
        }
    }
}

__device__ __forceinline__ void pool_out_phase(Frame& F, const bf16_t* z, bf16_t* ym, const float* scale, float* ps2, int first_wg, int n_wg) {
    const int gw = (F.vcu - first_wg) * NWAVES + F.wave, NGW = n_wg * NWAVES;
    if (F.vcu < first_wg || F.vcu >= first_wg + n_wg) return;
    for (int it = gw; it < (M / 32) * 4; it += NGW) {
        const int g = it & 3, run = it >> 2, tok0 = run * 32, t0 = tok0 & (SEQ - 1), w = 2 << g;
        const GAS u32x4* zp = (const GAS u32x4*)(z + (size_t)tok0 * PW + g * PGW) + F.lane;
        GAS u32x4* yp = (GAS u32x4*)(ym + (size_t)tok0 * D + g * PGW) + F.lane;
        const GAS f32x4* sp = (const GAS f32x4*)(scale + g * PGW + F.lane * 8); const f32x4 sa = sp[0], sb = sp[1];
        const float sc[8] = {sa.x, sa.y, sa.z, sa.w, sb.x, sb.y, sb.z, sb.w};
        float sum[8];
#pragma unroll
        for (int e = 0; e < 8; ++e) sum[e] = 0.f;
        for (int s = 1; s < w; ++s) { if (t0 - s >= 0) { float f[8]; unpack8(zp[-(long)s * (PW / 8)], f);
#pragma unroll
            for (int e = 0; e < 8; ++e) sum[e] += f[e]; } }
        for (int r = 0; r < 32; ++r) {
            const int t = t0 + r; float f[8]; unpack8(zp[(long)r * (PW / 8)], f);
#pragma unroll
            for (int e = 0; e < 8; ++e) sum[e] += f[e];
            const int cnt = (t + 1 < w) ? (t + 1) : w; const float inv = 1.0f / (float)cnt;
            float o[8]; float ss = 0.f;
#pragma unroll
            for (int e = 0; e < 8; ++e) { o[e] = (sum[e] * inv - f[e]) * sc[e]; ss += o[e] * o[e]; }
            u32x4 ov; ov.x = cvt_pk_bf16(o[0], o[1]); ov.y = cvt_pk_bf16(o[2], o[3]); ov.z = cvt_pk_bf16(o[4], o[5]); ov.w = cvt_pk_bf16(o[6], o[7]);
            yp[(long)r * (D / 8)] = ov;
            ss = wave_sum(ss);
            if (F.lane == 0) { ps2[(size_t)(tok0 + r) * 16 + g] = ss; ps2[(size_t)(tok0 + r) * 16 + 4 + g] = 0.f; }
            if (t - w + 1 >= 0) { float q[8]; unpack8(zp[(long)(r - w + 1) * (PW / 8)], q);
#pragma unroll
                for (int e = 0; e < 8; ++e) sum[e] -= q[e]; }
        }
    }
}
constexpr int PST = 65;
__device__ __forceinline__ void s5_tables_group(Frame& F, const Args& a, int g, int part) {
    LAS float* Bre = (LAS float*)(F.lds + RING_OFF);
    LAS float* Bim = Bre + 64 * 16;
    LAS float* Pre = Bim + 64 * 16;
    LAS float* Pim = Pre + 65 * PST;
    LAS float* Cre = Pim + 65 * PST;
    LAS float* Cim = Cre + 16 * PST;
    const int t = F.tid;
    const float dt = expf(a.in[I_LOGDT][g]);
    if (t < 64) {
        const int p = t;
        const float lr = a.in[I_LRE][g * SP + p], li = a.in[I_LIM][g * SP + p];
        const float mag = expf(lr * dt), ang = li * dt;
        const float br = mag * cosf(ang), bi = mag * sinf(ang);
        const float nr = br - 1.0f, ni = bi, den = 1.0f / (lr * lr + li * li);
        const float cr = (nr * lr + ni * li) * den, ci = (ni * lr - nr * li) * den;
        for (int h = 0; h < SH; ++h) { const float xr = a.in[I_BRE][(g * SP + p) * SH + h], xi = a.in[I_BIM][(g * SP + p) * SH + h]; Bre[p * 16 + h] = cr * xr - ci * xi; Bim[p * 16 + h] = cr * xi + ci * xr; }
        float pr = 1.0f, pi = 0.0f;
        for (int k = 0; k <= 64; ++k) { Pre[k * PST + p] = pr; Pim[k * PST + p] = pi; const float qr = pr * br - pi * bi, qi = pr * bi + pi * br; pr = qr; pi = qi; }
        if (part == 0) { float* lp = (float*)(a.ws + WS_LP) + ((size_t)g * SP + p) * 2; lp[0] = Pre[64 * PST + p]; lp[1] = Pim[64 * PST + p]; }
    }
    for (int e = t; e < SH * SP; e += NWAVES * 64) { Cre[(e >> 6) * PST + (e & 63)] = a.in[I_CRE][(size_t)g * SH * SP + e]; Cim[(e >> 6) * PST + (e & 63)] = a.in[I_CIM][(size_t)g * SH * SP + e]; }
    __syncthreads();
    if (part == 0) {
        bf16_t* kl = (bf16_t*)(a.ws + WS_KL) + (size_t)g * 32768;
        for (int ci = t; ci < 64 * 16; ci += NWAVES * 64) {
            const int lag = ci >> 4, hp = ci & 15;
            float acc[16];
#pragma unroll
            for (int h = 0; h < 16; ++h) acc[h] = 0.f;
#pragma unroll 2
            for (int p = 0; p < 64; ++p) {
                const float c1 = Cre[hp * PST + p], c2 = Cim[hp * PST + p], p1 = Pre[lag * PST + p], p2 = Pim[lag * PST + p];
                const float ar = c1 * p1 - c2 * p2, ai = c1 * p2 + c2 * p1;
#pragma unroll
                for (int h4 = 0; h4 < 4; ++h4) { const f32x4 b1 = *(const LAS f32x4*)(Bre + p * 16 + 4 * h4), b2 = *(const LAS f32x4*)(Bim + p * 16 + 4 * h4);
                    acc[4 * h4 + 0] += ar * b1.x - ai * b2.x; acc[4 * h4 + 1] += ar * b1.y - ai * b2.y; acc[4 * h4 + 2] += ar * b1.z - ai * b2.z; acc[4 * h4 + 3] += ar * b1.w - ai * b2.w; }
            }
            if (lag == 0) {
                const float dsk = a.in[I_DSKIP][g * SH + hp];
#pragma unroll
                for (int h = 0; h < 16; ++h) acc[h] += (h == hp) ? dsk : 0.f;
            }
            u32x4 w0, w1; w0.x = pk2(acc[0], acc[1]); w0.y = pk2(acc[2], acc[3]); w0.z = pk2(acc[4], acc[5]); w0.w = pk2(acc[6], acc[7]);
            w1.x = pk2(acc[8], acc[9]); w1.y = pk2(acc[10], acc[11]); w1.z = pk2(acc[12], acc[13]); w1.w = pk2(acc[14], acc[15]);
            GAS u32x4* o = (GAS u32x4*)(kl + (lag + 63) * 256 + hp * 16); o[0] = w0; o[1] = w1;
        }
        const u32x4 zz = {0u, 0u, 0u, 0u};
        for (int e = t; e < 63 * 32; e += NWAVES * 64) ((GAS u32x4*)kl)[e] = zz;
        for (int e = t; e < 32; e += NWAVES * 64) ((GAS u32x4*)(kl + 127 * 256))[e] = zz;
    }
    if (part == 1) {
        bf16_t* wcp = (bf16_t*)(a.ws + WS_WC) + (size_t)g * 1024 * 128;
        for (int e8 = t; e8 < 1024 * 16; e8 += NWAVES * 64) { const int q0 = (e8 & 15) * 8, n = e8 >> 4, j = n >> 4, hp = n & 15, p0 = q0 & 63; const bool im = q0 >= 64;
            float v[8];
#pragma unroll
            for (int x = 0; x < 8; ++x) { const float c1 = Cre[hp * PST + p0 + x], c2 = Cim[hp * PST + p0 + x], p1 = Pre[(j + 1) * PST + p0 + x], p2 = Pim[(j + 1) * PST + p0 + x];
                v[x] = im ? -(c1 * p2 + c2 * p1) : (c1 * p1 - c2 * p2); }
            u32x4 w; w.x = pk2(v[0], v[1]); w.y = pk2(v[2], v[3]); w.z = pk2(v[4], v[5]); w.w = pk2(v[6], v[7]);
            ((GAS u32x4*)wcp)[e8] = w; }
    }
    if (part == 1) {
        bf16_t* wsp = (bf16_t*)(a.ws + WS_WS) + (size_t)g * 128 * 1024;
        for (int e8 = t; e8 < 128 * 128; e8 += NWAVES * 64) { const int k0 = (e8 & 127) * 8, q = e8 >> 7, i = k0 >> 4, h0 = k0 & 15, p = q & 63; const bool im = q >= 64;
            const float p1 = Pre[(63 - i) * PST + p], p2 = Pim[(63 - i) * PST + p];
            float v[8];
#pragma unroll
            for (int x = 0; x < 8; ++x) { const float b1 = Bre[p * 16 + h0 + x], b2 = Bim[p * 16 + h0 + x]; v[x] = im ? (p1 * b2 + p2 * b1) : (p1 * b1 - p2 * b2); }
            u32x4 w; w.x = pk2(v[0], v[1]); w.y = pk2(v[2], v[3]); w.z = pk2(v[4], v[5]); w.w = pk2(v[6], v[7]);
            ((GAS u32x4*)wsp)[e8] = w; }
    }
    __syncthreads();
}

typedef const __attribute__((address_space(4))) Args* KArgsT;
__device__ __forceinline__ void p0_prologue(Frame& F) {
    KArgsT ap0 = (KArgsT)__builtin_amdgcn_kernarg_segment_ptr(); asm volatile("" : "+s"(ap0)); Args a;
#pragma unroll
    for (int i = 0; i < N_IN; ++i) a.in[i] = ap0->in[i];
    a.out = ap0->out; a.ws = ap0->ws; a.ph_lo = 0; a.ph_hi = 0; a.li = 0; a.pad = 0;
#ifndef PRO_REP
#define PRO_REP 0
#endif
    for (int rp = 0; rp <= (PRO_REP & 1); ++rp)
    for (int w = F.vcu; w < 2 * SG; w += F.G) s5_tables_group(F, a, w & (SG - 1), w >> 7);
    __syncthreads();
    LAS TDesc* td = (LAS TDesc*)(F.lds + RING_OFF + RING_BYTES - 1024);
    if (F.tid == 0) {
        int first = 0, k = 0;
#define TD(SRC, DST, K_, N_, RS, RO, GAIN) do { td[k].src = (SRC); td[k].dst = (bf16_t*)(DST); td[k].gain = (GAIN); td[k].gain2 = nullptr; td[k].K = (K_); td[k].N = (N_); td[k].ld = (N_); td[k].pad2 = 0; td[k].rs = (RS); td[k].ro = (RO); td[k].first = first; td[k].pad = (k == 12) ? 1 : ((k == 10 || k == 11) ? 2 : ((k == 0 || k == 1) ? 3 : ((k == 2 && F16 && DOWN1_BF16) ? 4 : 0))); first += ((K_) / 128) * ((N_) / 256); ++k; } while (0)
        TD(a.in[I_G1], a.ws + WS_WGU1, D, FF, 256, 0, nullptr);
        TD(a.in[I_U1], a.ws + WS_WGU1, D, FF, 256, 128, nullptr);
        if (WD_TILED) TD(a.in[I_D1], a.ws + WS_WD1, FF, D, 0, D, nullptr); else TD(a.in[I_D1], a.ws + WS_WD1, FF, D, 128, 0, nullptr);
        if (POOL_PREMUL) { TD(a.in[I_WIN] + PW, a.ws + WS_WIN, D, SW, 128, PW, a.in[I_MIXN]); td[k - 1].ld = D; }
        else TD(a.in[I_WIN], a.ws + WS_WIN, D, D, 128, 0, a.in[I_MIXN]);
        TD(a.in[I_WPOOL] + 0 * PGW * PGW, a.ws + WS_WPOOL + 0 * PGW * PGW * 2, PGW, PGW, 128, 0, nullptr);
        TD(a.in[I_WPOOL] + 1 * PGW * PGW, a.ws + WS_WPOOL + 1 * PGW * PGW * 2, PGW, PGW, 128, 0, nullptr);
        TD(a.in[I_WPOOL] + 2 * PGW * PGW, a.ws + WS_WPOOL + 2 * PGW * PGW * 2, PGW, PGW, 128, 0, nullptr);
        TD(a.in[I_WPOOL] + 3 * PGW * PGW, a.ws + WS_WPOOL + 3 * PGW * PGW * 2, PGW, PGW, 128, 0, nullptr);
        TD(a.in[I_WGLU], a.ws + WS_WGLU, SW, SW, 128, 0, nullptr);
        TD(a.in[I_WOUT], a.ws + WS_WOUT, D, D, 128, 0, a.in[I_PON]); td[k - 1].gain2 = a.in[I_SON];
        TD(a.in[I_G2], a.ws + WS_WGU2, D, FF, 256, 0, a.in[I_N2]);
        TD(a.in[I_U2], a.ws + WS_WGU2, D, FF, 256, 128, a.in[I_N2]);
        if (WD_TILED && !FP8_DOWN2) TD(a.in[I_D2], a.ws + WS_WD2, FF, D, 0, D, nullptr); else TD(a.in[I_D2], a.ws + WS_WD2, FF, D, 128, 0, nullptr);
#undef TD
        ((LAS int*)(td + N_TDESC))[0] = first;
    }
    __syncthreads();
    const int nitems = ((LAS int*)(td + N_TDESC))[0];
    LAS unsigned* T = (LAS unsigned*)(F.lds + RING_OFF);
    for (int rp = 0; rp <= ((PRO_REP >> 1) & 1); ++rp) {
    f32x4 vn[16];
    int it = F.vcu;
#define TD_FIND(IT, KK) do { KK = 0; _Pragma("unroll") for (int q_ = 1; q_ < N_TDESC; ++q_) KK += ((IT) >= td[q_].first) ? 1 : 0; } while (0)
    if (it < nitems) { int k; TD_FIND(it, k); p0_item_load(td[k].src, td[k].ld, it - td[k].first, P0_DIM(td[k].K, td[k].N), F.wave, F.lane, vn); }
    for (; it < nitems; it += F.G) {
        f32x4 vc[16];
#pragma unroll
        for (int r = 0; r < 16; ++r) vc[r] = vn[r];
        const int nx = it + F.G;
        if (nx < nitems) { int k; TD_FIND(nx, k); p0_item_load(td[k].src, td[k].ld, nx - td[k].first, P0_DIM(td[k].K, td[k].N), F.wave, F.lane, vn); }
        int k; TD_FIND(it, k);
        if ((INT8_GU2 == 2 && td[k].pad == 2) || (INT8_GU1 && td[k].pad == 3)) p0_item_store_i8(vc, td[k].K, (unsigned char*)td[k].dst, td[k].gain, td[k].rs, td[k].ro, it - td[k].first, P0_DIM(td[k].K, td[k].N), T, F.tid, F.wave, F.lane);
        else if (FP8_DOWN2 && td[k].pad == 1) p0_item_store_fp8(vc, td[k].K, (unsigned char*)td[k].dst, it - td[k].first, P0_DIM(td[k].K, td[k].N), T, F.tid, F.wave, F.lane);
        else { const int itl = it - td[k].first, nblk = P0_DIM(td[k].K, td[k].N); const float* gn = td[k].gain; if (td[k].gain2 && 128 * (P0_KFAST ? itl % nblk : itl / nblk) >= td[k].K / 2) gn = td[k].gain2 - td[k].K / 2;
            p0_item_store(vc, td[k].K, td[k].dst, gn, td[k].rs, td[k].ro, itl, nblk, T, F.tid, F.wave, F.lane, td[k].pad); }
    }
    }
#undef TD_FIND
    for (int rp = 0; rp <= ((PRO_REP >> 2) & 1); ++rp)
    if (POOL_PREMUL) {
        const int gt = F.vcu * (NWAVES * 64) + F.tid, NT = F.G * NWAVES * 64; const float* wi = a.in[I_WIN]; bf16_t* wp = (bf16_t*)(a.ws + WS_WINP);
        for (int e = gt; e < D * (PW / 8); e += NT) { const int k = e >> 8, c8 = e & 255; const f32x4 v0 = __builtin_nontemporal_load((const f32x4*)(wi + (size_t)k * D + c8 * 8)), v1 = __builtin_nontemporal_load((const f32x4*)(wi + (size_t)k * D + c8 * 8 + 4));
            u32x4 w; w.x = cvt_pk_bf16(v0.x, v0.y); w.y = cvt_pk_bf16(v0.z, v0.w); w.z = cvt_pk_bf16(v1.x, v1.y); w.w = cvt_pk_bf16(v1.z, v1.w); *(GAS u32x4*)(wp + (size_t)k * PW + c8 * 8) = w; } }
    if (INT8_GU1) norm_phase_i8(F, a.in[I_X], a.in[I_N1], a.ws + WS_XN); else
    norm_phase_bf16(F, a.in[I_X], a.in[I_N1], (bf16_t*)(a.ws + WS_XN));
}

constexpr int N_PHASES = 14;
__global__ void __launch_bounds__(NWAVES * 64, 2) fwd_kernel(Args args) {
    extern __shared__ __attribute__((aligned(16))) unsigned char lds[];
    Frame F;
    F.lds = (LAS unsigned char*)lds;
    F.MISC = (volatile LAS unsigned*)(F.lds + MISC_OFF);
    F.tid = threadIdx.x; F.lane = F.tid & 63; F.wave = __builtin_amdgcn_readfirstlane(F.tid >> 6);
    F.G = gridDim.x; { const int bx = blockIdx.x; F.vcu = (F.G % 8 == 0) ? (bx % 8) * (F.G / 8) + bx / 8 : bx; }
    typedef const __attribute__((address_space(4))) Args* KArgs;
#define FRESH_ARGS() KArgs ap = (KArgs)__builtin_amdgcn_kernarg_segment_ptr(); asm volatile("" : "+s"(ap)); unsigned char* const ws = ap->ws; (void)ws
    int lo, hi;
    { FRESH_ARGS(); F.ctl = (unsigned*)(ws + WS_CTL); lo = ap->ph_lo; hi = ap->ph_hi; }
    for (int u = F.tid; u < (LDS_BYTES - LDSCTL_OFF) / 4; u += NWAVES * 64) ((LAS unsigned*)(F.lds + LDSCTL_OFF))[u] = 0u;
    __syncthreads();
    XcdBarrier bar; bar.bar = F.ctl + CW_BAR; bar.x = 0; bar.st = nullptr;
    if (MK_N_LAUNCHES == 1) bar = xcd_barrier_post(F.ctl + CW_BAR, F.MISC + 8);
#define GRID_BAR() do { if (MK_N_LAUNCHES == 1) xcd_barrier(bar); } while (0)
#ifndef PH_MASK
#define PH_MASK 0x3fff
#endif
#define IN(k) (((PH_MASK >> (k)) & 1) && lo <= (k) && (k) < hi)
#define BOTH(k) (IN(k) && IN((k) + 1))
#define XN ((bf16_t*)(ws + WS_XN))
#define HB ((bf16_t*)(ws + WS_H))
#define ZPOOL ((bf16_t*)(ws + WS_ZPOOL))
#define AS5 ((bf16_t*)(ws + WS_AS5))
#define DPOOL ((bf16_t*)(ws + WS_DPOOL))
#define YB ((bf16_t*)(ws + WS_Y))
#define YPOOL ((bf16_t*)(ws + WS_YPOOL))
#define YSSM ((bf16_t*)(ws + WS_YSSM))
#define X1 ((bf16_t*)(ws + WS_X1))
#define X2 ((bf16_t*)(ws + WS_X2))
#define PS ((float*)(ws + WS_PS))
    const int bx = (int)blockIdx.x;
#ifndef WGM_DOWN
#define WGM_DOWN 2
#endif
#ifndef WGM_GU
#define WGM_GU 8
#endif
#ifndef REP_MASK
#define REP_MASK 0
#endif
#define PHASE(k) if (IN(k)) for (int rep_ = 0; rep_ <= ((REP_MASK >> (k)) & 1); ++rep_)
#define SEAM(k) if (BOTH(k)) GRID_BAR()
    PHASE(0) { FRESH_ARGS(); p0_prologue(F); } SEAM(0);
    PHASE(1) { FRESH_ARGS(); pg8::PlainGemm P;
        if (INT8_GU1) P.init(XN, ws + WS_WGU1, M, 2 * FF, D / 2, D / 2, D / 2, F.G, bx, WGM_GU); else P.init(XN, ws + WS_WGU1, M, 2 * FF, D, D, D, F.G, bx);
        pg8::EpiSwiGLU<false, false, INT8_GU1 != 0, (F16 && DOWN1_BF16)> E{HB, nullptr, -1, INT8_GU1 ? 1.0f / (AQ1_SCALE * WQ_SCALE) : 1.0f};
        pg8::gemm_phase<pg8::EpiSwiGLU<false, false, INT8_GU1 != 0, (F16 && DOWN1_BF16)>, pg8::PlainGemm, PG8_ALIGN, PG8_SP2, INT8_GU1 ? 2 : 0>(F.lds + RING_OFF, P, E);
        if (POOL_PREMUL) {
            __syncthreads();
            const int half = F.G / 2; const bool tailidle = (F.G == 256);
            pg8::CombGemm C; C.init(ws + WS_WPOOL, ws + WS_WINP, tailidle ? half : F.G, tailidle ? (bx >= half ? bx - half : -1) : bx); pg8::EpiComb EC{(bf16_t*)(ws + WS_WIN), ap->in[I_MIXN]};
            pg8::gemm_phase<pg8::EpiComb, pg8::CombGemm, PG8_ALIGN, PG8_SP2>(F.lds + RING_OFF, C, EC); } } SEAM(1);
    PHASE(2) { FRESH_ARGS(); pg8::PlainGemm P; if (H_TILED && WD_TILED) P.init_tiledAB(HB, ws + WS_WD1, M, D, FF, F.G, bx, WGM_DOWN); else if (H_TILED) P.init_tiledA(HB, ws + WS_WD1, M, D, FF, FF, F.G, bx, WGM_DOWN); else P.init(HB, ws + WS_WD1, M, D, FF, FF, FF, F.G, bx, WGM_DOWN); if (DOWN_REVK) P.reverse_k(); pg8::EpiResNorm<true> E{ap->in[I_X], 0.5f, X1, PS, nullptr};
        pg8::gemm_phase<pg8::EpiResNorm<true>, pg8::PlainGemm, PG8_ALIGN, PG8_SP2, (F16 && DOWN1_BF16) ? 3 : 0>(F.lds + RING_OFF, P, E); } SEAM(2);
    PHASE(4) { FRESH_ARGS(); pg8::PlainGemm P; P.init(X1, ws + WS_WIN, M, D, D, D, D, F.G, bx); pg8::Unit u0; const int pm0 = P.next(0, u0) ? u0.pm : -1; pg8::rstd_table(PS, pm0, F.lds, F.tid); pg8::EpiZ E{ZPOOL, AS5, PS, pm0};
        pg8::gemm_phase<pg8::EpiZ, pg8::PlainGemm, PG8_ALIGN, PG8_SP2>(F.lds + RING_OFF, P, E); } SEAM(4);
    PHASE(5) { FRESH_ARGS();
        const bool split = (F.G == 2 * SG);
        if (POOL_PREMUL) { if (split) pool_out_phase(F, ZPOOL, XN, ap->in[I_PSCALE], (float*)(ws + WS_PS2), SG, F.G - SG); else pool_out_phase(F, ZPOOL, XN, ap->in[I_PSCALE], (float*)(ws + WS_PS2), 0, F.G); }
        else if (split) pool_diff_phase(F, ZPOOL, DPOOL, SG, F.G - SG); else pool_diff_phase(F, ZPOOL, DPOOL, 0, F.G);
        VM_WAIT(); __syncthreads();
        pg8::S5CarryGemm P; P.init(AS5, ws + WS_WS, split ? SG : F.G, split ? (F.vcu < SG ? F.vcu : SG) : bx); pg8::EpiCarry E{AS5, (const float*)(ws + WS_LP)};
        pg8::gemm_phase<pg8::EpiCarry, pg8::S5CarryGemm, false, PG8_SP2>(F.lds + RING_OFF, P, E); __syncthreads(); } SEAM(5);
    PHASE(6) { FRESH_ARGS(); if (!POOL_PREMUL) { pg8::PoolGemm P; P.init(DPOOL, ws + WS_WPOOL, F.G, bx); pg8::EpiPool E{XN, ap->in[I_PSCALE], (float*)(ws + WS_PS2)};
          pg8::gemm_phase<pg8::EpiPool, pg8::PoolGemm, PG8_ALIGN, PG8_SP2>(F.lds + RING_OFF, P, E); }
        { pg8::S5OutGemm P; P.init(AS5, ws + WS_KL, ws + WS_WC, F.G, bx); pg8::EpiS5Y E{YB};
          pg8::gemm_phase<pg8::EpiS5Y, pg8::S5OutGemm, PG8_ALIGN, PG8_SP2>(F.lds + RING_OFF, P, E); } } SEAM(6);
    PHASE(7) { FRESH_ARGS(); pg8::PlainGemm P; P.init(YB, ws + WS_WGLU, M, SW, SW, SW, SW, F.G, bx); pg8::EpiGLU E{YB, XN, ap->in[I_BGLU], (float*)(ws + WS_PS2)};
        pg8::gemm_phase<pg8::EpiGLU, pg8::PlainGemm, PG8_ALIGN, PG8_SP2>(F.lds + RING_OFF, P, E); } SEAM(7);
    PHASE(9) { FRESH_ARGS(); pg8::PlainGemm P; P.init(XN, ws + WS_WOUT, M, D, D, D, D, F.G, bx); P.tmid = PW / pg8::BK;
        pg8::Unit u0; const int pm0 = P.next(0, u0) ? u0.pm : -1; pg8::rstd2_table((const float*)(ws + WS_PS2), pm0, F.lds, F.tid);
        pg8::EpiResNorm<false, INT8_GU2, true> E{X1, 1.0f, X2, PS, ws + WS_X2Q};
        pg8::gemm_phase<pg8::EpiResNorm<false, INT8_GU2, true>, pg8::PlainGemm, PG8_ALIGN, PG8_SP2>(F.lds + RING_OFF, P, E); } SEAM(9);
    PHASE(11) { FRESH_ARGS(); pg8::PlainGemm P;
        if (INT8_GU2 == 2) P.init(ws + WS_X2Q, ws + WS_WGU2, M, 2 * FF, D / 2, D / 2, D / 2, F.G, bx, WGM_GU);
        else P.init(INT8_GU2 == 1 ? (bf16_t*)(ws + WS_X2Q) : X2, ws + WS_WGU2, M, 2 * FF, D, D, D, F.G, bx);
        pg8::Unit u0; const int pm0 = P.next(0, u0) ? u0.pm : -1; pg8::rstd_table(PS, pm0, F.lds, F.tid);
        pg8::EpiSwiGLU<true, FP8_DOWN2 != 0, INT8_GU2 == 2> E{HB, PS, pm0, INT8_GU2 ? 1.0f / (AQ_SCALE * WQ_SCALE) : 1.0f};
        pg8::gemm_phase<pg8::EpiSwiGLU<true, FP8_DOWN2 != 0, INT8_GU2 == 2>, pg8::PlainGemm, PG8_ALIGN, PG8_SP2, INT8_GU2 == 2 ? 2 : 0>(F.lds + RING_OFF, P, E); } SEAM(11);
#if FP8_DOWN2
    PHASE(12) { FRESH_ARGS(); pg8::PlainGemm P; P.init_tiledA(HB, ws + WS_WD2, M, D, FF / 2, FF / 2, F.G, bx, WGM_DOWN); pg8::EpiResNorm<false> E{X2, 0.5f / (H8_SCALE * W8_SCALE), X1, PS, nullptr};
        pg8::gemm_phase<pg8::EpiResNorm<false>, pg8::PlainGemm, PG8_ALIGN, PG8_SP2, 1>(F.lds + RING_OFF, P, E); } SEAM(12);
#else
    PHASE(12) { FRESH_ARGS(); pg8::PlainGemm P; if (H_TILED && WD_TILED) P.init_tiledAB(HB, ws + WS_WD2, M, D, FF, F.G, bx, WGM_DOWN); else if (H_TILED) P.init_tiledA(HB, ws + WS_WD2, M, D, FF, FF, F.G, bx, WGM_DOWN); else P.init(HB, ws + WS_WD2, M, D, FF, FF, FF, F.G, bx, WGM_DOWN); if (DOWN_REVK) P.reverse_k(); pg8::EpiResNorm<false> E{X2, 0.5f, X1, PS, nullptr};
        pg8::gemm_phase<pg8::EpiResNorm<false>, pg8::PlainGemm, PG8_ALIGN, PG8_SP2>(F.lds + RING_OFF, P, E); } SEAM(12);
#endif
    PHASE(13) { FRESH_ARGS(); norm_phase_final(F, X1, PS, ap->in[I_FN], ap->out); }
#undef PHASE
#undef SEAM
#undef IN
#undef BOTH
#undef FRESH_ARGS
#undef GRID_BAR
}

extern "C" void kernel_launch(void* const* d_in, const int* in_sizes, int n_in, void* d_out, int out_size, void* d_ws, size_t ws_size, hipStream_t stream) {
    static int grid = 0;
    if (grid == 0) {
        if (n_in != N_IN || in_sizes[0] != M * D || out_size != M * D || ws_size < WS_END) { fprintf(stderr, "kernel_launch: unexpected shapes (n_in %d, in0 %d, out %d, ws %zu)\n", n_in, n_in > 0 ? in_sizes[0] : -1, out_size, ws_size); grid = -1; return; }
        int dev = 0, cus = 0, per_cu = 0;
        if (hipGetDevice(&dev) != hipSuccess || hipDeviceGetAttribute(&cus, hipDeviceAttributeMultiprocessorCount, dev) != hipSuccess) { grid = -1; return; }
        if (hipFuncSetAttribute((const void*)fwd_kernel, hipFuncAttributeMaxDynamicSharedMemorySize, LDS_BYTES) != hipSuccess) { fprintf(stderr, "kernel_launch: hipFuncSetAttribute failed\n"); grid = -1; return; }
        if (hipOccupancyMaxActiveBlocksPerMultiprocessor(&per_cu, (const void*)fwd_kernel, NWAVES * 64, LDS_BYTES) != hipSuccess || per_cu < 1) fprintf(stderr, "kernel_launch: occupancy query says %d\n", per_cu);
        (void)hipGetLastError();
        grid = cus;
    }
    if (grid < 0) return;
    if (hipMemsetAsync((char*)d_ws + WS_CTL, 0, CTL_ZERO_BYTES, stream) != hipSuccess) return;
    Args a{};
    for (int i = 0; i < N_IN; ++i) a.in[i] = (const float*)d_in[i];
    a.out = (float*)d_out; a.ws = (unsigned char*)d_ws; a.pad = 0;
    if (MK_N_LAUNCHES == 1) { a.ph_lo = 0; a.ph_hi = N_PHASES; a.li = 0; hipLaunchKernelGGL(fwd_kernel, dim3(grid), dim3(NWAVES * 64), LDS_BYTES, stream, a); }
    else for (int p = 0; p < N_PHASES; ++p) { a.ph_lo = p; a.ph_hi = p + 1; a.li = p; hipLaunchKernelGGL(fwd_kernel, dim3(grid), dim3(NWAVES * 64), LDS_BYTES, stream, a); }
}
```

```cpp
#include <hip/hip_runtime.h>
#include <cstdio>
#include <cstdint>

#define LAS __attribute__((address_space(3)))
#define GAS __attribute__((address_space(1)))
typedef unsigned short bf16_t;
typedef short bf16x8 __attribute__((ext_vector_type(8)));
typedef float f32x4 __attribute__((ext_vector_type(4)));
typedef float f32x2 __attribute__((ext_vector_type(2)));
typedef unsigned u32x4 __attribute__((ext_vector_type(4)));
typedef unsigned u32x2 __attribute__((ext_vector_type(2)));

#ifndef MK_N_LAUNCHES
#define MK_N_LAUNCHES 1
#endif
#ifndef PG8_SP2
#define PG8_SP2 true
#endif
#ifndef PG8_ALIGN
#define PG8_ALIGN true
#endif
#ifndef EPI_TWICE
#define EPI_TWICE 0
#endif
#ifndef DUP_MFMA
#define DUP_MFMA 0
#endif
#ifndef PG8_SPLIT
#define PG8_SPLIT 0
#endif
#ifndef ONE_PRIO_SPAN
#define ONE_PRIO_SPAN 1
#endif
#ifndef MMA_NM
#define MMA_NM 1
#endif
#ifndef MMA_PIN
#define MMA_PIN 1
#endif

constexpr int BATCH = 8, SEQ = 2048, D = 4096, M = BATCH * SEQ, FF = 11008;
constexpr int PW = 2048, SW = 2048, PGW = 512;
constexpr int SG = 128, SH = 16, SP = 64;
constexpr int CL = 64, CR = M / CL;
constexpr int AK = CL * SH + 2 * SP;
constexpr float NORM_EPS = 1e-6f;

constexpr size_t MiB = 1u << 20;
constexpr size_t WS_CTL = 0, CTL_ZERO_BYTES = 65536;
constexpr size_t WS_WGU1 = 1 * MiB, WS_WD1 = 173 * MiB, WS_WGU2 = 259 * MiB, WS_WD2 = 431 * MiB;
constexpr size_t WS_WIN = 517 * MiB, WS_WOUT = 549 * MiB, WS_WGLU = 581 * MiB, WS_WPOOL = 589 * MiB;
constexpr size_t WS_KL = 591 * MiB;
constexpr size_t WS_WC = 599 * MiB;
constexpr size_t WS_WS = 631 * MiB;
constexpr size_t WS_LP = 663 * MiB;
constexpr size_t WS_XN = 664 * MiB;
constexpr size_t WS_H = 792 * MiB;
constexpr size_t WS_ZPOOL = 792 * MiB;
constexpr size_t WS_AS5 = 856 * MiB;
constexpr size_t WS_DPOOL = 928 * MiB;
constexpr size_t WS_Y = 992 * MiB;
constexpr size_t WS_YPOOL = 1056 * MiB;
constexpr size_t WS_YSSM = WS_ZPOOL;
constexpr size_t WS_X2Q = 88 * MiB;
constexpr size_t WS_X2Q_OLD = 968 * MiB;
constexpr size_t WS_X1 = 1136 * MiB;
constexpr size_t WS_X2 = 1264 * MiB;
constexpr size_t WS_PS = 1392 * MiB;
constexpr size_t WS_PS2 = 1394 * MiB;
constexpr size_t WS_WINP = 1396 * MiB;
constexpr size_t WS_END = 1412 * MiB;
static_assert(WS_H + (size_t)M * FF * 2 <= WS_X1 && WS_YPOOL + (size_t)M * PW * 2 <= WS_H + (size_t)M * FF * 2, "ws map");
constexpr int CW_TMO = 0, CW_CODE = 1, CW_BAR = 4096;

constexpr int RING_OFF = 0, RING_BYTES = 131072;
constexpr int LDSCTL_OFF = RING_BYTES, MISC_OFF = LDSCTL_OFF + 320;
constexpr int LDS_BYTES = 147456;
constexpr int EPI_LDS_OFF = RING_BYTES + 1024;
constexpr int NWAVES = 8;

#define RLX_AGENT __ATOMIC_RELAXED, __HIP_MEMORY_SCOPE_AGENT
#define LDS_WAIT() asm volatile("s_waitcnt lgkmcnt(0)" ::: "memory")
#define VM_WAIT() asm volatile("s_waitcnt vmcnt(0)" ::: "memory")
#ifndef F16
#define F16 1
#endif
typedef _Float16 f16x2 __attribute__((ext_vector_type(2)));
typedef _Float16 f16x8 __attribute__((ext_vector_type(8)));
__device__ __forceinline__ unsigned cvt_pk_truebf16(float lo, float hi) { unsigned r; asm volatile("v_cvt_pk_bf16_f32 %0, %1, %2" : "=v"(r) : "v"(lo), "v"(hi)); return r; }
#ifndef DOWN1_BF16
#define DOWN1_BF16 1
#endif
#if F16
__device__ __forceinline__ unsigned cvt_pk_bf16(float lo, float hi) { return __builtin_bit_cast(unsigned, __builtin_convertvector((f32x2){lo, hi}, f16x2)); }
__device__ __forceinline__ unsigned f2bf(float f) { return (unsigned)__builtin_bit_cast(unsigned short, (_Float16)f); }
__device__ __forceinline__ unsigned pk2(float lo, float hi) { return cvt_pk_bf16(lo, hi); }
__device__ __forceinline__ float bf_lo(unsigned w) { return (float)__builtin_bit_cast(f16x2, w).x; }
__device__ __forceinline__ float bf_hi(unsigned w) { return (float)__builtin_bit_cast(f16x2, w).y; }
#else
__device__ __forceinline__ unsigned cvt_pk_bf16(float lo, float hi) { unsigned r; asm volatile("v_cvt_pk_bf16_f32 %0, %1, %2" : "=v"(r) : "v"(lo), "v"(hi)); return r; }
__device__ __forceinline__ unsigned f2bf(float f) { unsigned u = __builtin_bit_cast(unsigned, f); return (u + 0x7fffu + ((u >> 16) & 1u)) >> 16; }
__device__ __forceinline__ unsigned pk2(float lo, float hi) { return f2bf(lo) | (f2bf(hi) << 16); }
__device__ __forceinline__ float bf_lo(unsigned w) { return __builtin_bit_cast(float, w << 16); }
__device__ __forceinline__ float bf_hi(unsigned w) { return __builtin_bit_cast(float, w & 0xffff0000u); }
#endif
#ifndef EMU_FP8
#define EMU_FP8 0
#endif
#ifndef INT8_GU1
#define INT8_GU1 1
#endif
#ifndef INT8_GU2
#define INT8_GU2 2
#endif
#ifndef FP8_DOWN2
#define FP8_DOWN2 1
#endif
__device__ __forceinline__ float q8(float x) { unsigned u = __builtin_bit_cast(unsigned, x); u += 0x7FFFFu + ((u >> 20) & 1u); u &= 0xFFF00000u; return __builtin_bit_cast(float, u); }
__device__ __forceinline__ float clamp448(float x) { return __builtin_fminf(__builtin_fmaxf(x, -448.f), 448.f); }
__device__ __forceinline__ unsigned pk4_fp8(float a, float b, float c, float d) { int r = 0; r = __builtin_amdgcn_cvt_pk_fp8_f32(clamp448(a), clamp448(b), r, false); r = __builtin_amdgcn_cvt_pk_fp8_f32(clamp448(c), clamp448(d), r, true); return (unsigned)r; }
static_assert(INT8_GU1 == 1 && INT8_GU2 == 2, "WS_X2Q placement assumes int8 FFN1 gate/up weights and a 64 MiB int8 h2");
constexpr float H8_SCALE = 8.0f, W8_SCALE = 4096.0f;
constexpr float AQ1_SCALE = 31.75f;
constexpr float AQ_SCALE = 21.96f, WQ_SCALE = 2032.0f;
__device__ __forceinline__ unsigned pk4_i8(float a, float b, float c, float d) { const int ia = (int)__builtin_rintf(__builtin_fminf(__builtin_fmaxf(a, -127.f), 127.f)), ib = (int)__builtin_rintf(__builtin_fminf(__builtin_fmaxf(b, -127.f), 127.f)), ic = (int)__builtin_rintf(__builtin_fminf(__builtin_fmaxf(c, -127.f), 127.f)), id = (int)__builtin_rintf(__builtin_fminf(__builtin_fmaxf(d, -127.f), 127.f));
    return ((unsigned)ia & 0xffu) | (((unsigned)ib & 0xffu) << 8) | (((unsigned)ic & 0xffu) << 16) | ((unsigned)id << 24); }
__device__ __forceinline__ float qint8(float x) { return __builtin_rintf(__builtin_fminf(__builtin_fmaxf(x, -127.f), 127.f)); }
__device__ __forceinline__ float fast_sigmoid(float x) { return __builtin_amdgcn_rcpf(1.0f + __builtin_amdgcn_exp2f(-1.4426950408889634f * x)); }
__device__ __forceinline__ float silu_f(float x) { return x * fast_sigmoid(x); }
__device__ __forceinline__ float gelu_tanh_f(float x) { const float z = 0.7978845608028654f * (x + 0.044715f * x * x * x); return x * fast_sigmoid(2.0f * z); }
__device__ __forceinline__ float wave_sum(float v) {
#pragma unroll
    for (int o = 1; o < 64; o <<= 1) v += __shfl_xor(v, o);
    return v;
}

namespace pg8 {
constexpr int BM = 256, BK = 64, HALF = 128, HTB = HALF * BK * 2, STAGE_BYTES = 8 * HTB, NXCD = 8, WGM = 8;
__host__ __device__ __forceinline__ int lds_byte(int r, int c) { const int st = (r >> 4) * 2 + (c >> 5), rr = r & 15, cc = c & 31, ob = rr * 64 + cc * 2; return st * 1024 + (ob ^ (((ob >> 9) & 1) << 5)); }
__host__ __device__ __forceinline__ void stage_rc(int b, int& R, int& C) { const int st = b / 1024, sb = b % 1024, swz = sb ^ (((sb >> 9) & 1) << 5); R = (st >> 1) * 16 + swz / 64; C = (st & 1) * 32 + (swz % 64) / 2; }
__host__ __device__ __forceinline__ int perm32(int rho) { const int n = rho >> 4, i = rho & 15; return 8 * (i >> 2) + 4 * n + (i & 3); }

struct Unit { int pm, pn, g; };

struct TileOrder {
    int nM, nN, nwg, G, c, wgm;
    __device__ __forceinline__ void init(int Mr, int Nc, int G_, int c_, int wgm_) { nM = Mr / BM; nN = Nc / BM; nwg = nM * nN; G = G_; c = c_; wgm = wgm_; }
    __device__ __forceinline__ bool next(int i, Unit& u) const {
        const long L = (long)i * G + c; if (L >= nwg) return false;
        int wgid = (int)L; { const int q = nwg / NXCD, r = nwg % NXCD, xcd = wgid % NXCD, off = wgid / NXCD; wgid = (xcd < r ? xcd * (q + 1) : r * (q + 1) + (xcd - r) * q) + off; }
        const int nig = wgm * nN, gid = wgid / nig, fm = gid * wgm, gsz = (nM - fm) < wgm ? (nM - fm) : wgm;
        u.pm = fm + ((wgid % nig) % gsz); u.pn = (wgid % nig) / gsz; u.g = 0; return true;
    }
};

struct PlainGemm {
    static constexpr bool TWOSEG = false, KSKIP = false;
    int tmid = -1;
    const char* A; const char* Bt; int lda, ldb; int nt; long kstepA, kstepB, hstepA, hstepB; TileOrder ord;
    __device__ __forceinline__ void init(const void* A_, const void* Bt_, int Mr, int Nc, int K, int lda_, int ldb_, int G, int c, int wgm = WGM) {
        A = (const char*)A_; Bt = (const char*)Bt_; lda = lda_; ldb = ldb_; nt = K / BK; kstepA = kstepB = BK * 2; hstepA = (long)HALF * lda * 2; hstepB = (long)HALF * ldb * 2; ord.init(Mr, Nc, G, c, wgm); }
    __device__ __forceinline__ void init_tiledA(const void* A_, const void* Bt_, int Mr, int Nc, int K, int ldb_, int G, int c, int wgm) {
        init(A_, Bt_, Mr, Nc, K, 64, ldb_, G, c, wgm); kstepA = (long)Mr * 64 * 2; hstepA = (long)HALF * 64 * 2; }
    __device__ __forceinline__ void init_tiledAB(const void* A_, const void* Bt_, int Mr, int Nc, int K, int G, int c, int wgm) {
        init(A_, Bt_, Mr, Nc, K, 64, 64, G, c, wgm); kstepA = (long)Mr * 64 * 2; hstepA = (long)HALF * 64 * 2; kstepB = (long)Nc * 64 * 2; hstepB = (long)HALF * 64 * 2; }
    __device__ __forceinline__ void reverse_k() { A += (long)(nt - 1) * kstepA; Bt += (long)(nt - 1) * kstepB; kstepA = -kstepA; kstepB = -kstepB; }
    __device__ __forceinline__ bool next(int i, Unit& u) const { return ord.next(i, u); }
    __device__ __forceinline__ const char* a_base(const Unit& u) const { return A + (size_t)u.pm * 2 * hstepA; }
    __device__ __forceinline__ const char* b_base(const Unit& u) const { return Bt + (size_t)u.pn * 2 * hstepB; }
    __device__ __forceinline__ unsigned voffA(int R, int C) const { return (unsigned)(R * lda + C) * 2u; }
    __device__ __forceinline__ unsigned voffB(int R, int C) const { return (unsigned)(R * ldb + C) * 2u; }
    int ks; long kstepB2, hstepB2;
    __device__ __forceinline__ const char* b_base2(const Unit&) const { return Bt; }
    __device__ __forceinline__ unsigned voffB2(int, int) const { return 0u; }
};
struct PoolGemm {
    static constexpr int tmid = -1;
    static constexpr bool TWOSEG = false, KSKIP = false;
    const char* A; const char* Bt; int nt; long kstepA, kstepB, hstepA, hstepB; int G, c;
    __device__ __forceinline__ void init(const void* A_, const void* Bt_, int G_, int c_) { A = (const char*)A_; Bt = (const char*)Bt_; nt = PGW / BK; kstepA = kstepB = BK * 2; hstepA = (long)HALF * PW * 2; hstepB = (long)HALF * PGW * 2; G = G_; c = c_; }
    __device__ __forceinline__ bool next(int i, Unit& u) const { const int L = i * G + c; if (L >= 512) return false; u.pm = L >> 3; u.g = (L >> 1) & 3; u.pn = L & 1; return true; }
    __device__ __forceinline__ const char* a_base(const Unit& u) const { return A + ((size_t)u.pm * BM * PW + (size_t)u.g * PGW) * 2; }
    __device__ __forceinline__ const char* b_base(const Unit& u) const { return Bt + ((size_t)u.g * PGW * PGW + (size_t)u.pn * BM * PGW) * 2; }
    __device__ __forceinline__ unsigned voffA(int R, int C) const { return (unsigned)(R * PW + C) * 2u; }
    __device__ __forceinline__ unsigned voffB(int R, int C) const { return (unsigned)(R * PGW + C) * 2u; }
    int ks; long kstepB2, hstepB2;
    __device__ __forceinline__ const char* b_base2(const Unit&) const { return Bt; }
    __device__ __forceinline__ unsigned voffB2(int, int) const { return 0u; }
};
struct CombGemm {
    static constexpr bool TWOSEG = false, KSKIP = false; static constexpr int tmid = -1;
    const char* A; const char* Bt; int nt; long kstepA, kstepB, hstepA, hstepB; int G, c;
    __device__ __forceinline__ void init(const void* A_, const void* Bt_, int G_, int c_) { A = (const char*)A_; Bt = (const char*)Bt_; nt = PGW / BK; kstepA = kstepB = BK * 2; hstepA = (long)HALF * PGW * 2; hstepB = (long)HALF * PW * 2; G = G_; c = c_; }
    __device__ __forceinline__ bool next(int i, Unit& u) const { const int L = i * G + c; if (c < 0 || L >= 128) return false; u.g = L >> 5; u.pm = (L >> 4) & 1; u.pn = L & 15; return true; }
    __device__ __forceinline__ const char* a_base(const Unit& u) const { return A + ((size_t)u.g * PGW * PGW + (size_t)u.pm * BM * PGW) * 2; }
    __device__ __forceinline__ const char* b_base(const Unit& u) const { return Bt + ((size_t)u.pn * BM * PW + (size_t)u.g * PGW) * 2; }
    __device__ __forceinline__ unsigned voffA(int R, int C) const { return (unsigned)(R * PGW + C) * 2u; }
    __device__ __forceinline__ unsigned voffB(int R, int C) const { return (unsigned)(R * PW + C) * 2u; }
    int ks; long kstepB2, hstepB2;
    __device__ __forceinline__ const char* b_base2(const Unit&) const { return Bt; }
    __device__ __forceinline__ unsigned voffB2(int, int) const { return 0u; }
};
struct S5CarryGemm {
    static constexpr int tmid = -1;
    static constexpr bool TWOSEG = false, KSKIP = false;
    const char* A; const char* Bt; int nt; long kstepA, kstepB, hstepA, hstepB; int G, c;
    __device__ __forceinline__ void init(const void* A_, const void* Bt_, int G_, int c_) { A = (const char*)A_; Bt = (const char*)Bt_; nt = (CL * SH) / BK; kstepA = kstepB = BK * 2; hstepA = (long)HALF * AK * 2; hstepB = 0; G = G_; c = c_; }
    __device__ __forceinline__ bool next(int i, Unit& u) const { const int L = i * G + c; if (L >= SG) return false; u.pm = 0; u.pn = 0; u.g = L; return true; }
    __device__ __forceinline__ const char* a_base(const Unit& u) const { return A + (size_t)u.g * CR * AK * 2; }
    __device__ __forceinline__ const char* b_base(const Unit& u) const { return Bt + (size_t)u.g * 128 * 1024 * 2; }
    __device__ __forceinline__ unsigned voffA(int R, int C) const { return (unsigned)(R * AK + C) * 2u; }
    __device__ __forceinline__ unsigned voffB(int R, int C) const { return (unsigned)(R * 1024 + C) * 2u; }
    int ks; long kstepB2, hstepB2;
    __device__ __forceinline__ const char* b_base2(const Unit&) const { return Bt; }
    __device__ __forceinline__ unsigned voffB2(int, int) const { return 0u; }
};
#ifndef S5_KSKIP
#define S5_KSKIP 1
#endif
struct S5OutGemm {
    static constexpr int tmid = -1;
    static constexpr bool TWOSEG = true, KSKIP = S5_KSKIP != 0;
    __device__ __forceinline__ int ks_of(const Unit& u) const { return 4 * (u.pn + 1); }
    const char* A; const char* KLt; const char* WCt; int nt; long kstepA, kstepB, hstepA, hstepB; int ks; long kstepB2, hstepB2; int G, c;
    __device__ __forceinline__ void init(const void* A_, const void* KL_, const void* WC_, int G_, int c_) { A = (const char*)A_; KLt = (const char*)KL_; WCt = (const char*)WC_; nt = AK / BK; kstepA = BK * 2; hstepA = (long)HALF * AK * 2;
        kstepB = -2048; hstepB = 4096; ks = (CL * SH) / BK; kstepB2 = BK * 2; hstepB2 = (long)HALF * 128 * 2; G = G_; c = c_; }
    __device__ __forceinline__ bool next(int i, Unit& u) const { const int L = i * G + c; if (L >= SG * 4) return false; u.pm = 0; u.g = L >> 2; u.pn = (KSKIP && (i & 1)) ? 3 - (L & 3) : (L & 3); return true; }
    __device__ __forceinline__ const char* a_base(const Unit& u) const { return A + (size_t)u.g * CR * AK * 2; }
    __device__ __forceinline__ const char* b_base(const Unit& u) const { return KLt + (size_t)u.g * 65536 + (size_t)(16 * u.pn + 60) * 512; }
    __device__ __forceinline__ const char* b_base2(const Unit& u) const { return WCt + ((size_t)u.g * 1024 * 128 + (size_t)u.pn * BM * 128) * 2; }
    __device__ __forceinline__ unsigned voffA(int R, int C) const { return (unsigned)(R * AK + C) * 2u; }
    __device__ __forceinline__ unsigned voffB(int R, int C) const { return (unsigned)((((R >> 4) - (C >> 4) + 3) * 256) + (R & 15) * 16 + (C & 15)) * 2u; }
    __device__ __forceinline__ unsigned voffB2(int R, int C) const { return (unsigned)(R * 128 + C) * 2u; }
};

typedef f32x4 Acc[2][2][4][2];
#ifndef WIDE8
#define WIDE8 1
#endif
#ifndef WT_EPI
#define WT_EPI 1
#endif
#if WT_EPI
__device__ __forceinline__ void st16_wt(const void* base, unsigned byte_off, u32x4 v) { __builtin_amdgcn_raw_buffer_store_b128(v, __builtin_amdgcn_make_buffer_rsrc((void*)base, 0, 0x7fffffff, 0x00020000), (int)byte_off, 0, 16); }
#define ST16(base, byte_off, v) st16_wt((base), (unsigned)(byte_off), (v))
#else
#define ST16(base, byte_off, v) (*(u32x4*)((unsigned char*)(base) + (size_t)(unsigned)(byte_off)) = (v))
#endif
#ifndef XP_EPI
#define XP_EPI 1
#endif
constexpr int XP_OFF = EPI_LDS_OFF + 6144;
static_assert(XP_OFF + 8192 <= LDS_BYTES, "lds map");
__device__ __forceinline__ u32x4 xp_to_rows(LAS unsigned char* slot, int fr, int fq, int lane, u32x4 w) { *(LAS u32x4*)(slot + (fr * 4 + fq) * 16) = w; return *(const LAS u32x4*)(slot + lane * 16); }
__device__ __forceinline__ u32x4 xp_to_frag(LAS unsigned char* slot, int fr, int fq, int lane, u32x4 w) { *(LAS u32x4*)(slot + lane * 16) = w; return *(const LAS u32x4*)(slot + (fr * 4 + fq) * 16); }

__device__ __forceinline__ void row_rstd8(const float* ps, int pm, int pm0, int wr, int fr, int fq, LAS unsigned char* lds, float (&rs)[8]);
#ifndef H_TILED
#define H_TILED 1
#endif
#ifndef POOL_PREMUL
#define POOL_PREMUL 1
#endif
#ifndef DOWN_REVK
#define DOWN_REVK 0
#endif
#ifndef WD_TILED
#define WD_TILED 1
#endif
__device__ __forceinline__ f32x4 swg4(f32x4 g, f32x4 u, float c1, float c2) {
    const f32x4 t = g * c1;
    f32x4 e; e[0] = __builtin_amdgcn_exp2f(t[0]); e[1] = __builtin_amdgcn_exp2f(t[1]); e[2] = __builtin_amdgcn_exp2f(t[2]); e[3] = __builtin_amdgcn_exp2f(t[3]);
    const f32x4 d = e + 1.0f;
    f32x4 rc; rc[0] = __builtin_amdgcn_rcpf(d[0]); rc[1] = __builtin_amdgcn_rcpf(d[1]); rc[2] = __builtin_amdgcn_rcpf(d[2]); rc[3] = __builtin_amdgcn_rcpf(d[3]);
    return ((g * u) * c2) * rc;
}
template <bool RSTD, bool F8OUT = false, bool INTACC = false, bool HBF16 = false> struct EpiSwiGLU {
    static constexpr bool PERM = true, AFTER_DRAIN = false, IDEMPOTENT = true;
    bf16_t* H; const float* ps; int pm0; float qs;
    __device__ __forceinline__ void operator()(const Acc& acc, const Unit& u, int wr, int wc, int fr, int fq, LAS unsigned char* lds, int tid) const {
        const int row0 = u.pm * BM + wr * 64 + fr, col0 = u.pn * HALF + wc * 32 + 8 * fq;
        const int lane = tid & 63, rowT = u.pm * BM + wr * 64 + (lane >> 2), colT = u.pn * HALF + wc * 32 + 8 * (lane & 3); LAS unsigned char* const xslot = lds + XP_OFF + (wr * 4 + wc) * 1024; (void)rowT; (void)colT; (void)xslot;
        float rs[8]; u32x2 w8prev = {0u, 0u}; (void)w8prev;
        if constexpr (RSTD) row_rstd8(ps, u.pm, pm0, wr, fr, fq, lds, rs);
#pragma unroll
        for (int ai = 0; ai < 2; ++ai)
#pragma unroll
            for (int m = 0; m < 4; ++m) {
                f32x4 g0 = acc[ai][0][m][0], g1 = acc[ai][0][m][1], u0 = acc[ai][1][m][0], u1 = acc[ai][1][m][1];
                if constexpr (INTACC) {
                    typedef int i32x4v __attribute__((ext_vector_type(4)));
                    g0 = __builtin_convertvector(__builtin_bit_cast(i32x4v, g0), f32x4); g1 = __builtin_convertvector(__builtin_bit_cast(i32x4v, g1), f32x4);
                    u0 = __builtin_convertvector(__builtin_bit_cast(i32x4v, u0), f32x4); u1 = __builtin_convertvector(__builtin_bit_cast(i32x4v, u1), f32x4); }
                const float r = RSTD ? rs[ai * 4 + m] * qs : (INTACC ? qs : 1.0f);
                const float c1 = -1.4426950408889634f * r, c2 = r * r * (F8OUT ? H8_SCALE : 1.0f);
#define SWG(gv, uv) (((gv) * (uv)) * c2 * __builtin_amdgcn_rcpf(1.0f + __builtin_amdgcn_exp2f((gv) * c1)))
#define HQ(x) ((EMU_FP8 && RSTD) ? q8(x) : (x))
#define PK16(a, b) (HBF16 ? cvt_pk_truebf16(a, b) : cvt_pk_bf16(a, b))
                u32x4 w;
                const f32x4 o0 = swg4(g0, u0, c1, c2), o1 = swg4(g1, u1, c1, c2);
                if constexpr (!F8OUT) {
                w.x = PK16(HQ(o0[0]), HQ(o0[1])); w.y = PK16(HQ(o0[2]), HQ(o0[3]));
                w.z = PK16(HQ(o1[0]), HQ(o1[1])); w.w = PK16(HQ(o1[2]), HQ(o1[3])); }
#undef PK16
#undef HQ
                if constexpr (F8OUT) {
                    u32x2 w8; w8.x = pk4_fp8(o0[0], o0[1], o0[2], o0[3]); w8.y = pk4_fp8(o1[0], o1[1], o1[2], o1[3]);
#if WIDE8
                    if ((m & 1) == 0) { w8prev = w8; continue; }
                    const u32x2 sx = __builtin_amdgcn_permlane16_swap(w8prev.x, w8.x, false, false), sy = __builtin_amdgcn_permlane16_swap(w8prev.y, w8.y, false, false);
                    const u32x4 w16 = {sx.x, sy.x, sx.y, sy.y}; const int rst = row0 + ai * HALF + (m - 1 + (fq & 1)) * 16, cst = col0 & ~8;
                    *(u32x4*)((unsigned char*)H + ((size_t)(cst >> 7) * M + rst) * 128 + (cst & 127)) = w16; continue; }
#else
                    *(u32x2*)((unsigned char*)H + ((size_t)(col0 >> 7) * M + (row0 + ai * HALF + m * 16)) * 128 + (col0 & 127)) = w8; continue; }
#endif
#if H_TILED
                if (XP_EPI) ST16(H, (((unsigned)(colT >> 6) * M + (rowT + ai * HALF + m * 16)) * 64 + (colT & 63)) * 2u, xp_to_rows(xslot, fr, fq, lane, w));
                else ST16(H, (((unsigned)(col0 >> 6) * M + (row0 + ai * HALF + m * 16)) * 64 + (col0 & 63)) * 2u, w); }
#else
                *(u32x4*)(H + (size_t)(row0 + ai * HALF + m * 16) * FF + col0) = w; }
#endif
#undef SWG
    }
};
struct EpiResF32 {
    static constexpr bool PERM = false, AFTER_DRAIN = false, IDEMPOTENT = false;
    const float* base; float* out; float alpha;
    __device__ __forceinline__ void operator()(const Acc& acc, const Unit& u, int wr, int wc, int fr, int fq, LAS unsigned char* lds, int tid) const {
        const int row0 = u.pm * BM + wr * 64 + fr, col0 = u.pn * BM + wc * 32 + 4 * fq;
#pragma unroll
        for (int ai = 0; ai < 2; ++ai)
#pragma unroll
            for (int m = 0; m < 4; ++m) { const size_t off = (size_t)(row0 + ai * HALF + m * 16) * D + col0;
#pragma unroll
                for (int bj = 0; bj < 2; ++bj)
#pragma unroll
                    for (int n = 0; n < 2; ++n) { const f32x4 b = *(const f32x4*)(base + off + bj * HALF + n * 16); *(f32x4*)(out + off + bj * HALF + n * 16) = b + acc[ai][bj][m][n] * alpha; } }
    }
};
__device__ __forceinline__ void row_rstd8(const float* ps, int pm, int pm0, int wr, int fr, int fq, LAS unsigned char* lds, float (&rs)[8]) {
    if (pm == pm0) {
        const LAS float* RS = (const LAS float*)(lds + EPI_LDS_OFF + 4096);
#pragma unroll
        for (int ai = 0; ai < 2; ++ai)
#pragma unroll
            for (int m = 0; m < 4; ++m) rs[ai * 4 + m] = RS[ai * HALF + wr * 64 + m * 16 + fr];
        return; }
    f32x4 p[8];
#pragma unroll
    for (int ai = 0; ai < 2; ++ai)
#pragma unroll
        for (int m = 0; m < 4; ++m) p[ai * 4 + m] = *(const f32x4*)(ps + (size_t)(pm * BM + ai * HALF + wr * 64 + m * 16 + fr) * 16 + 4 * fq);
#pragma unroll
    for (int i = 0; i < 8; ++i) { float t = (p[i].x + p[i].y) + (p[i].z + p[i].w); t += __shfl_xor(t, 16); t += __shfl_xor(t, 32); rs[i] = 1.0f / sqrtf(t * (1.f / D) + NORM_EPS); }
}
template <bool BASE_F32, int QOUT = 0, bool ROWSC = false> struct EpiResNorm {
    static constexpr bool PERM = true, AFTER_DRAIN = false, IDEMPOTENT = false;
    const void* base; float alpha; bf16_t* xb; float* ps; void* xq;
    __device__ __forceinline__ void operator()(const Acc& acc, const Unit& u, int wr, int wc, int fr, int fq, LAS unsigned char* lds, int tid) const {
        const int row0 = u.pm * BM + wr * 64 + fr, col0 = u.pn * BM + wc * 32 + 8 * fq;
        const int lane = tid & 63, rowT = XP_EPI ? u.pm * BM + wr * 64 + (lane >> 2) : row0, colT = XP_EPI ? u.pn * BM + wc * 32 + 8 * (lane & 3) : col0; LAS unsigned char* const xslot = lds + XP_OFF + (wr * 4 + wc) * 1024;
        LAS float* P = (LAS float*)(lds + EPI_LDS_OFF);
#pragma unroll
        for (int ai = 0; ai < 2; ++ai)
#pragma unroll
            for (int mp = 0; mp < 2; ++mp) {
                f32x4 bv[2][2][2]; u32x4 bq[2][2]; (void)bq; u32x2 qprev[2] = {{0u, 0u}, {0u, 0u}}; (void)qprev;
#pragma unroll
                for (int mm = 0; mm < 2; ++mm) { const size_t off = (size_t)(rowT + ai * HALF + (2 * mp + mm) * 16) * D + colT;
#pragma unroll
                    for (int bj = 0; bj < 2; ++bj) {
                        if constexpr (BASE_F32) { bv[mm][bj][0] = *(const f32x4*)((const float*)base + off + bj * HALF); bv[mm][bj][1] = *(const f32x4*)((const float*)base + off + bj * HALF + 4); }
                        else { bq[mm][bj] = *(const u32x4*)((const bf16_t*)base + off + bj * HALF); } } }
#pragma unroll
                for (int mm = 0; mm < 2; ++mm) {
#pragma unroll
                    for (int bj = 0; bj < 2; ++bj) {
                        if constexpr (BASE_F32) { if (XP_EPI) { bv[mm][bj][0] = __builtin_bit_cast(f32x4, xp_to_frag(xslot, fr, fq, lane, __builtin_bit_cast(u32x4, bv[mm][bj][0]))); bv[mm][bj][1] = __builtin_bit_cast(f32x4, xp_to_frag(xslot, fr, fq, lane, __builtin_bit_cast(u32x4, bv[mm][bj][1]))); } }
                        else { const u32x4 q = XP_EPI ? xp_to_frag(xslot, fr, fq, lane, bq[mm][bj]) : bq[mm][bj];
                            bv[mm][bj][0] = (f32x4){bf_lo(q.x), bf_hi(q.x), bf_lo(q.y), bf_hi(q.y)}; bv[mm][bj][1] = (f32x4){bf_lo(q.z), bf_hi(q.z), bf_lo(q.w), bf_hi(q.w)}; } } }
#pragma unroll
                for (int mm = 0; mm < 2; ++mm) { const int m = 2 * mp + mm; const size_t off = (size_t)(row0 + ai * HALF + m * 16) * D + col0, offT = (size_t)(rowT + ai * HALF + m * 16) * D + colT; float ss = 0.f;
#pragma unroll
                    for (int bj = 0; bj < 2; ++bj) {
                        float al = alpha; if constexpr (ROWSC) al *= ((const LAS float*)(lds + EPI_LDS_OFF + 4096))[ai * HALF + wr * 64 + m * 16 + fr];
                        const f32x4 h0 = bv[mm][bj][0] + acc[ai][bj][m][0] * al, h1 = bv[mm][bj][1] + acc[ai][bj][m][1] * al;
                        ss += (h0[0] * h0[0] + h0[1] * h0[1]) + (h0[2] * h0[2] + h0[3] * h0[3]) + (h1[0] * h1[0] + h1[1] * h1[1]) + (h1[2] * h1[2] + h1[3] * h1[3]);
                        u32x4 w; w.x = cvt_pk_bf16(h0[0], h0[1]); w.y = cvt_pk_bf16(h0[2], h0[3]); w.z = cvt_pk_bf16(h1[0], h1[1]); w.w = cvt_pk_bf16(h1[2], h1[3]);
                        ST16(xb, (unsigned)(offT + bj * HALF) * 2u, XP_EPI ? xp_to_rows(xslot, fr, fq, lane, w) : w);
                        if constexpr (QOUT == 1) { u32x4 q; q.x = cvt_pk_bf16(qint8(h0[0] * AQ_SCALE), qint8(h0[1] * AQ_SCALE)); q.y = cvt_pk_bf16(qint8(h0[2] * AQ_SCALE), qint8(h0[3] * AQ_SCALE));
                            q.z = cvt_pk_bf16(qint8(h1[0] * AQ_SCALE), qint8(h1[1] * AQ_SCALE)); q.w = cvt_pk_bf16(qint8(h1[2] * AQ_SCALE), qint8(h1[3] * AQ_SCALE));
                            *(u32x4*)((bf16_t*)xq + off + bj * HALF) = q; }
                        if constexpr (QOUT == 2) { u32x2 q; q.x = pk4_i8(h0[0] * AQ_SCALE, h0[1] * AQ_SCALE, h0[2] * AQ_SCALE, h0[3] * AQ_SCALE); q.y = pk4_i8(h1[0] * AQ_SCALE, h1[1] * AQ_SCALE, h1[2] * AQ_SCALE, h1[3] * AQ_SCALE);
#if WIDE8
                            if (mm == 0) qprev[bj] = q;
                            else { const u32x2 sx = __builtin_amdgcn_permlane16_swap(qprev[bj].x, q.x, false, false), sy = __builtin_amdgcn_permlane16_swap(qprev[bj].y, q.y, false, false);
                                const u32x4 q16 = {sx.x, sy.x, sx.y, sy.y}; const size_t ost = (size_t)(row0 + ai * HALF + (2 * mp + (fq & 1)) * 16) * D + (col0 & ~8);
                                *(u32x4*)((unsigned char*)xq + ost + bj * HALF) = q16; } } }
#else
                            *(u32x2*)((unsigned char*)xq + off + bj * HALF) = q; } }
#endif
                    ss += __shfl_xor(ss, 16); ss += __shfl_xor(ss, 32);
                    if (fq == 0) P[(ai * HALF + wr * 64 + m * 16 + fr) * 4 + wc] = ss; } }
        LDS_WAIT(); __builtin_amdgcn_s_barrier(); asm volatile("" ::: "memory");
        if (tid < BM) { const f32x4 q = *(const LAS f32x4*)(P + tid * 4); ps[(size_t)(u.pm * BM + tid) * 16 + u.pn] = (q.x + q.y) + (q.z + q.w); }
    }
};
__device__ __forceinline__ void rstd_table(const float* ps, int pm, LAS unsigned char* lds, int tid) {
    if (pm >= 0 && tid < BM) { const f32x4* p = (const f32x4*)(ps + (size_t)(pm * BM + tid) * 16); const f32x4 a = p[0], b = p[1], c = p[2], d = p[3];
        const float t = (((a.x + a.y) + (a.z + a.w)) + ((b.x + b.y) + (b.z + b.w))) + (((c.x + c.y) + (c.z + c.w)) + ((d.x + d.y) + (d.z + d.w)));
        ((LAS float*)(lds + EPI_LDS_OFF + 4096))[tid] = 1.0f / sqrtf(t * (1.f / D) + NORM_EPS); }
    __syncthreads();
}
__device__ __forceinline__ void rstd2_table(const float* ps2, int pm, LAS unsigned char* lds, int tid) {
    if (pm >= 0 && tid < BM) { const f32x4* p = (const f32x4*)(ps2 + (size_t)(pm * BM + tid) * 16); const f32x4 a = p[0], b = p[1], c = p[2], d = p[3];
        const float tp = ((a.x + a.y) + (a.z + a.w)) + ((b.x + b.y) + (b.z + b.w)), ts = ((c.x + c.y) + (c.z + c.w)) + ((d.x + d.y) + (d.z + d.w));
        const float rp = 1.0f / sqrtf(tp * (1.f / PW) + NORM_EPS), rs = 1.0f / sqrtf(ts * (1.f / SW) + NORM_EPS);
        ((LAS float*)(lds + EPI_LDS_OFF + 4096))[tid] = rs; ((LAS float*)(lds + EPI_LDS_OFF + 5120))[tid] = rp / rs; }
    __syncthreads();
}
struct EpiZ {
    static constexpr bool PERM = true, AFTER_DRAIN = false, IDEMPOTENT = false;
    bf16_t* zpool; bf16_t* as5; const float* ps; int pm0;
    __device__ __forceinline__ void operator()(const Acc& acc, const Unit& u, int wr, int wc, int fr, int fq, LAS unsigned char* lds, int tid) const {
        const int row0 = u.pm * BM + wr * 64 + fr;
        float rs[8]; row_rstd8(ps, u.pm, pm0, wr, fr, fq, lds, rs);
#pragma unroll
        for (int ai = 0; ai < 2; ++ai)
#pragma unroll
            for (int m = 0; m < 4; ++m) { const int row = row0 + ai * HALF + m * 16;
#pragma unroll
                for (int bj = 0; bj < 2; ++bj) { const f32x4 v0 = acc[ai][bj][m][0] * rs[ai * 4 + m], v1 = acc[ai][bj][m][1] * rs[ai * 4 + m];
                    u32x4 w; w.x = cvt_pk_bf16(v0[0], v0[1]); w.y = cvt_pk_bf16(v0[2], v0[3]); w.z = cvt_pk_bf16(v1[0], v1[1]); w.w = cvt_pk_bf16(v1[2], v1[3]);
                    const int col = u.pn * BM + bj * HALF + wc * 32 + 8 * fq;
                    if (u.pn < 8) ST16(zpool, ((unsigned)row * PW + col) * 2u, w);
                    else { const int cs = col - PW, g = cs >> 4, h0 = cs & 15; ST16(as5, (unsigned)((g * CR + (row >> 6)) * AK + (row & 63) * SH + h0) * 2u, w); } } }
    }
};
__device__ __forceinline__ void tile_row_ss(float (&ss8)[8], float* ps, int pm, int slot, int wr, int wc, int fr, int fq, LAS unsigned char* lds, int tid) {
    LAS float* P = (LAS float*)(lds + EPI_LDS_OFF);
#pragma unroll
    for (int i = 0; i < 8; ++i) { float t = ss8[i]; t += __shfl_xor(t, 16); t += __shfl_xor(t, 32); if (fq == 0) P[((i >> 2) * HALF + wr * 64 + (i & 3) * 16 + fr) * 4 + wc] = t; }
    LDS_WAIT(); __builtin_amdgcn_s_barrier(); asm volatile("" ::: "memory");
    if (tid < BM) { const f32x4 q = *(const LAS f32x4*)(P + tid * 4); ps[(size_t)(pm * BM + tid) * 16 + slot] = (q.x + q.y) + (q.z + q.w); }
}
struct EpiPool {
    static constexpr bool PERM = true, AFTER_DRAIN = false, IDEMPOTENT = false;
    bf16_t* O; const float* scale; float* ps2;
    __device__ __forceinline__ void operator()(const Acc& acc, const Unit& u, int wr, int wc, int fr, int fq, LAS unsigned char* lds, int tid) const {
        const int row0 = u.pm * BM + wr * 64 + fr, col0 = u.g * PGW + u.pn * BM + wc * 32 + 8 * fq;
        f32x4 sv[2][2];
#pragma unroll
        for (int bj = 0; bj < 2; ++bj)
#pragma unroll
            for (int n = 0; n < 2; ++n) sv[bj][n] = *(const f32x4*)(scale + col0 + bj * HALF + 4 * n);
        float ss8[8];
#pragma unroll
        for (int ai = 0; ai < 2; ++ai)
#pragma unroll
            for (int m = 0; m < 4; ++m) { bf16_t* rowp = O + (size_t)(row0 + ai * HALF + m * 16) * D + col0; float ss = 0.f;
#pragma unroll
                for (int bj = 0; bj < 2; ++bj) { const f32x4 v0 = acc[ai][bj][m][0] * sv[bj][0], v1 = acc[ai][bj][m][1] * sv[bj][1];
                    ss += (v0[0] * v0[0] + v0[1] * v0[1]) + (v0[2] * v0[2] + v0[3] * v0[3]) + (v1[0] * v1[0] + v1[1] * v1[1]) + (v1[2] * v1[2] + v1[3] * v1[3]);
                    u32x4 w; w.x = cvt_pk_bf16(v0[0], v0[1]); w.y = cvt_pk_bf16(v0[2], v0[3]); w.z = cvt_pk_bf16(v1[0], v1[1]); w.w = cvt_pk_bf16(v1[2], v1[3]);
                    *(u32x4*)(rowp + bj * HALF) = w; }
                ss8[ai * 4 + m] = ss; }
        tile_row_ss(ss8, ps2, u.pm, u.g * 2 + u.pn, wr, wc, fr, fq, lds, tid);
    }
};
struct EpiComb {
    static constexpr bool PERM = true, AFTER_DRAIN = false, IDEMPOTENT = false;
    bf16_t* O; const float* gain;
    __device__ __forceinline__ void operator()(const Acc& acc, const Unit& u, int wr, int wc, int fr, int fq, LAS unsigned char* lds, int tid) const {
        const int row0 = u.g * PGW + u.pm * BM + wr * 64 + fr, col0 = u.pn * BM + wc * 32 + 8 * fq;
        f32x4 gv[2][2];
#pragma unroll
        for (int bj = 0; bj < 2; ++bj)
#pragma unroll
            for (int n = 0; n < 2; ++n) gv[bj][n] = *(const f32x4*)(gain + col0 + bj * HALF + 4 * n);
#pragma unroll
        for (int ai = 0; ai < 2; ++ai)
#pragma unroll
            for (int m = 0; m < 4; ++m) { bf16_t* rowp = O + (size_t)(row0 + ai * HALF + m * 16) * D + col0;
#pragma unroll
                for (int bj = 0; bj < 2; ++bj) { const f32x4 v0 = acc[ai][bj][m][0] * gv[bj][0], v1 = acc[ai][bj][m][1] * gv[bj][1];
                    u32x4 w; w.x = cvt_pk_bf16(v0[0], v0[1]); w.y = cvt_pk_bf16(v0[2], v0[3]); w.z = cvt_pk_bf16(v1[0], v1[1]); w.w = cvt_pk_bf16(v1[2], v1[3]);
                    *(u32x4*)(rowp + bj * HALF) = w; } }
    }
};
struct EpiS5Y {
    static constexpr bool PERM = true, AFTER_DRAIN = false, IDEMPOTENT = false;
    bf16_t* Y;
    __device__ __forceinline__ void operator()(const Acc& acc, const Unit& u, int wr, int wc, int fr, int fq, LAS unsigned char* lds, int tid) const {
        const int cr0 = wr * 64 + fr, h0 = 8 * (fq & 1);
#pragma unroll
        for (int ai = 0; ai < 2; ++ai)
#pragma unroll
            for (int m = 0; m < 4; ++m) { const int cr = cr0 + ai * HALF + m * 16;
#pragma unroll
                for (int bj = 0; bj < 2; ++bj) { const f32x4 v0 = acc[ai][bj][m][0], v1 = acc[ai][bj][m][1];
                    u32x4 w; w.x = cvt_pk_bf16(gelu_tanh_f(v0[0]), gelu_tanh_f(v0[1])); w.y = cvt_pk_bf16(gelu_tanh_f(v0[2]), gelu_tanh_f(v0[3]));
                    w.z = cvt_pk_bf16(gelu_tanh_f(v1[0]), gelu_tanh_f(v1[1])); w.w = cvt_pk_bf16(gelu_tanh_f(v1[2]), gelu_tanh_f(v1[3]));
                    const int j = u.pn * 16 + bj * 8 + wc * 2 + (fq >> 1);
                    ST16(Y, ((unsigned)(cr * CL + j) * SW + u.g * SH + h0) * 2u, w); } }
    }
};
struct EpiGLU {
    static constexpr bool PERM = true, AFTER_DRAIN = false, IDEMPOTENT = false;
    const bf16_t* Y; bf16_t* O; const float* bias; float* ps2;
    __device__ __forceinline__ void operator()(const Acc& acc, const Unit& u, int wr, int wc, int fr, int fq, LAS unsigned char* lds, int tid) const {
        const int row0 = u.pm * BM + wr * 64 + fr, col0 = u.pn * BM + wc * 32 + 8 * fq;
        f32x4 bv[2][2];
#pragma unroll
        for (int bj = 0; bj < 2; ++bj)
#pragma unroll
            for (int n = 0; n < 2; ++n) bv[bj][n] = *(const f32x4*)(bias + col0 + bj * HALF + 4 * n);
        float ss8[8];
#pragma unroll
        for (int ai = 0; ai < 2; ++ai)
#pragma unroll
            for (int m = 0; m < 4; ++m) { const int row = row0 + ai * HALF + m * 16; float ss = 0.f;
#pragma unroll
                for (int bj = 0; bj < 2; ++bj) { const f32x4 v0 = acc[ai][bj][m][0] + bv[bj][0], v1 = acc[ai][bj][m][1] + bv[bj][1];
                    const u32x4 yv = *(const u32x4*)(Y + (size_t)row * SW + col0 + bj * HALF);
                    float o[8]; o[0] = bf_lo(yv.x) * fast_sigmoid(v0[0]); o[1] = bf_hi(yv.x) * fast_sigmoid(v0[1]); o[2] = bf_lo(yv.y) * fast_sigmoid(v0[2]); o[3] = bf_hi(yv.y) * fast_sigmoid(v0[3]);
                    o[4] = bf_lo(yv.z) * fast_sigmoid(v1[0]); o[5] = bf_hi(yv.z) * fast_sigmoid(v1[1]); o[6] = bf_lo(yv.w) * fast_sigmoid(v1[2]); o[7] = bf_hi(yv.w) * fast_sigmoid(v1[3]);
                    ss += (o[0] * o[0] + o[1] * o[1]) + (o[2] * o[2] + o[3] * o[3]) + (o[4] * o[4] + o[5] * o[5]) + (o[6] * o[6] + o[7] * o[7]);
                    u32x4 w; w.x = cvt_pk_bf16(o[0], o[1]); w.y = cvt_pk_bf16(o[2], o[3]); w.z = cvt_pk_bf16(o[4], o[5]); w.w = cvt_pk_bf16(o[6], o[7]);
                    ST16(O, ((unsigned)row * D + SW + col0 + bj * HALF) * 2u, w); }
                ss8[ai * 4 + m] = ss; }
        tile_row_ss(ss8, ps2, u.pm, 8 + u.pn, wr, wc, fr, fq, lds, tid);
    }
};
struct EpiCarry {
    static constexpr bool PERM = false, AFTER_DRAIN = true, IDEMPOTENT = false;
    bf16_t* as5; const float* lp;
    __device__ __forceinline__ void fused(const Acc& acc, const Unit& u, int wr, int wc, int fr, int fq, LAS unsigned char* lds, int wid, int lane) const {
        LAS float* S = (LAS float*)lds;
#pragma unroll
        for (int ai = 0; ai < 2; ++ai)
#pragma unroll
            for (int m = 0; m < 4; ++m) { const int r = ai * HALF + wr * 64 + m * 16 + fr;
#pragma unroll
                for (int n = 0; n < 2; ++n) *(LAS f32x4*)(S + r * 128 + wc * 32 + n * 16 + 4 * fq) = acc[ai][0][m][n]; }
        LDS_WAIT(); __builtin_amdgcn_s_barrier(); asm volatile("" ::: "memory");
        const int b = wid, p = lane;
        const f32x2 L = *(const f32x2*)(lp + ((size_t)u.g * SP + p) * 2);
        float xr = 0.f, xi = 0.f;
        bf16_t* dst = as5 + (size_t)(u.g * CR + b * 32) * AK + CL * SH;
        for (int c = 0; c < 32; ++c) {
            const float sr = S[(b * 32 + c) * 128 + p], si = S[(b * 32 + c) * 128 + 64 + p];
            dst[(size_t)c * AK + p] = (bf16_t)f2bf(xr); dst[(size_t)c * AK + 64 + p] = (bf16_t)f2bf(xi);
            const float nr = L.x * xr - L.y * xi + sr, ni = L.x * xi + L.y * xr + si; xr = nr; xi = ni; }
    }
};

typedef int i32x4 __attribute__((ext_vector_type(4)));
typedef int i32x8 __attribute__((ext_vector_type(8)));
__device__ __forceinline__ i32x8 cat8(bf16x8 a, bf16x8 b) { return __builtin_shufflevector(__builtin_bit_cast(i32x4, a), __builtin_bit_cast(i32x4, b), 0, 1, 2, 3, 4, 5, 6, 7); }
template <class Epi, class Prob, bool ALIGN_EPI, bool SP2, int MODE = 0>
__device__ __forceinline__ void gemm_phase(LAS unsigned char* lds, const Prob& S, const Epi& E) {
    const int tid = threadIdx.x, wid = __builtin_amdgcn_readfirstlane(tid >> 6), lane = tid & 63, wr = wid >> 2, wc = wid & 3, fr = lane & 15, fq = lane >> 4;
    constexpr bool FP8 = (MODE == 1);
    int nt = S.nt, ksu = Prob::TWOSEG ? S.ks : 0; long skipA = 0;
    unsigned voffA0, voffB0, voffB20;
    { int R, C; stage_rc(tid * 16, R, C); const int Rb = Epi::PERM ? ((R & ~31) + perm32(R & 31)) : R;
      voffA0 = S.voffA(R, C); voffB0 = S.voffB(Rb, C); voffB20 = Prob::TWOSEG ? S.voffB2(Rb, C) : 0u; }
    const long dA = (long)S.voffA(64, 0) - (long)S.voffA(0, 0), dB = (long)S.voffB(64, 0) - (long)S.voffB(0, 0), dB2 = Prob::TWOSEG ? ((long)S.voffB2(64, 0) - (long)S.voffB2(0, 0)) : 0;
    const long kstepA = S.kstepA, kstepB = S.kstepB, hstepA = S.hstepA, hstepB = S.hstepB;
    const unsigned ldsw = (unsigned)wid * 1024u;
    const int aoff = lds_byte(wr * 64 + fr, fq * 8), boff = lds_byte(wc * 32 + fr, fq * 8);
#define PG8_SA(b, h) (((b) * 2 + (h)) * HTB)
#define PG8_SB(b, h) ((4 + (b) * 2 + (h)) * HTB)
#define PG8_STAGE(bufoff, gbase, v0, d) do { const unsigned _v0 = (v0); const char* _g0 = (const char*)(gbase); const char* _g1 = _g0 + (d); asm volatile("" : "+s"(_g0), "+s"(_g1)); \
        __builtin_amdgcn_global_load_lds((const unsigned*)(_g0 + _v0), (LAS unsigned*)(lds + (bufoff) + ldsw), 16, 0, 0); \
        __builtin_amdgcn_global_load_lds((const unsigned*)(_g1 + _v0), (LAS unsigned*)(lds + (bufoff) + ldsw + 8192), 16, 0, 0); } while (0)
#define PG8_STA(bufoff, gbase) PG8_STAGE(bufoff, gbase, voffA0, dA)
#define PG8_LDA(dst, b, h) do { _Pragma("unroll") for (int m = 0; m < 4; ++m) { if constexpr (FP8) { dst##8[m].lo = *(const LAS i32x4*)(lds + PG8_SA(b, h) + aoff + m * 2048); dst##8[m].hi = *(const LAS i32x4*)(lds + PG8_SA(b, h) + aoff + m * 2048 + 1024); } \
        else { _Pragma("unroll") for (int k = 0; k < 2; ++k) dst[m][k] = *(const LAS bf16x8*)(lds + PG8_SA(b, h) + aoff + m * 2048 + k * 1024); } } } while (0)
#define PG8_LDB(dst, b, h) do { _Pragma("unroll") for (int n = 0; n < 2; ++n) { if constexpr (FP8) { dst##8[n].lo = *(const LAS i32x4*)(lds + PG8_SB(b, h) + boff + n * 2048); dst##8[n].hi = *(const LAS i32x4*)(lds + PG8_SB(b, h) + boff + n * 2048 + 1024); } \
        else { _Pragma("unroll") for (int k = 0; k < 2; ++k) dst[n][k] = *(const LAS bf16x8*)(lds + PG8_SB(b, h) + boff + n * 2048 + k * 1024); } } } while (0)
#define PG8_MMA(ai, bj, At, Bt) do { if (!ONE_PRIO_SPAN || (bj) == 0) __builtin_amdgcn_s_setprio(1); \
        if constexpr (FP8) { _Pragma("unroll") for (int m = 0; m < 4; ++m) _Pragma("unroll") for (int n = 0; n < 2; ++n) \
            acc[ai][bj][m][n] = __builtin_amdgcn_mfma_scale_f32_16x16x128_f8f6f4(Bt##8[n], At##8[m], acc[ai][bj][m][n], 0, 0, 0, 0x7F7F7F7F, 0, 0x7F7F7F7F); } \
        else if constexpr (MODE == 2) { _Pragma("unroll") for (int o_ = 0; o_ < 8; ++o_) _Pragma("unroll") for (int k = 0; k < 2; ++k) { const int m = MMA_NM ? (o_ & 3) : (o_ >> 1), n = MMA_NM ? (o_ >> 2) : (o_ & 1); \
            acc[ai][bj][m][n] = __builtin_bit_cast(f32x4, __builtin_amdgcn_mfma_i32_16x16x64_i8(__builtin_bit_cast(i32x4, Bt[n][k]), __builtin_bit_cast(i32x4, At[m][k]), __builtin_bit_cast(i32x4, acc[ai][bj][m][n]), 0, 0, 0)); if (MMA_PIN) __builtin_amdgcn_sched_barrier(0); } } \
        else { _Pragma("unroll") for (int o_ = 0; o_ < 8; ++o_) _Pragma("unroll") for (int k = 0; k < 2; ++k) { const int m = MMA_NM ? (o_ & 3) : (o_ >> 1), n = MMA_NM ? (o_ >> 2) : (o_ & 1); \
            acc[ai][bj][m][n] = (F16 && MODE != 3) ? __builtin_amdgcn_mfma_f32_16x16x32_f16(__builtin_bit_cast(f16x8, Bt[n][k]), __builtin_bit_cast(f16x8, At[m][k]), acc[ai][bj][m][n], 0, 0, 0) \
                                    : __builtin_amdgcn_mfma_f32_16x16x32_bf16(Bt[n][k], At[m][k], acc[ai][bj][m][n], 0, 0, 0); if (MMA_PIN) __builtin_amdgcn_sched_barrier(0); \
            if (DUP_MFMA) dummy[(m * 2 + n) & 3] = __builtin_amdgcn_mfma_f32_16x16x32_bf16(Bt[n][k], At[m][k], dummy[(m * 2 + n) & 3], 0, 0, 0); } } \
        if (!ONE_PRIO_SPAN || (bj) == 1) __builtin_amdgcn_s_setprio(0); } while (0)
#define PG8_WAIT_V(n) asm volatile("s_waitcnt vmcnt(" #n ")" ::: "memory")
#define PG8_WAIT_L(n) asm volatile("s_waitcnt lgkmcnt(" #n ")" ::: "memory")
#define PG8_BAR __builtin_amdgcn_s_barrier()
#define PG8_SCHED __builtin_amdgcn_sched_barrier(0)
    Unit cur, nxt; int ui = 0;
    if (!S.next(0, cur)) return;
    f32x4 acc[2][2][4][2];
#pragma unroll
    for (int a = 0; a < 2; ++a)
#pragma unroll
        for (int b = 0; b < 2; ++b)
#pragma unroll
            for (int m = 0; m < 4; ++m)
#pragma unroll
                for (int n = 0; n < 2; ++n) acc[a][b][m][n] = (f32x4){0.f, 0.f, 0.f, 0.f};
    bf16x8 At[4][2], B0[2][2], B1[2][2]; i32x8 At8[4], B08[2], B18[2];
    f32x4 dummy[4] = {{0.f, 0.f, 0.f, 0.f}, {0.f, 0.f, 0.f, 0.f}, {0.f, 0.f, 0.f, 0.f}, {0.f, 0.f, 0.f, 0.f}};
    const char* cA = S.a_base(cur); const char* cB = S.b_base(cur); const char* cB2 = Prob::TWOSEG ? S.b_base2(cur) : cB;
    if constexpr (Prob::KSKIP) { ksu = S.ks_of(cur); nt = ksu + (S.nt - S.ks); skipA = (long)(S.ks - ksu) * S.kstepA; }
    if constexpr (SP2) {
        PG8_STAGE(PG8_SB(0, 0), cB, voffB0, dB); PG8_STAGE(PG8_SB(0, 1), cB + hstepB, voffB0, dB); PG8_STA(PG8_SA(0, 0), cA); PG8_STA(PG8_SA(0, 1), cA + hstepA);
        if (wr == 1) PG8_BAR;
        PG8_WAIT_V(2); PG8_BAR;
        PG8_STAGE(PG8_SB(1, 0), cB + kstepB, voffB0, dB); PG8_STA(PG8_SA(1, 0), cA + kstepA); PG8_STAGE(PG8_SB(1, 1), cB + hstepB + kstepB, voffB0, dB);
        PG8_WAIT_V(6); PG8_BAR;
    } else {
        PG8_STAGE(PG8_SB(0, 0), cB, voffB0, dB); PG8_STA(PG8_SA(0, 0), cA); PG8_STAGE(PG8_SB(0, 1), cB + hstepB, voffB0, dB); PG8_STA(PG8_SA(0, 1), cA + hstepA);
        if (wr == 1) PG8_BAR;
        PG8_WAIT_V(4); PG8_BAR;
        PG8_STAGE(PG8_SB(1, 0), cB + kstepB, voffB0, dB); PG8_STA(PG8_SA(1, 0), cA + kstepA); PG8_STAGE(PG8_SB(1, 1), cB + hstepB + kstepB, voffB0, dB);
        PG8_WAIT_V(6); PG8_BAR;
    }
    for (;;) {
        const bool has_next = S.next(ui + 1, nxt);
        const char* nA = has_next ? S.a_base(nxt) : cA; const char* nB = has_next ? S.b_base(nxt) : cB; const char* nB2 = (Prob::TWOSEG && has_next) ? S.b_base2(nxt) : cB2;
        for (int t = 0; t < nt; t += 2) {
            asm volatile("" : "+v"(voffA0), "+v"(voffB0), "+v"(voffB20));
            if (S.tmid >= 0 && t == S.tmid) {
                const LAS float* RAT = (const LAS float*)(lds + EPI_LDS_OFF + 5120);
#pragma unroll
                for (int ai = 0; ai < 2; ++ai)
#pragma unroll
                    for (int m = 0; m < 4; ++m) { const float r = RAT[ai * HALF + wr * 64 + m * 16 + fr];
#pragma unroll
                        for (int bj = 0; bj < 2; ++bj)
#pragma unroll
                            for (int n = 0; n < 2; ++n) acc[ai][bj][m][n] = acc[ai][bj][m][n] * r; } }
            const bool last = (t == nt - 2);
            const char* a1 = cA + (long)(t + 1) * kstepA + ((Prob::KSKIP && t >= ksu) ? skipA : 0);
            const char* a2; const char* b2; long kb = kstepB, hb = hstepB, db = dB; unsigned vb0 = voffB0;
            if (last) { a2 = nA; b2 = nB; }
            else { a2 = cA + (long)(t + 2) * kstepA + ((Prob::KSKIP && t + 2 >= ksu) ? skipA : 0);
                   if (Prob::TWOSEG && t + 2 >= ksu) { b2 = cB2 + (long)(t + 2 - ksu) * S.kstepB2; kb = S.kstepB2; hb = S.hstepB2; vb0 = voffB20; db = dB2; }
                   else b2 = cB + (long)(t + 2) * kstepB; }
            const char* a3 = a2 + kstepA; const char* b3 = b2 + kb;
            if constexpr (SP2) {
            PG8_LDB(B0, 0, 0); PG8_LDB(B1, 0, 1); PG8_SCHED; PG8_LDA(At, 0, 0); PG8_STA(PG8_SA(1, 1), a1 + hstepA);
            PG8_WAIT_V(8); PG8_WAIT_L(0); PG8_BAR; PG8_MMA(0, 0, At, B0); PG8_MMA(0, 1, At, B1); PG8_BAR; PG8_SCHED;
#if PG8_SPLIT
            PG8_LDA(At, 0, 1); PG8_STAGE(PG8_SB(0, 0), b2, vb0, db);
            PG8_WAIT_V(4); PG8_WAIT_L(0); PG8_BAR; PG8_MMA(1, 0, At, B0); PG8_SCHED; PG8_STAGE(PG8_SB(0, 1), b2 + hb, vb0, db); PG8_SCHED; PG8_MMA(1, 1, At, B1); PG8_SCHED; PG8_STA(PG8_SA(0, 0), a2); PG8_BAR; PG8_SCHED;
#else
            PG8_LDA(At, 0, 1); PG8_STAGE(PG8_SB(0, 0), b2, vb0, db); PG8_STAGE(PG8_SB(0, 1), b2 + hb, vb0, db); PG8_STA(PG8_SA(0, 0), a2);
            PG8_WAIT_V(8); PG8_WAIT_L(0); PG8_BAR; PG8_MMA(1, 0, At, B0); PG8_MMA(1, 1, At, B1); PG8_BAR; PG8_SCHED;
#endif
            PG8_LDB(B0, 1, 0); PG8_LDB(B1, 1, 1); PG8_SCHED; PG8_LDA(At, 1, 0); PG8_STA(PG8_SA(0, 1), a2 + hstepA);
            PG8_WAIT_V(8); PG8_WAIT_L(0); PG8_BAR; PG8_MMA(0, 0, At, B0); PG8_MMA(0, 1, At, B1); PG8_BAR; PG8_SCHED;
#if PG8_SPLIT
            PG8_LDA(At, 1, 1); PG8_STAGE(PG8_SB(1, 0), b3, vb0, db);
            PG8_WAIT_V(4); PG8_WAIT_L(0); PG8_BAR; PG8_MMA(1, 0, At, B0); PG8_SCHED; PG8_STAGE(PG8_SB(1, 1), b3 + hb, vb0, db); PG8_SCHED; PG8_MMA(1, 1, At, B1); PG8_SCHED; PG8_STA(PG8_SA(1, 0), a3); PG8_BAR; PG8_SCHED;
#else
            PG8_LDA(At, 1, 1); PG8_STAGE(PG8_SB(1, 0), b3, vb0, db); PG8_STAGE(PG8_SB(1, 1), b3 + hb, vb0, db); PG8_STA(PG8_SA(1, 0), a3);
            PG8_WAIT_V(8); PG8_WAIT_L(0); PG8_BAR; PG8_MMA(1, 0, At, B0); PG8_MMA(1, 1, At, B1); PG8_BAR; PG8_SCHED;
#endif
            } else {
            PG8_LDB(B0, 0, 0); PG8_SCHED; PG8_LDA(At, 0, 0); PG8_STA(PG8_SA(1, 1), a1 + hstepA);
            PG8_WAIT_L(8); PG8_BAR; PG8_WAIT_L(0); PG8_MMA(0, 0, At, B0); PG8_BAR; PG8_SCHED;
            PG8_LDB(B1, 0, 1); PG8_STAGE(PG8_SB(0, 0), b2, vb0, db);
            PG8_BAR; PG8_WAIT_L(0); PG8_MMA(0, 1, At, B1); PG8_BAR;
            PG8_LDA(At, 0, 1); PG8_STA(PG8_SA(0, 0), a2);
            PG8_BAR; PG8_WAIT_L(0); PG8_MMA(1, 0, At, B0); PG8_BAR; PG8_SCHED;
            PG8_STAGE(PG8_SB(0, 1), b2 + hb, vb0, db);
            PG8_WAIT_V(6); PG8_BAR; PG8_MMA(1, 1, At, B1); PG8_BAR;
            PG8_LDB(B0, 1, 0); PG8_SCHED; PG8_LDA(At, 1, 0); PG8_STA(PG8_SA(0, 1), a2 + hstepA);
            PG8_WAIT_L(8); PG8_BAR; PG8_WAIT_L(0); PG8_MMA(0, 0, At, B0); PG8_BAR; PG8_SCHED;
            PG8_LDB(B1, 1, 1); PG8_STAGE(PG8_SB(1, 0), b3, vb0, db);
            PG8_BAR; PG8_WAIT_L(0); PG8_MMA(0, 1, At, B1); PG8_BAR;
            PG8_LDA(At, 1, 1); PG8_STA(PG8_SA(1, 0), a3);
            PG8_BAR; PG8_WAIT_L(0); PG8_MMA(1, 0, At, B0); PG8_BAR; PG8_SCHED;
            PG8_STAGE(PG8_SB(1, 1), b3 + hb, vb0, db);
            PG8_WAIT_V(6); PG8_BAR; PG8_MMA(1, 1, At, B1); PG8_BAR;
            }
        }
        if constexpr (ALIGN_EPI) { if (wr == 0) PG8_BAR; }
        if constexpr (!Epi::AFTER_DRAIN) {
            int tz = threadIdx.x; asm volatile("" : "+v"(tz)); const int lz = tz & 63;
            E(acc, cur, wr, wc, lz & 15, lz >> 4, lds, tz);
            if (EPI_TWICE && Epi::IDEMPOTENT) E(acc, cur, wr, wc, lz & 15, lz >> 4, lds, tz); }
        if (!has_next) break;
#pragma unroll
        for (int a = 0; a < 2; ++a)
#pragma unroll
            for (int b = 0; b < 2; ++b)
#pragma unroll
                for (int m = 0; m < 4; ++m)
#pragma unroll
                    for (int n = 0; n < 2; ++n) acc[a][b][m][n] = (f32x4){0.f, 0.f, 0.f, 0.f};
        cur = nxt; cA = nA; cB = nB; cB2 = nB2; ++ui;
        if constexpr (Prob::KSKIP) { ksu = S.ks_of(cur); nt = ksu + (S.nt - S.ks); skipA = (long)(S.ks - ksu) * S.kstepA; }
        if constexpr (ALIGN_EPI) { if (wr == 1) PG8_BAR; }
    }
    if (DUP_MFMA) asm volatile("" :: "v"(dummy[0]), "v"(dummy[1]), "v"(dummy[2]), "v"(dummy[3]));
    PG8_WAIT_V(0);
    if constexpr (!ALIGN_EPI) { if (wr == 0) PG8_BAR; }
    PG8_BAR;
    if constexpr (Epi::AFTER_DRAIN) { E.fused(acc, cur, wr, wc, fr, fq, lds, wid, lane); }
#undef PG8_SA
#undef PG8_SB
#undef PG8_STAGE
#undef PG8_STA
#undef PG8_LDA
#undef PG8_LDB
#undef PG8_MMA
#undef PG8_WAIT_V
#undef PG8_WAIT_L
#undef PG8_BAR
#undef PG8_SCHED
}
}

#define XB_TMO      128
#define XB_XCNT(j)  (256  + 64 * (j))
#define XB_XSUB(j)  (1280 + 64 * (j))
#define XB_XGEN(j)  (2304 + 64 * (j))
#define XB_TOP      3328
#define XB_TOPGEN   3392
#define XCD_BAR_WORDS 3456
#define XB_SPIN_CAP (1u << 18)
__device__ __forceinline__ unsigned xb_ld(unsigned* p)              { return __hip_atomic_load(p, __ATOMIC_RELAXED, __HIP_MEMORY_SCOPE_AGENT); }
__device__ __forceinline__ unsigned xb_add(unsigned* p, unsigned v) { return __hip_atomic_fetch_add(p, v, __ATOMIC_RELAXED, __HIP_MEMORY_SCOPE_AGENT); }
__device__ __forceinline__ unsigned xb_xcc_id() { return (unsigned)__builtin_amdgcn_s_getreg((3 << 11) | 20) & 0xFu; }
#define XB_SPIN(cond, bar) do { unsigned _sp = 0; while (cond) { __builtin_amdgcn_s_sleep(1); \
    if ((++_sp & 255u) == 0u) { if (xb_ld(&(bar)[XB_TMO])) break; if (_sp > XB_SPIN_CAP) { atomicAdd(&(bar)[XB_TMO], 1u); break; } } } } while (0)
struct XcdBarrier { unsigned* bar; unsigned x; volatile LAS unsigned* st; };
__device__ __forceinline__ XcdBarrier xcd_barrier_post(unsigned* bar, volatile LAS unsigned* st) {
    XcdBarrier b; b.bar = bar; b.x = xb_xcc_id(); b.st = st;
    if (threadIdx.x == 0) (void)xb_add(&bar[XB_XCNT(b.x)], 1u);
    return b;
}
__device__ __forceinline__ void xcd_barrier_complete(unsigned* bar, unsigned x, unsigned& nloc, unsigned& nx) {
    const unsigned G = gridDim.x * gridDim.y * gridDim.z;
    unsigned sum, cnt, mine, sp = 0u;
    for (;;) {
        sum = 0u; cnt = 0u; mine = 0u;
#pragma unroll
        for (unsigned j = 0; j < 16; ++j) { const unsigned c = xb_ld(&bar[XB_XCNT(j)]); sum += c; cnt += (c > 0u) ? 1u : 0u; mine = (j == x) ? c : mine; }
        if (sum == G) break;
        __builtin_amdgcn_s_sleep(1);
        if ((++sp & 255u) == 0u) { if (xb_ld(&bar[XB_TMO])) break; if (sp > XB_SPIN_CAP) { atomicAdd(&bar[XB_TMO], 1u); break; } }
    }
    nloc = mine > 0u ? mine : 1u; nx = cnt > 0u ? cnt : 1u;
}
__device__ __forceinline__ void xcd_barrier(const XcdBarrier& b) {
    asm volatile("s_waitcnt vmcnt(0)" ::: "memory");
    __syncthreads();
    if (threadIdx.x == 0) {
        unsigned* bar = b.bar;
        __builtin_amdgcn_s_waitcnt(0);
        unsigned nloc = b.st[0], nx = b.st[1];
        if (nloc == 0u) { xcd_barrier_complete(bar, b.x, nloc, nx); b.st[0] = nloc; b.st[1] = nx; }
        const unsigned old = xb_add(&bar[XB_XSUB(b.x)], 1u);
        const unsigned gen = old / nloc;
        if (old + 1u == (gen + 1u) * nloc) {
            __builtin_amdgcn_fence(__ATOMIC_RELEASE, "agent");
            asm volatile("s_waitcnt vmcnt(0)" ::: "memory");
            const unsigned og = xb_add(&bar[XB_TOP], 1u);
            const unsigned tg = og / nx;
            if (og + 1u == (tg + 1u) * nx) xb_add(&bar[XB_TOPGEN], 1u);
            else XB_SPIN(xb_ld(&bar[XB_TOPGEN]) == tg, bar);
            __builtin_amdgcn_fence(__ATOMIC_ACQUIRE, "agent");
            xb_add(&bar[XB_XGEN(b.x)], 1u);
            asm volatile("s_waitcnt vmcnt(0)" ::: "memory");
        } else {
            XB_SPIN(xb_ld(&bar[XB_XGEN(b.x)]) == gen, bar);
            __builtin_amdgcn_fence(__ATOMIC_ACQUIRE, "agent");
            asm volatile("s_waitcnt vmcnt(0)" ::: "memory");
        }
    }
    __syncthreads();
}

enum In { I_X = 0, I_N1, I_G1, I_U1, I_D1, I_MIXN, I_WIN, I_WPOOL, I_PSCALE, I_LRE, I_LIM, I_LOGDT, I_BRE, I_BIM, I_CRE, I_CIM, I_DSKIP, I_WGLU, I_BGLU, I_PON, I_SON, I_WOUT, I_N2, I_G2, I_U2, I_D2, I_FN, N_IN };
struct Args { const float* in[N_IN]; float* out; unsigned char* ws; int ph_lo, ph_hi, li, pad; };
struct Frame {
    LAS unsigned char* lds; volatile LAS unsigned* MISC; unsigned* ctl;
    int tid, lane, wave, vcu, G;
};

#ifndef P0_KFAST
#define P0_KFAST 1
#endif
#define P0_DECODE(item, dim) const int kb = P0_KFAST ? (item) % (dim) : (item) / (dim), nb = P0_KFAST ? (item) / (dim) : (item) % (dim)
#define P0_DIM(K_, N_) (P0_KFAST ? (K_) / 128 : (N_) / 256)
__device__ __forceinline__ void p0_item_load(const float* W, int ld, int item, int nblk, int wave, int lane, f32x4 (&v)[16]) {
    P0_DECODE(item, nblk);
    const float* src = W + (size_t)(128 * kb + 16 * wave) * ld + 256 * nb + 4 * lane;
#pragma unroll
    for (int r = 0; r < 16; ++r) v[r] = __builtin_nontemporal_load((const f32x4*)(src + (size_t)r * ld));
}
typedef const __attribute__((address_space(4))) float* CFP;
__device__ __forceinline__ CFP scalar_gain_ptr(const float* gain, int k0, int wave) { const unsigned long long a = (unsigned long long)(gain + k0 + 16 * wave);
    return (CFP)(((unsigned long long)(unsigned)__builtin_amdgcn_readfirstlane((int)(a >> 32)) << 32) | (unsigned long long)(unsigned)__builtin_amdgcn_readfirstlane((int)(unsigned)a)); }
__device__ __forceinline__ void p0_item_store(const f32x4 (&v)[16], int K, bf16_t* WT, const float* gain, int rs, int ro, int item, int nblk, LAS unsigned* T, int tid, int wave, int lane, int qf = 0) {
    P0_DECODE(item, nblk); const int k0 = 128 * kb, n0 = 256 * nb; const CFP gs = scalar_gain_ptr(gain, k0, wave);
#pragma unroll
    for (int i = 0; i < 8; ++i) { const int kp = 8 * wave + i;
        float ge = 1.f, go = 1.f; if (gain) { ge = gs[2 * i]; go = gs[2 * i + 1]; }
        if (INT8_GU2 == 1 && qf == 2) { ge *= WQ_SCALE; go *= WQ_SCALE; }
#define WQ(x) ((INT8_GU2 == 1 && qf == 2) ? qint8(x) : ((EMU_FP8 && qf == 1) ? q8(x) : (x)))
        if (qf == 4) { u32x4 wb; wb.x = cvt_pk_truebf16(v[2 * i].x * ge, v[2 * i + 1].x * go); wb.y = cvt_pk_truebf16(v[2 * i].y * ge, v[2 * i + 1].y * go); wb.z = cvt_pk_truebf16(v[2 * i].z * ge, v[2 * i + 1].z * go); wb.w = cvt_pk_truebf16(v[2 * i].w * ge, v[2 * i + 1].w * go);
            *(LAS u32x4*)(T + kp * 256 + 4 * (lane ^ ((kp >> 2) & 7))) = wb; continue; }
        u32x4 w; w.x = cvt_pk_bf16(WQ(v[2 * i].x * ge), WQ(v[2 * i + 1].x * go)); w.y = cvt_pk_bf16(WQ(v[2 * i].y * ge), WQ(v[2 * i + 1].y * go)); w.z = cvt_pk_bf16(WQ(v[2 * i].z * ge), WQ(v[2 * i + 1].z * go)); w.w = cvt_pk_bf16(WQ(v[2 * i].w * ge), WQ(v[2 * i + 1].w * go));
#undef WQ
        *(LAS u32x4*)(T + kp * 256 + 4 * (lane ^ ((kp >> 2) & 7))) = w; }
    LDS_WAIT(); __builtin_amdgcn_s_barrier(); asm volatile("" ::: "memory");
    const int q = tid & 15;
#pragma unroll
    for (int j = 0; j < 8; ++j) { const int n = (tid >> 4) + 32 * j; const LAS unsigned* r = T + (4 * q) * 256 + 4 * ((n >> 2) ^ (q & 7)) + (n & 3);
        u32x4 w; w.x = r[0]; w.y = r[256]; w.z = r[512]; w.w = r[768];
        const int ng = n0 + n, drow = (ng >> 7) * rs + (ng & 127) + ro;
        if (rs == 0) *(GAS u32x4*)(WT + ((size_t)((k0 + 8 * q) >> 6) * ro + ng) * 64 + ((k0 + 8 * q) & 63)) = w;
        else *(GAS u32x4*)(WT + (size_t)drow * K + k0 + 8 * q) = w; }
    LDS_WAIT(); __builtin_amdgcn_s_barrier(); asm volatile("" ::: "memory");
}
__device__ __forceinline__ void p0_item_store_fp8(const f32x4 (&v)[16], int K, unsigned char* WT, int item, int nblk, LAS unsigned* T, int tid, int wave, int lane) {
    P0_DECODE(item, nblk); const int k0 = 128 * kb, n0 = 256 * nb;
#pragma unroll
    for (int i = 0; i < 4; ++i) { const int kq = 4 * wave + i;
        u32x4 w; w.x = pk4_fp8(v[4 * i].x * W8_SCALE, v[4 * i + 1].x * W8_SCALE, v[4 * i + 2].x * W8_SCALE, v[4 * i + 3].x * W8_SCALE);
        w.y = pk4_fp8(v[4 * i].y * W8_SCALE, v[4 * i + 1].y * W8_SCALE, v[4 * i + 2].y * W8_SCALE, v[4 * i + 3].y * W8_SCALE);
        w.z = pk4_fp8(v[4 * i].z * W8_SCALE, v[4 * i + 1].z * W8_SCALE, v[4 * i + 2].z * W8_SCALE, v[4 * i + 3].z * W8_SCALE);
        w.w = pk4_fp8(v[4 * i].w * W8_SCALE, v[4 * i + 1].w * W8_SCALE, v[4 * i + 2].w * W8_SCALE, v[4 * i + 3].w * W8_SCALE);
        *(LAS u32x4*)(T + kq * 256 + 4 * (lane ^ ((kq >> 2) & 7))) = w; }
    LDS_WAIT(); __builtin_amdgcn_s_barrier(); asm volatile("" ::: "memory");
    const int q = tid & 7;
#pragma unroll
    for (int j = 0; j < 4; ++j) { const int n = (tid >> 3) + 64 * j; const LAS unsigned* r = T + (4 * q) * 256 + 4 * ((n >> 2) ^ (q & 7)) + (n & 3);
        u32x4 w; w.x = r[0]; w.y = r[256]; w.z = r[512]; w.w = r[768];
        *(GAS u32x4*)(WT + (size_t)(n0 + n) * K + k0 + 16 * q) = w; }
    LDS_WAIT(); __builtin_amdgcn_s_barrier(); asm volatile("" ::: "memory");
}
__device__ __forceinline__ void p0_item_store_i8(const f32x4 (&v)[16], int K, unsigned char* WT, const float* gain, int rs, int ro, int item, int nblk, LAS unsigned* T, int tid, int wave, int lane) {
    P0_DECODE(item, nblk); const int k0 = 128 * kb, n0 = 256 * nb; const CFP gs = scalar_gain_ptr(gain, k0, wave);
#pragma unroll
    for (int i = 0; i < 4; ++i) { const int kq = 4 * wave + i;
        float g0 = WQ_SCALE, g1 = WQ_SCALE, g2 = WQ_SCALE, g3 = WQ_SCALE;
        if (gain) { g0 *= gs[4 * i]; g1 *= gs[4 * i + 1]; g2 *= gs[4 * i + 2]; g3 *= gs[4 * i + 3]; }
        u32x4 w; w.x = pk4_i8(v[4 * i].x * g0, v[4 * i + 1].x * g1, v[4 * i + 2].x * g2, v[4 * i + 3].x * g3);
        w.y = pk4_i8(v[4 * i].y * g0, v[4 * i + 1].y * g1, v[4 * i + 2].y * g2, v[4 * i + 3].y * g3);
        w.z = pk4_i8(v[4 * i].z * g0, v[4 * i + 1].z * g1, v[4 * i + 2].z * g2, v[4 * i + 3].z * g3);
        w.w = pk4_i8(v[4 * i].w * g0, v[4 * i + 1].w * g1, v[4 * i + 2].w * g2, v[4 * i + 3].w * g3);
        *(LAS u32x4*)(T + kq * 256 + 4 * (lane ^ ((kq >> 2) & 7))) = w; }
    LDS_WAIT(); __builtin_amdgcn_s_barrier(); asm volatile("" ::: "memory");
    const int q = tid & 7;
#pragma unroll
    for (int j = 0; j < 4; ++j) { const int n = (tid >> 3) + 64 * j; const LAS unsigned* r = T + (4 * q) * 256 + 4 * ((n >> 2) ^ (q & 7)) + (n & 3);
        u32x4 w; w.x = r[0]; w.y = r[256]; w.z = r[512]; w.w = r[768];
        const int ng = n0 + n, drow = (ng >> 7) * rs + (ng & 127) + ro;
        *(GAS u32x4*)(WT + (size_t)drow * K + k0 + 16 * q) = w; }
    LDS_WAIT(); __builtin_amdgcn_s_barrier(); asm volatile("" ::: "memory");
}
struct TDesc { const float* src; bf16_t* dst; const float* gain; const float* gain2; int K, N, rs, ro, first, pad, ld, pad2; };
constexpr int N_TDESC = 13;

__device__ __forceinline__ void rms_row_to_bf16(const float* xrow, const float* gain, bf16_t* orow, int lane) {
    const GAS f32x4* xr = (const GAS f32x4*)xrow + lane;
    f32x4 v[16]; float s = 0.f;
#pragma unroll
    for (int j = 0; j < 16; ++j) { v[j] = xr[64 * j]; s += (v[j].x * v[j].x + v[j].y * v[j].y) + (v[j].z * v[j].z + v[j].w * v[j].w); }
    const float rstd = 1.0f / sqrtf(wave_sum(s) * (1.f / D) + NORM_EPS);
    const GAS f32x4* gr = (const GAS f32x4*)gain + lane;
    GAS u32x2* o8 = (GAS u32x2*)orow + lane;
#pragma unroll
    for (int j = 0; j < 16; ++j) { const f32x4 g = gr[64 * j]; u32x2 w; w.x = cvt_pk_bf16(v[j].x * rstd * g.x, v[j].y * rstd * g.y); w.y = cvt_pk_bf16(v[j].z * rstd * g.z, v[j].w * rstd * g.w); o8[64 * j] = w; }
}
__device__ __forceinline__ void rms_row_to_i8(const float* xrow, const float* gain, unsigned char* orow, int lane) {
    const GAS f32x4* xr = (const GAS f32x4*)xrow + lane;
    f32x4 v[16]; float s = 0.f;
#pragma unroll
    for (int j = 0; j < 16; ++j) { v[j] = xr[64 * j]; s += (v[j].x * v[j].x + v[j].y * v[j].y) + (v[j].z * v[j].z + v[j].w * v[j].w); }
    const float rstd = AQ1_SCALE / sqrtf(wave_sum(s) * (1.f / D) + NORM_EPS);
    const GAS f32x4* gr = (const GAS f32x4*)gain + lane;
    GAS unsigned* o4 = (GAS unsigned*)orow + lane;
#pragma unroll
    for (int j = 0; j < 16; ++j) { const f32x4 g = gr[64 * j]; o4[64 * j] = pk4_i8(v[j].x * rstd * g.x, v[j].y * rstd * g.y, v[j].z * rstd * g.z, v[j].w * rstd * g.w); }
}
__device__ __forceinline__ void norm_phase_i8(Frame& F, const float* src, const float* gain, unsigned char* dst) {
    const int gw = F.vcu * NWAVES + F.wave, NGW = F.G * NWAVES;
    LAS f32x4* GL = (LAS f32x4*)(F.lds + RING_OFF);
    __syncthreads();
    for (int e = F.tid; e < D / 4; e += NWAVES * 64) GL[e] = ((const f32x4*)gain)[e];
    __syncthreads();
    f32x4 vn[16];
    int m = gw;
    if (m < M) { const GAS f32x4* xr = (const GAS f32x4*)(src + (size_t)m * D) + F.lane;
#pragma unroll
        for (int j = 0; j < 16; ++j) vn[j] = xr[64 * j]; }
#define XN_ROW(m_, more_) do { f32x4 v[16]; \
        _Pragma("unroll") for (int j = 0; j < 16; ++j) v[j] = vn[j]; \
        if (more_) { const GAS f32x4* xr = (const GAS f32x4*)(src + (size_t)((m_) + NGW) * D) + F.lane; \
            _Pragma("unroll") for (int j = 0; j < 16; ++j) vn[j] = xr[64 * j]; } \
        asm volatile("" ::: "memory");        \
        float s = 0.f; \
        _Pragma("unroll") for (int j = 0; j < 16; ++j) s += (v[j].x * v[j].x + v[j].y * v[j].y) + (v[j].z * v[j].z + v[j].w * v[j].w); \
        const float rstd = AQ1_SCALE / sqrtf(wave_sum(s) * (1.f / D) + NORM_EPS); \
        GAS unsigned* o4 = (GAS unsigned*)(dst + (size_t)(m_) * D) + F.lane; \
        _Pragma("unroll") for (int j = 0; j < 16; ++j) { const f32x4 gj = GL[64 * j + F.lane]; o4[64 * j] = pk4_i8(v[j].x * rstd * gj.x, v[j].y * rstd * gj.y, v[j].z * rstd * gj.z, v[j].w * rstd * gj.w); } } while (0)
    constexpr int RPW = M / (256 * NWAVES);
    if (NGW == 256 * NWAVES) {
#pragma unroll
        for (int r = 0; r < RPW; ++r) XN_ROW(gw + r * NGW, r + 1 < RPW);
    } else { for (; m < M; m += NGW) XN_ROW(m, m + NGW < M); }
#undef XN_ROW
}
__device__ __forceinline__ void norm_phase_bf16(Frame& F, const float* src, const float* gain, bf16_t* dst) {
    const int gw = F.vcu * NWAVES + F.wave, NGW = F.G * NWAVES;
    for (int m = gw; m < M; m += NGW) rms_row_to_bf16(src + (size_t)m * D, gain, dst + (size_t)m * D, F.lane);
}
__device__ __forceinline__ void norm_phase_final(Frame& F, const bf16_t* h, const float* ps, const float* gain, float* out) {
    const int gw = F.vcu * NWAVES + F.wave, NGW = F.G * NWAVES;
    int tz = threadIdx.x; asm volatile("" : "+v"(tz)); const int ln = tz & 63;
    LAS f32x4* GL = (LAS f32x4*)(F.lds + RING_OFF);
    __syncthreads();
    for (int e = tz; e < D / 4; e += NWAVES * 64) GL[e] = ((const f32x4*)gain)[e];
    __syncthreads();
    u32x4 vn[8]; float pvn = 0.f;
    if (gw < M) { const GAS u32x4* hr = (const GAS u32x4*)(h + (size_t)gw * D) + ln;
#pragma unroll
        for (int j = 0; j < 8; ++j) vn[j] = hr[64 * j];
        pvn = (ln < 16) ? ps[(size_t)gw * 16 + ln] : 0.f; }
#define FN_ROW(m_, more_) do { \
        u32x4 v[8]; const float pv = pvn; \
        _Pragma("unroll") for (int j = 0; j < 8; ++j) v[j] = vn[j]; \
        if (more_) { const GAS u32x4* hr = (const GAS u32x4*)(h + (size_t)((m_) + NGW) * D) + ln; \
            _Pragma("unroll") for (int j = 0; j < 8; ++j) vn[j] = hr[64 * j]; \
            pvn = (ln < 16) ? ps[(size_t)((m_) + NGW) * 16 + ln] : 0.f; } \
        asm volatile("" ::: "memory");        \
        const float rstd = 1.0f / sqrtf(wave_sum(pv) * (1.f / D) + NORM_EPS); \
        GAS f32x4* o = (GAS f32x4*)(out + (size_t)(m_) * D) + 2 * ln; \
        _Pragma("unroll") for (int j = 0; j < 8; ++j) { const f32x4 ga = GL[(64 * j + ln) * 2], gb = GL[(64 * j + ln) * 2 + 1]; \
            o[128 * j] = (f32x4){bf_lo(v[j].x) * rstd * ga.x, bf_hi(v[j].x) * rstd * ga.y, bf_lo(v[j].y) * rstd * ga.z, bf_hi(v[j].y) * rstd * ga.w}; \
            o[128 * j + 1] = (f32x4){bf_lo(v[j].z) * rstd * gb.x, bf_hi(v[j].z) * rstd * gb.y, bf_lo(v[j].w) * rstd * gb.z, bf_hi(v[j].w) * rstd * gb.w}; } } while (0)
    constexpr int RPW = M / (256 * NWAVES);
    if (NGW == 256 * NWAVES) {
#pragma unroll 1
        for (int r0 = 0; r0 < RPW; r0 += 4) {
#pragma unroll
            for (int rr = 0; rr < 4; ++rr) FN_ROW(gw + (r0 + rr) * NGW, r0 + rr + 1 < RPW); }
    } else { for (int m = gw; m < M; m += NGW) FN_ROW(m, m + NGW < M); }
#undef FN_ROW
}
__device__ __forceinline__ void norm_phase_merged(Frame& F, const bf16_t* yp, const bf16_t* ys, const float* gp, const float* gs, bf16_t* dst) {
    const int gw = F.vcu * NWAVES + F.wave, NGW = F.G * NWAVES;
    for (int m = gw; m < M; m += NGW) {
#pragma unroll
        for (int half = 0; half < 2; ++half) {
            const GAS u32x4* src = (const GAS u32x4*)((half ? ys : yp) + (size_t)m * PW) + F.lane; const float* gn = half ? gs : gp;
            u32x4 v[4]; float s = 0.f;
#pragma unroll
            for (int j = 0; j < 4; ++j) { v[j] = src[64 * j];
                const float a0 = bf_lo(v[j].x), a1 = bf_hi(v[j].x), a2 = bf_lo(v[j].y), a3 = bf_hi(v[j].y), a4 = bf_lo(v[j].z), a5 = bf_hi(v[j].z), a6 = bf_lo(v[j].w), a7 = bf_hi(v[j].w);
                s += (a0 * a0 + a1 * a1) + (a2 * a2 + a3 * a3) + (a4 * a4 + a5 * a5) + (a6 * a6 + a7 * a7); }
            const float rstd = 1.0f / sqrtf(wave_sum(s) * (1.f / PW) + NORM_EPS);
            GAS u32x4* o = (GAS u32x4*)(dst + (size_t)m * D + half * PW) + F.lane;
#pragma unroll
            for (int j = 0; j < 4; ++j) { const GAS f32x4* g4 = (const GAS f32x4*)(gn + (64 * j + F.lane) * 8); const f32x4 ga = g4[0], gb = g4[1];
                u32x4 w; w.x = cvt_pk_bf16(bf_lo(v[j].x) * rstd * ga.x, bf_hi(v[j].x) * rstd * ga.y); w.y = cvt_pk_bf16(bf_lo(v[j].y) * rstd * ga.z, bf_hi(v[j].y) * rstd * ga.w);
                w.z = cvt_pk_bf16(bf_lo(v[j].z) * rstd * gb.x, bf_hi(v[j].z) * rstd * gb.y); w.w = cvt_pk_bf16(bf_lo(v[j].w) * rstd * gb.z, bf_hi(v[j].w) * rstd * gb.w);
                o[64 * j] = w; }
        }
    }
}
__device__ __forceinline__ void unpack8(const u32x4 v, float (&f)[8]) { f[0] = bf_lo(v.x); f[1] = bf_hi(v.x); f[2] = bf_lo(v.y); f[3] = bf_hi(v.y); f[4] = bf_lo(v.z); f[5] = bf_hi(v.z); f[6] = bf_lo(v.w); f[7] = bf_hi(v.w); }
__device__ __forceinline__ void pool_diff_phase(Frame& F, const bf16_t* z, bf16_t* d, int first_wg, int n_wg) {
    const int gw = (F.vcu - first_wg) * NWAVES + F.wave, NGW = n_wg * NWAVES;
    if (F.vcu < first_wg || F.vcu >= first_wg + n_wg) return;
    for (int it = gw; it < (M / 32) * 4; it += NGW) {
        const int g = it & 3, run = it >> 2, tok0 = run * 32, t0 = tok0 & (SEQ - 1), w = 2 << g;
        const GAS u32x4* zp = (const GAS u32x4*)(z + (size_t)tok0 * PW + g * PGW) + F.lane;
        GAS u32x4* dp = (GAS u32x4*)(d + (size_t)tok0 * PW + g * PGW) + F.lane;
        float sum[8];
#pragma unroll
        for (int e = 0; e < 8; ++e) sum[e] = 0.f;
        for (int s = 1; s < w; ++s) { if (t0 - s >= 0) { float f[8]; unpack8(zp[-(long)s * (PW / 8)], f);
#pragma unroll
            for (int e = 0; e < 8; ++e) sum[e] += f[e]; } }
        for (int r = 0; r < 32; ++r) {
            const int t = t0 + r; float f[8]; unpack8(zp[(long)r * (PW / 8)], f);
#pragma unroll
            for (int e = 0; e < 8; ++e) sum[e] += f[e];
            const int cnt = (t + 1 < w) ? (t + 1) : w; const float inv = 1.0f / (float)cnt;
            u32x4 o; o.x = cvt_pk_bf16(sum[0] * inv - f[0], sum[1] * inv - f[1]); o.y = cvt_pk_bf16(sum[2] * inv - f[2], sum[3] * inv - f[3]);
            o.z = cvt_pk_bf16(sum[4] * inv - f[4], sum[5] * inv - f[5]); o.w = cvt_pk_bf16(sum[6] * inv - f[6], sum[7] * inv - f[7]);
            dp[(long)r * (PW / 8)] = o;
            if (t - w + 1 >= 0) { float q[8]; unpack8(zp[(long)(r - w + 1) * (PW / 8)], q);
#pragma unroll
                for (int e = 0; e < 8; ++e) sum[e] -= q[e]; }
        }
    }
}

__device__ __forceinline__ void pool_out_phase(Frame& F, const bf16_t* z, bf16_t* ym, const float* scale, float* ps2, int first_wg, int n_wg) {
    const int gw = (F.vcu - first_wg) * NWAVES + F.wave, NGW = n_wg * NWAVES;
    if (F.vcu < first_wg || F.vcu >= first_wg + n_wg) return;
    for (int it = gw; it < (M / 32) * 4; it += NGW) {
        const int g = it & 3, run = it >> 2, tok0 = run * 32, t0 = tok0 & (SEQ - 1), w = 2 << g;
        const GAS u32x4* zp = (const GAS u32x4*)(z + (size_t)tok0 * PW + g * PGW) + F.lane;
        GAS u32x4* yp = (GAS u32x4*)(ym + (size_t)tok0 * D + g * PGW) + F.lane;
        const GAS f32x4* sp = (const GAS f32x4*)(scale + g * PGW + F.lane * 8); const f32x4 sa = sp[0], sb = sp[1];
        const float sc[8] = {sa.x, sa.y, sa.z, sa.w, sb.x, sb.y, sb.z, sb.w};
        float sum[8];
#pragma unroll
        for (int e = 0; e < 8; ++e) sum[e] = 0.f;
        for (int s = 1; s < w; ++s) { if (t0 - s >= 0) { float f[8]; unpack8(zp[-(long)s * (PW / 8)], f);
#pragma unroll
            for (int e = 0; e < 8; ++e) sum[e] += f[e]; } }
        for (int r = 0; r < 32; ++r) {
            const int t = t0 + r; float f[8]; unpack8(zp[(long)r * (PW / 8)], f);
#pragma unroll
            for (int e = 0; e < 8; ++e) sum[e] += f[e];
            const int cnt = (t + 1 < w) ? (t + 1) : w; const float inv = 1.0f / (float)cnt;
            float o[8]; float ss = 0.f;
#pragma unroll
            for (int e = 0; e < 8; ++e) { o[e] = (sum[e] * inv - f[e]) * sc[e]; ss += o[e] * o[e]; }
            u32x4 ov; ov.x = cvt_pk_bf16(o[0], o[1]); ov.y = cvt_pk_bf16(o[2], o[3]); ov.z = cvt_pk_bf16(o[4], o[5]); ov.w = cvt_pk_bf16(o[6], o[7]);
            yp[(long)r * (D / 8)] = ov;
            ss = wave_sum(ss);
            if (F.lane == 0) { ps2[(size_t)(tok0 + r) * 16 + g] = ss; ps2[(size_t)(tok0 + r) * 16 + 4 + g] = 0.f; }
            if (t - w + 1 >= 0) { float q[8]; unpack8(zp[(long)(r - w + 1) * (PW / 8)], q);
#pragma unroll
                for (int e = 0; e < 8; ++e) sum[e] -= q[e]; }
        }
    }
}
constexpr int PST = 65;
__device__ __forceinline__ void s5_tables_group(Frame& F, const Args& a, int g, int part) {
    LAS float* Bre = (LAS float*)(F.lds + RING_OFF);
    LAS float* Bim = Bre + 64 * 16;
    LAS float* Pre = Bim + 64 * 16;
    LAS float* Pim = Pre + 65 * PST;
    LAS float* Cre = Pim + 65 * PST;
    LAS float* Cim = Cre + 16 * PST;
    const int t = F.tid;
    const float dt = expf(a.in[I_LOGDT][g]);
    if (t < 64) {
        const int p = t;
        const float lr = a.in[I_LRE][g * SP + p], li = a.in[I_LIM][g * SP + p];
        const float mag = expf(lr * dt), ang = li * dt;
        const float br = mag * cosf(ang), bi = mag * sinf(ang);
        const float nr = br - 1.0f, ni = bi, den = 1.0f / (lr * lr + li * li);
        const float cr = (nr * lr + ni * li) * den, ci = (ni * lr - nr * li) * den;
        for (int h = 0; h < SH; ++h) { const float xr = a.in[I_BRE][(g * SP + p) * SH + h], xi = a.in[I_BIM][(g * SP + p) * SH + h]; Bre[p * 16 + h] = cr * xr - ci * xi; Bim[p * 16 + h] = cr * xi + ci * xr; }
        float pr = 1.0f, pi = 0.0f;
        for (int k = 0; k <= 64; ++k) { Pre[k * PST + p] = pr; Pim[k * PST + p] = pi; const float qr = pr * br - pi * bi, qi = pr * bi + pi * br; pr = qr; pi = qi; }
        if (part == 0) { float* lp = (float*)(a.ws + WS_LP) + ((size_t)g * SP + p) * 2; lp[0] = Pre[64 * PST + p]; lp[1] = Pim[64 * PST + p]; }
    }
    for (int e = t; e < SH * SP; e += NWAVES * 64) { Cre[(e >> 6) * PST + (e & 63)] = a.in[I_CRE][(size_t)g * SH * SP + e]; Cim[(e >> 6) * PST + (e & 63)] = a.in[I_CIM][(size_t)g * SH * SP + e]; }
    __syncthreads();
    if (part == 0) {
        bf16_t* kl = (bf16_t*)(a.ws + WS_KL) + (size_t)g * 32768;
        for (int ci = t; ci < 64 * 16; ci += NWAVES * 64) {
            const int lag = ci >> 4, hp = ci & 15;
            float acc[16];
#pragma unroll
            for (int h = 0; h < 16; ++h) acc[h] = 0.f;
#pragma unroll 2
            for (int p = 0; p < 64; ++p) {
                const float c1 = Cre[hp * PST + p], c2 = Cim[hp * PST + p], p1 = Pre[lag * PST + p], p2 = Pim[lag * PST + p];
                const float ar = c1 * p1 - c2 * p2, ai = c1 * p2 + c2 * p1;
#pragma unroll
                for (int h4 = 0; h4 < 4; ++h4) { const f32x4 b1 = *(const LAS f32x4*)(Bre + p * 16 + 4 * h4), b2 = *(const LAS f32x4*)(Bim + p * 16 + 4 * h4);
                    acc[4 * h4 + 0] += ar * b1.x - ai * b2.x; acc[4 * h4 + 1] += ar * b1.y - ai * b2.y; acc[4 * h4 + 2] += ar * b1.z - ai * b2.z; acc[4 * h4 + 3] += ar * b1.w - ai * b2.w; }
            }
            if (lag == 0) {
                const float dsk = a.in[I_DSKIP][g * SH + hp];
#pragma unroll
                for (int h = 0; h < 16; ++h) acc[h] += (h == hp) ? dsk : 0.f;
            }
            u32x4 w0, w1; w0.x = pk2(acc[0], acc[1]); w0.y = pk2(acc[2], acc[3]); w0.z = pk2(acc[4], acc[5]); w0.w = pk2(acc[6], acc[7]);
            w1.x = pk2(acc[8], acc[9]); w1.y = pk2(acc[10], acc[11]); w1.z = pk2(acc[12], acc[13]); w1.w = pk2(acc[14], acc[15]);
            GAS u32x4* o = (GAS u32x4*)(kl + (lag + 63) * 256 + hp * 16); o[0] = w0; o[1] = w1;
        }
        const u32x4 zz = {0u, 0u, 0u, 0u};
        for (int e = t; e < 63 * 32; e += NWAVES * 64) ((GAS u32x4*)kl)[e] = zz;
        for (int e = t; e < 32; e += NWAVES * 64) ((GAS u32x4*)(kl + 127 * 256))[e] = zz;
    }
    if (part == 1) {
        bf16_t* wcp = (bf16_t*)(a.ws + WS_WC) + (size_t)g * 1024 * 128;
        for (int e8 = t; e8 < 1024 * 16; e8 += NWAVES * 64) { const int q0 = (e8 & 15) * 8, n = e8 >> 4, j = n >> 4, hp = n & 15, p0 = q0 & 63; const bool im = q0 >= 64;
            float v[8];
#pragma unroll
            for (int x = 0; x < 8; ++x) { const float c1 = Cre[hp * PST + p0 + x], c2 = Cim[hp * PST + p0 + x], p1 = Pre[(j + 1) * PST + p0 + x], p2 = Pim[(j + 1) * PST + p0 + x];
                v[x] = im ? -(c1 * p2 + c2 * p1) : (c1 * p1 - c2 * p2); }
            u32x4 w; w.x = pk2(v[0], v[1]); w.y = pk2(v[2], v[3]); w.z = pk2(v[4], v[5]); w.w = pk2(v[6], v[7]);
            ((GAS u32x4*)wcp)[e8] = w; }
    }
    if (part == 1) {
        bf16_t* wsp = (bf16_t*)(a.ws + WS_WS) + (size_t)g * 128 * 1024;
        for (int e8 = t; e8 < 128 * 128; e8 += NWAVES * 64) { const int k0 = (e8 & 127) * 8, q = e8 >> 7, i = k0 >> 4, h0 = k0 & 15, p = q & 63; const bool im = q >= 64;
            const float p1 = Pre[(63 - i) * PST + p], p2 = Pim[(63 - i) * PST + p];
            float v[8];
#pragma unroll
            for (int x = 0; x < 8; ++x) { const float b1 = Bre[p * 16 + h0 + x], b2 = Bim[p * 16 + h0 + x]; v[x] = im ? (p1 * b2 + p2 * b1) : (p1 * b1 - p2 * b2); }
            u32x4 w; w.x = pk2(v[0], v[1]); w.y = pk2(v[2], v[3]); w.z = pk2(v[4], v[5]); w.w = pk2(v[6], v[7]);
            ((GAS u32x4*)wsp)[e8] = w; }
    }
    __syncthreads();
}

typedef const __attribute__((address_space(4))) Args* KArgsT;
__device__ __forceinline__ void p0_prologue(Frame& F) {
    KArgsT ap0 = (KArgsT)__builtin_amdgcn_kernarg_segment_ptr(); asm volatile("" : "+s"(ap0)); Args a;
#pragma unroll
    for (int i = 0; i < N_IN; ++i) a.in[i] = ap0->in[i];
    a.out = ap0->out; a.ws = ap0->ws; a.ph_lo = 0; a.ph_hi = 0; a.li = 0; a.pad = 0;
#ifndef PRO_REP
#define PRO_REP 0
#endif
    for (int rp = 0; rp <= (PRO_REP & 1); ++rp)
    for (int w = F.vcu; w < 2 * SG; w += F.G) s5_tables_group(F, a, w & (SG - 1), w >> 7);
    __syncthreads();
    LAS TDesc* td = (LAS TDesc*)(F.lds + RING_OFF + RING_BYTES - 1024);
    if (F.tid == 0) {
        int first = 0, k = 0;
#define TD(SRC, DST, K_, N_, RS, RO, GAIN) do { td[k].src = (SRC); td[k].dst = (bf16_t*)(DST); td[k].gain = (GAIN); td[k].gain2 = nullptr; td[k].K = (K_); td[k].N = (N_); td[k].ld = (N_); td[k].pad2 = 0; td[k].rs = (RS); td[k].ro = (RO); td[k].first = first; td[k].pad = (k == 12) ? 1 : ((k == 10 || k == 11) ? 2 : ((k == 0 || k == 1) ? 3 : ((k == 2 && F16 && DOWN1_BF16) ? 4 : 0))); first += ((K_) / 128) * ((N_) / 256); ++k; } while (0)
        TD(a.in[I_G1], a.ws + WS_WGU1, D, FF, 256, 0, nullptr);
        TD(a.in[I_U1], a.ws + WS_WGU1, D, FF, 256, 128, nullptr);
        if (WD_TILED) TD(a.in[I_D1], a.ws + WS_WD1, FF, D, 0, D, nullptr); else TD(a.in[I_D1], a.ws + WS_WD1, FF, D, 128, 0, nullptr);
        if (POOL_PREMUL) { TD(a.in[I_WIN] + PW, a.ws + WS_WIN, D, SW, 128, PW, a.in[I_MIXN]); td[k - 1].ld = D; }
        else TD(a.in[I_WIN], a.ws + WS_WIN, D, D, 128, 0, a.in[I_MIXN]);
        TD(a.in[I_WPOOL] + 0 * PGW * PGW, a.ws + WS_WPOOL + 0 * PGW * PGW * 2, PGW, PGW, 128, 0, nullptr);
        TD(a.in[I_WPOOL] + 1 * PGW * PGW, a.ws + WS_WPOOL + 1 * PGW * PGW * 2, PGW, PGW, 128, 0, nullptr);
        TD(a.in[I_WPOOL] + 2 * PGW * PGW, a.ws + WS_WPOOL + 2 * PGW * PGW * 2, PGW, PGW, 128, 0, nullptr);
        TD(a.in[I_WPOOL] + 3 * PGW * PGW, a.ws + WS_WPOOL + 3 * PGW * PGW * 2, PGW, PGW, 128, 0, nullptr);
        TD(a.in[I_WGLU], a.ws + WS_WGLU, SW, SW, 128, 0, nullptr);
        TD(a.in[I_WOUT], a.ws + WS_WOUT, D, D, 128, 0, a.in[I_PON]); td[k - 1].gain2 = a.in[I_SON];
        TD(a.in[I_G2], a.ws + WS_WGU2, D, FF, 256, 0, a.in[I_N2]);
        TD(a.in[I_U2], a.ws + WS_WGU2, D, FF, 256, 128, a.in[I_N2]);
        if (WD_TILED && !FP8_DOWN2) TD(a.in[I_D2], a.ws + WS_WD2, FF, D, 0, D, nullptr); else TD(a.in[I_D2], a.ws + WS_WD2, FF, D, 128, 0, nullptr);
#undef TD
        ((LAS int*)(td + N_TDESC))[0] = first;
    }
    __syncthreads();
    const int nitems = ((LAS int*)(td + N_TDESC))[0];
    LAS unsigned* T = (LAS unsigned*)(F.lds + RING_OFF);
    for (int rp = 0; rp <= ((PRO_REP >> 1) & 1); ++rp) {
    f32x4 vn[16];
    int it = F.vcu;
#define TD_FIND(IT, KK) do { KK = 0; _Pragma("unroll") for (int q_ = 1; q_ < N_TDESC; ++q_) KK += ((IT) >= td[q_].first) ? 1 : 0; } while (0)
    if (it < nitems) { int k; TD_FIND(it, k); p0_item_load(td[k].src, td[k].ld, it - td[k].first, P0_DIM(td[k].K, td[k].N), F.wave, F.lane, vn); }
    for (; it < nitems; it += F.G) {
        f32x4 vc[16];
#pragma unroll
        for (int r = 0; r < 16; ++r) vc[r] = vn[r];
        const int nx = it + F.G;
        if (nx < nitems) { int k; TD_FIND(nx, k); p0_item_load(td[k].src, td[k].ld, nx - td[k].first, P0_DIM(td[k].K, td[k].N), F.wave, F.lane, vn); }
        int k; TD_FIND(it, k);
        if ((INT8_GU2 == 2 && td[k].pad == 2) || (INT8_GU1 && td[k].pad == 3)) p0_item_store_i8(vc, td[k].K, (unsigned char*)td[k].dst, td[k].gain, td[k].rs, td[k].ro, it - td[k].first, P0_DIM(td[k].K, td[k].N), T, F.tid, F.wave, F.lane);
        else if (FP8_DOWN2 && td[k].pad == 1) p0_item_store_fp8(vc, td[k].K, (unsigned char*)td[k].dst, it - td[k].first, P0_DIM(td[k].K, td[k].N), T, F.tid, F.wave, F.lane);
        else { const int itl = it - td[k].first, nblk = P0_DIM(td[k].K, td[k].N); const float* gn = td[k].gain; if (td[k].gain2 && 128 * (P0_KFAST ? itl % nblk : itl / nblk) >= td[k].K / 2) gn = td[k].gain2 - td[k].K / 2;
            p0_item_store(vc, td[k].K, td[k].dst, gn, td[k].rs, td[k].ro, itl, nblk, T, F.tid, F.wave, F.lane, td[k].pad); }
    }
    }
#undef TD_FIND
    for (int rp = 0; rp <= ((PRO_REP >> 2) & 1); ++rp)
    if (POOL_PREMUL) {
        const int gt = F.vcu * (NWAVES * 64) + F.tid, NT = F.G * NWAVES * 64; const float* wi = a.in[I_WIN]; bf16_t* wp = (bf16_t*)(a.ws + WS_WINP);
        for (int e = gt; e < D * (PW / 8); e += NT) { const int k = e >> 8, c8 = e & 255; const f32x4 v0 = __builtin_nontemporal_load((const f32x4*)(wi + (size_t)k * D + c8 * 8)), v1 = __builtin_nontemporal_load((const f32x4*)(wi + (size_t)k * D + c8 * 8 + 4));
            u32x4 w; w.x = cvt_pk_bf16(v0.x, v0.y); w.y = cvt_pk_bf16(v0.z, v0.w); w.z = cvt_pk_bf16(v1.x, v1.y); w.w = cvt_pk_bf16(v1.z, v1.w); *(GAS u32x4*)(wp + (size_t)k * PW + c8 * 8) = w; } }
    if (INT8_GU1) norm_phase_i8(F, a.in[I_X], a.in[I_N1], a.ws + WS_XN); else
    norm_phase_bf16(F, a.in[I_X], a.in[I_N1], (bf16_t*)(a.ws + WS_XN));
}

constexpr int N_PHASES = 14;
__global__ void __launch_bounds__(NWAVES * 64, 2) fwd_kernel(Args args) {
    extern __shared__ __attribute__((aligned(16))) unsigned char lds[];
    Frame F;
    F.lds = (LAS unsigned char*)lds;
    F.MISC = (volatile LAS unsigned*)(F.lds + MISC_OFF);
    F.tid = threadIdx.x; F.lane = F.tid & 63; F.wave = __builtin_amdgcn_readfirstlane(F.tid >> 6);
    F.G = gridDim.x; { const int bx = blockIdx.x; F.vcu = (F.G % 8 == 0) ? (bx % 8) * (F.G / 8) + bx / 8 : bx; }
    typedef const __attribute__((address_space(4))) Args* KArgs;
#define FRESH_ARGS() KArgs ap = (KArgs)__builtin_amdgcn_kernarg_segment_ptr(); asm volatile("" : "+s"(ap)); unsigned char* const ws = ap->ws; (void)ws
    int lo, hi;
    { FRESH_ARGS(); F.ctl = (unsigned*)(ws + WS_CTL); lo = ap->ph_lo; hi = ap->ph_hi; }
    for (int u = F.tid; u < (LDS_BYTES - LDSCTL_OFF) / 4; u += NWAVES * 64) ((LAS unsigned*)(F.lds + LDSCTL_OFF))[u] = 0u;
    __syncthreads();
    XcdBarrier bar; bar.bar = F.ctl + CW_BAR; bar.x = 0; bar.st = nullptr;
    if (MK_N_LAUNCHES == 1) bar = xcd_barrier_post(F.ctl + CW_BAR, F.MISC + 8);
#define GRID_BAR() do { if (MK_N_LAUNCHES == 1) xcd_barrier(bar); } while (0)
#ifndef PH_MASK
#define PH_MASK 0x3fff
#endif
#define IN(k) (((PH_MASK >> (k)) & 1) && lo <= (k) && (k) < hi)
#define BOTH(k) (IN(k) && IN((k) + 1))
#define XN ((bf16_t*)(ws + WS_XN))
#define HB ((bf16_t*)(ws + WS_H))
#define ZPOOL ((bf16_t*)(ws + WS_ZPOOL))
#define AS5 ((bf16_t*)(ws + WS_AS5))
#define DPOOL ((bf16_t*)(ws + WS_DPOOL))
#define YB ((bf16_t*)(ws + WS_Y))
#define YPOOL ((bf16_t*)(ws + WS_YPOOL))
#define YSSM ((bf16_t*)(ws + WS_YSSM))
#define X1 ((bf16_t*)(ws + WS_X1))
#define X2 ((bf16_t*)(ws + WS_X2))
#define PS ((float*)(ws + WS_PS))
    const int bx = (int)blockIdx.x;
#ifndef WGM_DOWN
#define WGM_DOWN 2
#endif
#ifndef WGM_GU
#define WGM_GU 8
#endif
#ifndef REP_MASK
#define REP_MASK 0
#endif
#define PHASE(k) if (IN(k)) for (int rep_ = 0; rep_ <= ((REP_MASK >> (k)) & 1); ++rep_)
#define SEAM(k) if (BOTH(k)) GRID_BAR()
    PHASE(0) { FRESH_ARGS(); p0_prologue(F); } SEAM(0);
    PHASE(1) { FRESH_ARGS(); pg8::PlainGemm P;
        if (INT8_GU1) P.init(XN, ws + WS_WGU1, M, 2 * FF, D / 2, D / 2, D / 2, F.G, bx, WGM_GU); else P.init(XN, ws + WS_WGU1, M, 2 * FF, D, D, D, F.G, bx);
        pg8::EpiSwiGLU<false, false, INT8_GU1 != 0, (F16 && DOWN1_BF16)> E{HB, nullptr, -1, INT8_GU1 ? 1.0f / (AQ1_SCALE * WQ_SCALE) : 1.0f};
        pg8::gemm_phase<pg8::EpiSwiGLU<false, false, INT8_GU1 != 0, (F16 && DOWN1_BF16)>, pg8::PlainGemm, PG8_ALIGN, PG8_SP2, INT8_GU1 ? 2 : 0>(F.lds + RING_OFF, P, E);
        if (POOL_PREMUL) {
            __syncthreads();
            const int half = F.G / 2; const bool tailidle = (F.G == 256);
            pg8::CombGemm C; C.init(ws + WS_WPOOL, ws + WS_WINP, tailidle ? half : F.G, tailidle ? (bx >= half ? bx - half : -1) : bx); pg8::EpiComb EC{(bf16_t*)(ws + WS_WIN), ap->in[I_MIXN]};
            pg8::gemm_phase<pg8::EpiComb, pg8::CombGemm, PG8_ALIGN, PG8_SP2>(F.lds + RING_OFF, C, EC); } } SEAM(1);
    PHASE(2) { FRESH_ARGS(); pg8::PlainGemm P; if (H_TILED && WD_TILED) P.init_tiledAB(HB, ws + WS_WD1, M, D, FF, F.G, bx, WGM_DOWN); else if (H_TILED) P.init_tiledA(HB, ws + WS_WD1, M, D, FF, FF, F.G, bx, WGM_DOWN); else P.init(HB, ws + WS_WD1, M, D, FF, FF, FF, F.G, bx, WGM_DOWN); if (DOWN_REVK) P.reverse_k(); pg8::EpiResNorm<true> E{ap->in[I_X], 0.5f, X1, PS, nullptr};
        pg8::gemm_phase<pg8::EpiResNorm<true>, pg8::PlainGemm, PG8_ALIGN, PG8_SP2, (F16 && DOWN1_BF16) ? 3 : 0>(F.lds + RING_OFF, P, E); } SEAM(2);
    PHASE(4) { FRESH_ARGS(); pg8::PlainGemm P; P.init(X1, ws + WS_WIN, M, D, D, D, D, F.G, bx); pg8::Unit u0; const int pm0 = P.next(0, u0) ? u0.pm : -1; pg8::rstd_table(PS, pm0, F.lds, F.tid); pg8::EpiZ E{ZPOOL, AS5, PS, pm0};
        pg8::gemm_phase<pg8::EpiZ, pg8::PlainGemm, PG8_ALIGN, PG8_SP2>(F.lds + RING_OFF, P, E); } SEAM(4);
    PHASE(5) { FRESH_ARGS();
        const bool split = (F.G == 2 * SG);
        if (POOL_PREMUL) { if (split) pool_out_phase(F, ZPOOL, XN, ap->in[I_PSCALE], (float*)(ws + WS_PS2), SG, F.G - SG); else pool_out_phase(F, ZPOOL, XN, ap->in[I_PSCALE], (float*)(ws + WS_PS2), 0, F.G); }
        else if (split) pool_diff_phase(F, ZPOOL, DPOOL, SG, F.G - SG); else pool_diff_phase(F, ZPOOL, DPOOL, 0, F.G);
        VM_WAIT(); __syncthreads();
        pg8::S5CarryGemm P; P.init(AS5, ws + WS_WS, split ? SG : F.G, split ? (F.vcu < SG ? F.vcu : SG) : bx); pg8::EpiCarry E{AS5, (const float*)(ws + WS_LP)};
        pg8::gemm_phase<pg8::EpiCarry, pg8::S5CarryGemm, false, PG8_SP2>(F.lds + RING_OFF, P, E); __syncthreads(); } SEAM(5);
    PHASE(6) { FRESH_ARGS(); if (!POOL_PREMUL) { pg8::PoolGemm P; P.init(DPOOL, ws + WS_WPOOL, F.G, bx); pg8::EpiPool E{XN, ap->in[I_PSCALE], (float*)(ws + WS_PS2)};
          pg8::gemm_phase<pg8::EpiPool, pg8::PoolGemm, PG8_ALIGN, PG8_SP2>(F.lds + RING_OFF, P, E); }
        { pg8::S5OutGemm P; P.init(AS5, ws + WS_KL, ws + WS_WC, F.G, bx); pg8::EpiS5Y E{YB};
          pg8::gemm_phase<pg8::EpiS5Y, pg8::S5OutGemm, PG8_ALIGN, PG8_SP2>(F.lds + RING_OFF, P, E); } } SEAM(6);
    PHASE(7) { FRESH_ARGS(); pg8::PlainGemm P; P.init(YB, ws + WS_WGLU, M, SW, SW, SW, SW, F.G, bx); pg8::EpiGLU E{YB, XN, ap->in[I_BGLU], (float*)(ws + WS_PS2)};
        pg8::gemm_phase<pg8::EpiGLU, pg8::PlainGemm, PG8_ALIGN, PG8_SP2>(F.lds + RING_OFF, P, E); } SEAM(7);
    PHASE(9) { FRESH_ARGS(); pg8::PlainGemm P; P.init(XN, ws + WS_WOUT, M, D, D, D, D, F.G, bx); P.tmid = PW / pg8::BK;
        pg8::Unit u0; const int pm0 = P.next(0, u0) ? u0.pm : -1; pg8::rstd2_table((const float*)(ws + WS_PS2), pm0, F.lds, F.tid);
        pg8::EpiResNorm<false, INT8_GU2, true> E{X1, 1.0f, X2, PS, ws + WS_X2Q};
        pg8::gemm_phase<pg8::EpiResNorm<false, INT8_GU2, true>, pg8::PlainGemm, PG8_ALIGN, PG8_SP2>(F.lds + RING_OFF, P, E); } SEAM(9);
    PHASE(11) { FRESH_ARGS(); pg8::PlainGemm P;
        if (INT8_GU2 == 2) P.init(ws + WS_X2Q, ws + WS_WGU2, M, 2 * FF, D / 2, D / 2, D / 2, F.G, bx, WGM_GU);
        else P.init(INT8_GU2 == 1 ? (bf16_t*)(ws + WS_X2Q) : X2, ws + WS_WGU2, M, 2 * FF, D, D, D, F.G, bx);
        pg8::Unit u0; const int pm0 = P.next(0, u0) ? u0.pm : -1; pg8::rstd_table(PS, pm0, F.lds, F.tid);
        pg8::EpiSwiGLU<true, FP8_DOWN2 != 0, INT8_GU2 == 2> E{HB, PS, pm0, INT8_GU2 ? 1.0f / (AQ_SCALE * WQ_SCALE) : 1.0f};
        pg8::gemm_phase<pg8::EpiSwiGLU<true, FP8_DOWN2 != 0, INT8_GU2 == 2>, pg8::PlainGemm, PG8_ALIGN, PG8_SP2, INT8_GU2 == 2 ? 2 : 0>(F.lds + RING_OFF, P, E); } SEAM(11);
#if FP8_DOWN2
    PHASE(12) { FRESH_ARGS(); pg8::PlainGemm P; P.init_tiledA(HB, ws + WS_WD2, M, D, FF / 2, FF / 2, F.G, bx, WGM_DOWN); pg8::EpiResNorm<false> E{X2, 0.5f / (H8_SCALE * W8_SCALE), X1, PS, nullptr};
        pg8::gemm_phase<pg8::EpiResNorm<false>, pg8::PlainGemm, PG8_ALIGN, PG8_SP2, 1>(F.lds + RING_OFF, P, E); } SEAM(12);
#else
    PHASE(12) { FRESH_ARGS(); pg8::PlainGemm P; if (H_TILED && WD_TILED) P.init_tiledAB(HB, ws + WS_WD2, M, D, FF, F.G, bx, WGM_DOWN); else if (H_TILED) P.init_tiledA(HB, ws + WS_WD2, M, D, FF, FF, F.G, bx, WGM_DOWN); else P.init(HB, ws + WS_WD2, M, D, FF, FF, FF, F.G, bx, WGM_DOWN); if (DOWN_REVK) P.reverse_k(); pg8::EpiResNorm<false> E{X2, 0.5f, X1, PS, nullptr};
        pg8::gemm_phase<pg8::EpiResNorm<false>, pg8::PlainGemm, PG8_ALIGN, PG8_SP2>(F.lds + RING_OFF, P, E); } SEAM(12);
#endif
    PHASE(13) { FRESH_ARGS(); norm_phase_final(F, X1, PS, ap->in[I_FN], ap->out); }
#undef PHASE
#undef SEAM
#undef IN
#undef BOTH
#undef FRESH_ARGS
#undef GRID_BAR
}

extern "C" void kernel_launch(void* const* d_in, const int* in_sizes, int n_in, void* d_out, int out_size, void* d_ws, size_t ws_size, hipStream_t stream) {
    static int grid = 0;
    if (grid == 0) {
        if (n_in != N_IN || in_sizes[0] != M * D || out_size != M * D || ws_size < WS_END) { fprintf(stderr, "kernel_launch: unexpected shapes (n_in %d, in0 %d, out %d, ws %zu)\n", n_in, n_in > 0 ? in_sizes[0] : -1, out_size, ws_size); grid = -1; return; }
        int dev = 0, cus = 0, per_cu = 0;
        if (hipGetDevice(&dev) != hipSuccess || hipDeviceGetAttribute(&cus, hipDeviceAttributeMultiprocessorCount, dev) != hipSuccess) { grid = -1; return; }
        if (hipFuncSetAttribute((const void*)fwd_kernel, hipFuncAttributeMaxDynamicSharedMemorySize, LDS_BYTES) != hipSuccess) { fprintf(stderr, "kernel_launch: hipFuncSetAttribute failed\n"); grid = -1; return; }
        if (hipOccupancyMaxActiveBlocksPerMultiprocessor(&per_cu, (const void*)fwd_kernel, NWAVES * 64, LDS_BYTES) != hipSuccess || per_cu < 1) fprintf(stderr, "kernel_launch: occupancy query says %d\n", per_cu);
        (void)hipGetLastError();
        grid = cus;
    }
    if (grid < 0) return;
    if (hipMemsetAsync((char*)d_ws + WS_CTL, 0, CTL_ZERO_BYTES, stream) != hipSuccess) return;
    Args a{};
    for (int i = 0; i < N_IN; ++i) a.in[i] = (const float*)d_in[i];
    a.out = (float*)d_out; a.ws = (unsigned char*)d_ws; a.pad = 0;
    if (MK_N_LAUNCHES == 1) { a.ph_lo = 0; a.ph_hi = N_PHASES; a.li = 0; hipLaunchKernelGGL(fwd_kernel, dim3(grid), dim3(NWAVES * 64), LDS_BYTES, stream, a); }
    else for (int p = 0; p < N_PHASES; ++p) { a.ph_lo = p; a.ph_hi = p + 1; a.li = p; hipLaunchKernelGGL(fwd_kernel, dim3(grid), dim3(NWAVES * 64), LDS_BYTES, stream, a); }
}
```

```cpp
#include <hip/hip_runtime.h>
#include <cstdio>
#include <cstdint>

#define LAS __attribute__((address_space(3)))
#define GAS __attribute__((address_space(1)))
typedef unsigned short bf16_t;
typedef short bf16x8 __attribute__((ext_vector_type(8)));
typedef float f32x4 __attribute__((ext_vector_type(4)));
typedef float f32x2 __attribute__((ext_vector_type(2)));
typedef unsigned u32x4 __attribute__((ext_vector_type(4)));
typedef unsigned u32x2 __attribute__((ext_vector_type(2)));

#ifndef MK_N_LAUNCHES
#define MK_N_LAUNCHES 1
#endif
#ifndef PG8_SP2
#define PG8_SP2 true
#endif
#ifndef PG8_ALIGN
#define PG8_ALIGN true
#endif
#ifndef EPI_TWICE
#define EPI_TWICE 0
#endif
#ifndef DUP_MFMA
#define DUP_MFMA 0
#endif
#ifndef PG8_SPLIT
#define PG8_SPLIT 0
#endif
#ifndef FP8_SCALE_ARG
#define FP8_SCALE_ARG 0
#endif
#ifndef MMA_NM
#define MMA_NM 1
#endif
#ifndef MMA_PIN
#define MMA_PIN 1
#endif

constexpr int BATCH = 8, SEQ = 2048, D = 4096, M = BATCH * SEQ, FF = 11008;
constexpr int PW = 2048, SW = 2048, PGW = 512;
constexpr int SG = 128, SH = 16, SP = 64;
constexpr int CL = 64, CR = M / CL;
constexpr int AK = CL * SH + 2 * SP;
constexpr float NORM_EPS = 1e-6f;

constexpr size_t MiB = 1u << 20;
constexpr size_t WS_CTL = 0, CTL_ZERO_BYTES = 65536;
constexpr size_t WS_WGU1 = 1 * MiB, WS_WD1 = 173 * MiB, WS_WGU2 = 259 * MiB, WS_WD2 = 431 * MiB;
constexpr size_t WS_WIN = 517 * MiB, WS_WOUT = 549 * MiB, WS_WGLU = 581 * MiB, WS_WPOOL = 589 * MiB;
constexpr size_t WS_KL = 591 * MiB;
constexpr size_t WS_WC = 599 * MiB;
constexpr size_t WS_WS = 631 * MiB;
constexpr size_t WS_LP = 663 * MiB;
constexpr size_t WS_XN = 664 * MiB;
constexpr size_t WS_H = 792 * MiB;
constexpr size_t WS_ZPOOL = 792 * MiB;
constexpr size_t WS_AS5 = 856 * MiB;
constexpr size_t WS_DPOOL = 928 * MiB;
constexpr size_t WS_Y = 992 * MiB;
constexpr size_t WS_YPOOL = 1056 * MiB;
constexpr size_t WS_YSSM = WS_ZPOOL;
constexpr size_t WS_X2Q = 88 * MiB;
constexpr size_t WS_X2Q_OLD = 968 * MiB;
constexpr size_t WS_X1 = 1136 * MiB;
constexpr size_t WS_X2 = 1264 * MiB;
constexpr size_t WS_PS = 1392 * MiB;
constexpr size_t WS_PS2 = 1394 * MiB;
constexpr size_t WS_WINP = 1396 * MiB;
constexpr size_t WS_END = 1412 * MiB;
static_assert(WS_H + (size_t)M * FF * 2 <= WS_X1 && WS_YPOOL + (size_t)M * PW * 2 <= WS_H + (size_t)M * FF * 2, "ws map");
constexpr int CW_TMO = 0, CW_CODE = 1, CW_BAR = 4096;

constexpr int RING_OFF = 0, RING_BYTES = 131072;
constexpr int LDSCTL_OFF = RING_BYTES, MISC_OFF = LDSCTL_OFF + 320;
constexpr int LDS_BYTES = 147456;
constexpr int EPI_LDS_OFF = RING_BYTES + 1024;
constexpr int NWAVES = 8;

#define RLX_AGENT __ATOMIC_RELAXED, __HIP_MEMORY_SCOPE_AGENT
#define LDS_WAIT() asm volatile("s_waitcnt lgkmcnt(0)" ::: "memory")
#define VM_WAIT() asm volatile("s_waitcnt vmcnt(0)" ::: "memory")
#ifndef F16
#define F16 1
#endif
typedef _Float16 f16x2 __attribute__((ext_vector_type(2)));
typedef _Float16 f16x8 __attribute__((ext_vector_type(8)));
__device__ __forceinline__ unsigned cvt_pk_truebf16(float lo, float hi) { unsigned r; asm volatile("v_cvt_pk_bf16_f32 %0, %1, %2" : "=v"(r) : "v"(lo), "v"(hi)); return r; }
#ifndef DOWN1_BF16
#define DOWN1_BF16 1
#endif
#if F16
__device__ __forceinline__ unsigned cvt_pk_bf16(float lo, float hi) { return __builtin_bit_cast(unsigned, __builtin_convertvector((f32x2){lo, hi}, f16x2)); }
__device__ __forceinline__ unsigned f2bf(float f) { return (unsigned)__builtin_bit_cast(unsigned short, (_Float16)f); }
__device__ __forceinline__ unsigned pk2(float lo, float hi) { return cvt_pk_bf16(lo, hi); }
__device__ __forceinline__ float bf_lo(unsigned w) { return (float)__builtin_bit_cast(f16x2, w).x; }
__device__ __forceinline__ float bf_hi(unsigned w) { return (float)__builtin_bit_cast(f16x2, w).y; }
#else
__device__ __forceinline__ unsigned cvt_pk_bf16(float lo, float hi) { unsigned r; asm volatile("v_cvt_pk_bf16_f32 %0, %1, %2" : "=v"(r) : "v"(lo), "v"(hi)); return r; }
__device__ __forceinline__ unsigned f2bf(float f) { unsigned u = __builtin_bit_cast(unsigned, f); return (u + 0x7fffu + ((u >> 16) & 1u)) >> 16; }
__device__ __forceinline__ unsigned pk2(float lo, float hi) { return f2bf(lo) | (f2bf(hi) << 16); }
__device__ __forceinline__ float bf_lo(unsigned w) { return __builtin_bit_cast(float, w << 16); }
__device__ __forceinline__ float bf_hi(unsigned w) { return __builtin_bit_cast(float, w & 0xffff0000u); }
#endif
#ifndef EMU_FP8
#define EMU_FP8 0
#endif
#ifndef INT8_GU1
#define INT8_GU1 1
#endif
#ifndef INT8_GU2
#define INT8_GU2 2
#endif
#ifndef FP8_DOWN2
#define FP8_DOWN2 1
#endif
__device__ __forceinline__ float q8(float x) { unsigned u = __builtin_bit_cast(unsigned, x); u += 0x7FFFFu + ((u >> 20) & 1u); u &= 0xFFF00000u; return __builtin_bit_cast(float, u); }
__device__ __forceinline__ float clamp448(float x) { return __builtin_fminf(__builtin_fmaxf(x, -448.f), 448.f); }
__device__ __forceinline__ unsigned pk4_fp8(float a, float b, float c, float d) { int r = 0; r = __builtin_amdgcn_cvt_pk_fp8_f32(clamp448(a), clamp448(b), r, false); r = __builtin_amdgcn_cvt_pk_fp8_f32(clamp448(c), clamp448(d), r, true); return (unsigned)r; }
static_assert(INT8_GU1 == 1 && INT8_GU2 == 2, "WS_X2Q placement assumes int8 FFN1 gate/up weights and a 64 MiB int8 h2");
constexpr float H8_SCALE = 8.0f, W8_SCALE = 4096.0f;
constexpr float AQ1_SCALE = 31.75f;
constexpr float AQ_SCALE = 21.96f, WQ_SCALE = 2032.0f;
__device__ __forceinline__ unsigned pk4_i8(float a, float b, float c, float d) { const int ia = (int)__builtin_rintf(__builtin_fminf(__builtin_fmaxf(a, -127.f), 127.f)), ib = (int)__builtin_rintf(__builtin_fminf(__builtin_fmaxf(b, -127.f), 127.f)), ic = (int)__builtin_rintf(__builtin_fminf(__builtin_fmaxf(c, -127.f), 127.f)), id = (int)__builtin_rintf(__builtin_fminf(__builtin_fmaxf(d, -127.f), 127.f));
    return ((unsigned)ia & 0xffu) | (((unsigned)ib & 0xffu) << 8) | (((unsigned)ic & 0xffu) << 16) | ((unsigned)id << 24); }
__device__ __forceinline__ float qint8(float x) { return __builtin_rintf(__builtin_fminf(__builtin_fmaxf(x, -127.f), 127.f)); }
__device__ __forceinline__ float fast_sigmoid(float x) { return __builtin_amdgcn_rcpf(1.0f + __builtin_amdgcn_exp2f(-1.4426950408889634f * x)); }
__device__ __forceinline__ float silu_f(float x) { return x * fast_sigmoid(x); }
__device__ __forceinline__ float gelu_tanh_f(float x) { const float z = 0.7978845608028654f * (x + 0.044715f * x * x * x); return x * fast_sigmoid(2.0f * z); }
__device__ __forceinline__ float wave_sum(float v) {
#pragma unroll
    for (int o = 1; o < 64; o <<= 1) v += __shfl_xor(v, o);
    return v;
}

namespace pg8 {
constexpr int BM = 256, BK = 64, HALF = 128, HTB = HALF * BK * 2, STAGE_BYTES = 8 * HTB, NXCD = 8, WGM = 8;
__host__ __device__ __forceinline__ int lds_byte(int r, int c) { const int st = (r >> 4) * 2 + (c >> 5), rr = r & 15, cc = c & 31, ob = rr * 64 + cc * 2; return st * 1024 + (ob ^ (((ob >> 9) & 1) << 5)); }
__host__ __device__ __forceinline__ void stage_rc(int b, int& R, int& C) { const int st = b / 1024, sb = b % 1024, swz = sb ^ (((sb >> 9) & 1) << 5); R = (st >> 1) * 16 + swz / 64; C = (st & 1) * 32 + (swz % 64) / 2; }
__host__ __device__ __forceinline__ int perm32(int rho) { const int n = rho >> 4, i = rho & 15; return 8 * (i >> 2) + 4 * n + (i & 3); }

struct Unit { int pm, pn, g; };

struct TileOrder {
    int nM, nN, nwg, G, c, wgm;
    __device__ __forceinline__ void init(int Mr, int Nc, int G_, int c_, int wgm_) { nM = Mr / BM; nN = Nc / BM; nwg = nM * nN; G = G_; c = c_; wgm = wgm_; }
    __device__ __forceinline__ bool next(int i, Unit& u) const {
        const long L = (long)i * G + c; if (L >= nwg) return false;
        int wgid = (int)L; { const int q = nwg / NXCD, r = nwg % NXCD, xcd = wgid % NXCD, off = wgid / NXCD; wgid = (xcd < r ? xcd * (q + 1) : r * (q + 1) + (xcd - r) * q) + off; }
        const int nig = wgm * nN, gid = wgid / nig, fm = gid * wgm, gsz = (nM - fm) < wgm ? (nM - fm) : wgm;
        u.pm = fm + ((wgid % nig) % gsz); u.pn = (wgid % nig) / gsz; u.g = 0; return true;
    }
};

struct PlainGemm {
    static constexpr bool TWOSEG = false, KSKIP = false;
    int tmid = -1;
    const char* A; const char* Bt; int lda, ldb; int nt; long kstepA, kstepB, hstepA, hstepB; TileOrder ord;
    __device__ __forceinline__ void init(const void* A_, const void* Bt_, int Mr, int Nc, int K, int lda_, int ldb_, int G, int c, int wgm = WGM) {
        A = (const char*)A_; Bt = (const char*)Bt_; lda = lda_; ldb = ldb_; nt = K / BK; kstepA = kstepB = BK * 2; hstepA = (long)HALF * lda * 2; hstepB = (long)HALF * ldb * 2; ord.init(Mr, Nc, G, c, wgm); }
    __device__ __forceinline__ void init_tiledA(const void* A_, const void* Bt_, int Mr, int Nc, int K, int ldb_, int G, int c, int wgm) {
        init(A_, Bt_, Mr, Nc, K, 64, ldb_, G, c, wgm); kstepA = (long)Mr * 64 * 2; hstepA = (long)HALF * 64 * 2; }
    __device__ __forceinline__ void init_tiledAB(const void* A_, const void* Bt_, int Mr, int Nc, int K, int G, int c, int wgm) {
        init(A_, Bt_, Mr, Nc, K, 64, 64, G, c, wgm); kstepA = (long)Mr * 64 * 2; hstepA = (long)HALF * 64 * 2; kstepB = (long)Nc * 64 * 2; hstepB = (long)HALF * 64 * 2; }
    __device__ __forceinline__ void reverse_k() { A += (long)(nt - 1) * kstepA; Bt += (long)(nt - 1) * kstepB; kstepA = -kstepA; kstepB = -kstepB; }
    __device__ __forceinline__ bool next(int i, Unit& u) const { return ord.next(i, u); }
    __device__ __forceinline__ const char* a_base(const Unit& u) const { return A + (size_t)u.pm * 2 * hstepA; }
    __device__ __forceinline__ const char* b_base(const Unit& u) const { return Bt + (size_t)u.pn * 2 * hstepB; }
    __device__ __forceinline__ unsigned voffA(int R, int C) const { return (unsigned)(R * lda + C) * 2u; }
    __device__ __forceinline__ unsigned voffB(int R, int C) const { return (unsigned)(R * ldb + C) * 2u; }
    int ks; long kstepB2, hstepB2;
    __device__ __forceinline__ const char* b_base2(const Unit&) const { return Bt; }
    __device__ __forceinline__ unsigned voffB2(int, int) const { return 0u; }
};
struct PoolGemm {
    static constexpr int tmid = -1;
    static constexpr bool TWOSEG = false, KSKIP = false;
    const char* A; const char* Bt; int nt; long kstepA, kstepB, hstepA, hstepB; int G, c;
    __device__ __forceinline__ void init(const void* A_, const void* Bt_, int G_, int c_) { A = (const char*)A_; Bt = (const char*)Bt_; nt = PGW / BK; kstepA = kstepB = BK * 2; hstepA = (long)HALF * PW * 2; hstepB = (long)HALF * PGW * 2; G = G_; c = c_; }
    __device__ __forceinline__ bool next(int i, Unit& u) const { const int L = i * G + c; if (L >= 512) return false; u.pm = L >> 3; u.g = (L >> 1) & 3; u.pn = L & 1; return true; }
    __device__ __forceinline__ const char* a_base(const Unit& u) const { return A + ((size_t)u.pm * BM * PW + (size_t)u.g * PGW) * 2; }
    __device__ __forceinline__ const char* b_base(const Unit& u) const { return Bt + ((size_t)u.g * PGW * PGW + (size_t)u.pn * BM * PGW) * 2; }
    __device__ __forceinline__ unsigned voffA(int R, int C) const { return (unsigned)(R * PW + C) * 2u; }
    __device__ __forceinline__ unsigned voffB(int R, int C) const { return (unsigned)(R * PGW + C) * 2u; }
    int ks; long kstepB2, hstepB2;
    __device__ __forceinline__ const char* b_base2(const Unit&) const { return Bt; }
    __device__ __forceinline__ unsigned voffB2(int, int) const { return 0u; }
};
struct CombGemm {
    static constexpr bool TWOSEG = false, KSKIP = false; static constexpr int tmid = -1;
    const char* A; const char* Bt; int nt; long kstepA, kstepB, hstepA, hstepB; int G, c;
    __device__ __forceinline__ void init(const void* A_, const void* Bt_, int G_, int c_) { A = (const char*)A_; Bt = (const char*)Bt_; nt = PGW / BK; kstepA = kstepB = BK * 2; hstepA = (long)HALF * PGW * 2; hstepB = (long)HALF * PW * 2; G = G_; c = c_; }
    __device__ __forceinline__ bool next(int i, Unit& u) const { const int L = i * G + c; if (c < 0 || L >= 128) return false; u.g = L >> 5; u.pm = (L >> 4) & 1; u.pn = L & 15; return true; }
    __device__ __forceinline__ const char* a_base(const Unit& u) const { return A + ((size_t)u.g * PGW * PGW + (size_t)u.pm * BM * PGW) * 2; }
    __device__ __forceinline__ const char* b_base(const Unit& u) const { return Bt + ((size_t)u.pn * BM * PW + (size_t)u.g * PGW) * 2; }
    __device__ __forceinline__ unsigned voffA(int R, int C) const { return (unsigned)(R * PGW + C) * 2u; }
    __device__ __forceinline__ unsigned voffB(int R, int C) const { return (unsigned)(R * PW + C) * 2u; }
    int ks; long kstepB2, hstepB2;
    __device__ __forceinline__ const char* b_base2(const Unit&) const { return Bt; }
    __device__ __forceinline__ unsigned voffB2(int, int) const { return 0u; }
};
struct S5CarryGemm {
    static constexpr int tmid = -1;
    static constexpr bool TWOSEG = false, KSKIP = false;
    const char* A; const char* Bt; int nt; long kstepA, kstepB, hstepA, hstepB; int G, c;
    __device__ __forceinline__ void init(const void* A_, const void* Bt_, int G_, int c_) { A = (const char*)A_; Bt = (const char*)Bt_; nt = (CL * SH) / BK; kstepA = kstepB = BK * 2; hstepA = (long)HALF * AK * 2; hstepB = 0; G = G_; c = c_; }
    __device__ __forceinline__ bool next(int i, Unit& u) const { const int L = i * G + c; if (L >= SG) return false; u.pm = 0; u.pn = 0; u.g = L; return true; }
    __device__ __forceinline__ const char* a_base(const Unit& u) const { return A + (size_t)u.g * CR * AK * 2; }
    __device__ __forceinline__ const char* b_base(const Unit& u) const { return Bt + (size_t)u.g * 128 * 1024 * 2; }
    __device__ __forceinline__ unsigned voffA(int R, int C) const { return (unsigned)(R * AK + C) * 2u; }
    __device__ __forceinline__ unsigned voffB(int R, int C) const { return (unsigned)(R * 1024 + C) * 2u; }
    int ks; long kstepB2, hstepB2;
    __device__ __forceinline__ const char* b_base2(const Unit&) const { return Bt; }
    __device__ __forceinline__ unsigned voffB2(int, int) const { return 0u; }
};
#ifndef S5_KSKIP
#define S5_KSKIP 1
#endif
struct S5OutGemm {
    static constexpr int tmid = -1;
    static constexpr bool TWOSEG = true, KSKIP = S5_KSKIP != 0;
    __device__ __forceinline__ int ks_of(const Unit& u) const { return 4 * (u.pn + 1); }
    const char* A; const char* KLt; const char* WCt; int nt; long kstepA, kstepB, hstepA, hstepB; int ks; long kstepB2, hstepB2; int G, c;
    __device__ __forceinline__ void init(const void* A_, const void* KL_, const void* WC_, int G_, int c_) { A = (const char*)A_; KLt = (const char*)KL_; WCt = (const char*)WC_; nt = AK / BK; kstepA = BK * 2; hstepA = (long)HALF * AK * 2;
        kstepB = -2048; hstepB = 4096; ks = (CL * SH) / BK; kstepB2 = BK * 2; hstepB2 = (long)HALF * 128 * 2; G = G_; c = c_; }
    __device__ __forceinline__ bool next(int i, Unit& u) const { const int L = i * G + c; if (L >= SG * 4) return false; u.pm = 0; u.g = L >> 2; u.pn = (KSKIP && (i & 1)) ? 3 - (L & 3) : (L & 3); return true; }
    __device__ __forceinline__ const char* a_base(const Unit& u) const { return A + (size_t)u.g * CR * AK * 2; }
    __device__ __forceinline__ const char* b_base(const Unit& u) const { return KLt + (size_t)u.g * 65536 + (size_t)(16 * u.pn + 60) * 512; }
    __device__ __forceinline__ const char* b_base2(const Unit& u) const { return WCt + ((size_t)u.g * 1024 * 128 + (size_t)u.pn * BM * 128) * 2; }
    __device__ __forceinline__ unsigned voffA(int R, int C) const { return (unsigned)(R * AK + C) * 2u; }
    __device__ __forceinline__ unsigned voffB(int R, int C) const { return (unsigned)((((R >> 4) - (C >> 4) + 3) * 256) + (R & 15) * 16 + (C & 15)) * 2u; }
    __device__ __forceinline__ unsigned voffB2(int R, int C) const { return (unsigned)(R * 128 + C) * 2u; }
};

typedef f32x4 Acc[2][2][4][2];
#ifndef WIDE8
#define WIDE8 1
#endif
#ifndef WT_EPI
#define WT_EPI 1
#endif
#if WT_EPI
__device__ __forceinline__ void st16_wt(const void* base, unsigned byte_off, u32x4 v) { __builtin_amdgcn_raw_buffer_store_b128(v, __builtin_amdgcn_make_buffer_rsrc((void*)base, 0, 0x7fffffff, 0x00020000), (int)byte_off, 0, 16); }
#define ST16(base, byte_off, v) st16_wt((base), (unsigned)(byte_off), (v))
#else
#define ST16(base, byte_off, v) (*(u32x4*)((unsigned char*)(base) + (size_t)(unsigned)(byte_off)) = (v))
#endif
#ifndef XP_EPI
#define XP_EPI 1
#endif
constexpr int XP_OFF = EPI_LDS_OFF + 6144;
static_assert(XP_OFF + 8192 <= LDS_BYTES, "lds map");
__device__ __forceinline__ u32x4 xp_to_rows(LAS unsigned char* slot, int fr, int fq, int lane, u32x4 w) { *(LAS u32x4*)(slot + (fr * 4 + fq) * 16) = w; return *(const LAS u32x4*)(slot + lane * 16); }
__device__ __forceinline__ u32x4 xp_to_frag(LAS unsigned char* slot, int fr, int fq, int lane, u32x4 w) { *(LAS u32x4*)(slot + lane * 16) = w; return *(const LAS u32x4*)(slot + (fr * 4 + fq) * 16); }

__device__ __forceinline__ void row_rstd8(const float* ps, int pm, int pm0, int wr, int fr, int fq, LAS unsigned char* lds, float (&rs)[8]);
#ifndef H_TILED
#define H_TILED 1
#endif
#ifndef POOL_PREMUL
#define POOL_PREMUL 1
#endif
#ifndef DOWN_REVK
#define DOWN_REVK 0
#endif
#ifndef WD_TILED
#define WD_TILED 1
#endif
__device__ __forceinline__ f32x4 swg4(f32x4 g, f32x4 u, float c1, float c2) {
    const f32x4 t = g * c1;
    f32x4 e; e[0] = __builtin_amdgcn_exp2f(t[0]); e[1] = __builtin_amdgcn_exp2f(t[1]); e[2] = __builtin_amdgcn_exp2f(t[2]); e[3] = __builtin_amdgcn_exp2f(t[3]);
    const f32x4 d = e + 1.0f;
    f32x4 rc; rc[0] = __builtin_amdgcn_rcpf(d[0]); rc[1] = __builtin_amdgcn_rcpf(d[1]); rc[2] = __builtin_amdgcn_rcpf(d[2]); rc[3] = __builtin_amdgcn_rcpf(d[3]);
    return ((g * u) * c2) * rc;
}
template <bool RSTD, bool F8OUT = false, bool INTACC = false, bool HBF16 = false> struct EpiSwiGLU {
    static constexpr bool PERM = true, AFTER_DRAIN = false, IDEMPOTENT = true;
    bf16_t* H; const float* ps; int pm0; float qs;
    __device__ __forceinline__ void operator()(const Acc& acc, const Unit& u, int wr, int wc, int fr, int fq, LAS unsigned char* lds, int tid) const {
        const int row0 = u.pm * BM + wr * 64 + fr, col0 = u.pn * HALF + wc * 32 + 8 * fq;
        const int lane = tid & 63, rowT = u.pm * BM + wr * 64 + (lane >> 2), colT = u.pn * HALF + wc * 32 + 8 * (lane & 3); LAS unsigned char* const xslot = lds + XP_OFF + (wr * 4 + wc) * 1024; (void)rowT; (void)colT; (void)xslot;
        float rs[8]; u32x2 w8prev = {0u, 0u}; (void)w8prev;
        if constexpr (RSTD) row_rstd8(ps, u.pm, pm0, wr, fr, fq, lds, rs);
#pragma unroll
        for (int ai = 0; ai < 2; ++ai)
#pragma unroll
            for (int m = 0; m < 4; ++m) {
                f32x4 g0 = acc[ai][0][m][0], g1 = acc[ai][0][m][1], u0 = acc[ai][1][m][0], u1 = acc[ai][1][m][1];
                if constexpr (INTACC) {
                    typedef int i32x4v __attribute__((ext_vector_type(4)));
                    g0 = __builtin_convertvector(__builtin_bit_cast(i32x4v, g0), f32x4); g1 = __builtin_convertvector(__builtin_bit_cast(i32x4v, g1), f32x4);
                    u0 = __builtin_convertvector(__builtin_bit_cast(i32x4v, u0), f32x4); u1 = __builtin_convertvector(__builtin_bit_cast(i32x4v, u1), f32x4); }
                const float r = RSTD ? rs[ai * 4 + m] * qs : (INTACC ? qs : 1.0f);
                const float c1 = -1.4426950408889634f * r, c2 = r * r * (F8OUT ? H8_SCALE : 1.0f);
#define SWG(gv, uv) (((gv) * (uv)) * c2 * __builtin_amdgcn_rcpf(1.0f + __builtin_amdgcn_exp2f((gv) * c1)))
#define HQ(x) ((EMU_FP8 && RSTD) ? q8(x) : (x))
#define PK16(a, b) (HBF16 ? cvt_pk_truebf16(a, b) : cvt_pk_bf16(a, b))
                u32x4 w;
                const f32x4 o0 = swg4(g0, u0, c1, c2), o1 = swg4(g1, u1, c1, c2);
                if constexpr (!F8OUT) {
                w.x = PK16(HQ(o0[0]), HQ(o0[1])); w.y = PK16(HQ(o0[2]), HQ(o0[3]));
                w.z = PK16(HQ(o1[0]), HQ(o1[1])); w.w = PK16(HQ(o1[2]), HQ(o1[3])); }
#undef PK16
#undef HQ
                if constexpr (F8OUT) {
                    u32x2 w8; w8.x = pk4_fp8(o0[0], o0[1], o0[2], o0[3]); w8.y = pk4_fp8(o1[0], o1[1], o1[2], o1[3]);
#if WIDE8
                    if ((m & 1) == 0) { w8prev = w8; continue; }
                    const u32x2 sx = __builtin_amdgcn_permlane16_swap(w8prev.x, w8.x, false, false), sy = __builtin_amdgcn_permlane16_swap(w8prev.y, w8.y, false, false);
                    const u32x4 w16 = {sx.x, sy.x, sx.y, sy.y}; const int rst = row0 + ai * HALF + (m - 1 + (fq & 1)) * 16, cst = col0 & ~8;
                    *(u32x4*)((unsigned char*)H + ((size_t)(cst >> 7) * M + rst) * 128 + (cst & 127)) = w16; continue; }
#else
                    *(u32x2*)((unsigned char*)H + ((size_t)(col0 >> 7) * M + (row0 + ai * HALF + m * 16)) * 128 + (col0 & 127)) = w8; continue; }
#endif
#if H_TILED
                if (XP_EPI) ST16(H, (((unsigned)(colT >> 6) * M + (rowT + ai * HALF + m * 16)) * 64 + (colT & 63)) * 2u, xp_to_rows(xslot, fr, fq, lane, w));
                else ST16(H, (((unsigned)(col0 >> 6) * M + (row0 + ai * HALF + m * 16)) * 64 + (col0 & 63)) * 2u, w); }
#else
                *(u32x4*)(H + (size_t)(row0 + ai * HALF + m * 16) * FF + col0) = w; }
#endif
#undef SWG
    }
};
struct EpiResF32 {
    static constexpr bool PERM = false, AFTER_DRAIN = false, IDEMPOTENT = false;
    const float* base; float* out; float alpha;
    __device__ __forceinline__ void operator()(const Acc& acc, const Unit& u, int wr, int wc, int fr, int fq, LAS unsigned char* lds, int tid) const {
        const int row0 = u.pm * BM + wr * 64 + fr, col0 = u.pn * BM + wc * 32 + 4 * fq;
#pragma unroll
        for (int ai = 0; ai < 2; ++ai)
#pragma unroll
            for (int m = 0; m < 4; ++m) { const size_t off = (size_t)(row0 + ai * HALF + m * 16) * D + col0;
#pragma unroll
                for (int bj = 0; bj < 2; ++bj)
#pragma unroll
                    for (int n = 0; n < 2; ++n) { const f32x4 b = *(const f32x4*)(base + off + bj * HALF + n * 16); *(f32x4*)(out + off + bj * HALF + n * 16) = b + acc[ai][bj][m][n] * alpha; } }
    }
};
__device__ __forceinline__ void row_rstd8(const float* ps, int pm, int pm0, int wr, int fr, int fq, LAS unsigned char* lds, float (&rs)[8]) {
    if (pm == pm0) {
        const LAS float* RS = (const LAS float*)(lds + EPI_LDS_OFF + 4096);
#pragma unroll
        for (int ai = 0; ai < 2; ++ai)
#pragma unroll
            for (int m = 0; m < 4; ++m) rs[ai * 4 + m] = RS[ai * HALF + wr * 64 + m * 16 + fr];
        return; }
    f32x4 p[8];
#pragma unroll
    for (int ai = 0; ai < 2; ++ai)
#pragma unroll
        for (int m = 0; m < 4; ++m) p[ai * 4 + m] = *(const f32x4*)(ps + (size_t)(pm * BM + ai * HALF + wr * 64 + m * 16 + fr) * 16 + 4 * fq);
#pragma unroll
    for (int i = 0; i < 8; ++i) { float t = (p[i].x + p[i].y) + (p[i].z + p[i].w); t += __shfl_xor(t, 16); t += __shfl_xor(t, 32); rs[i] = 1.0f / sqrtf(t * (1.f / D) + NORM_EPS); }
}
template <bool BASE_F32, int QOUT = 0, bool ROWSC = false> struct EpiResNorm {
    static constexpr bool PERM = true, AFTER_DRAIN = false, IDEMPOTENT = false;
    const void* base; float alpha; bf16_t* xb; float* ps; void* xq;
    __device__ __forceinline__ void operator()(const Acc& acc, const Unit& u, int wr, int wc, int fr, int fq, LAS unsigned char* lds, int tid) const {
        const int row0 = u.pm * BM + wr * 64 + fr, col0 = u.pn * BM + wc * 32 + 8 * fq;
        const int lane = tid & 63, rowT = XP_EPI ? u.pm * BM + wr * 64 + (lane >> 2) : row0, colT = XP_EPI ? u.pn * BM + wc * 32 + 8 * (lane & 3) : col0; LAS unsigned char* const xslot = lds + XP_OFF + (wr * 4 + wc) * 1024;
        LAS float* P = (LAS float*)(lds + EPI_LDS_OFF);
#pragma unroll
        for (int ai = 0; ai < 2; ++ai)
#pragma unroll
            for (int mp = 0; mp < 2; ++mp) {
                f32x4 bv[2][2][2]; u32x4 bq[2][2]; (void)bq; u32x2 qprev[2] = {{0u, 0u}, {0u, 0u}}; (void)qprev;
#pragma unroll
                for (int mm = 0; mm < 2; ++mm) { const size_t off = (size_t)(rowT + ai * HALF + (2 * mp + mm) * 16) * D + colT;
#pragma unroll
                    for (int bj = 0; bj < 2; ++bj) {
                        if constexpr (BASE_F32) { bv[mm][bj][0] = *(const f32x4*)((const float*)base + off + bj * HALF); bv[mm][bj][1] = *(const f32x4*)((const float*)base + off + bj * HALF + 4); }
                        else { bq[mm][bj] = *(const u32x4*)((const bf16_t*)base + off + bj * HALF); } } }
#pragma unroll
                for (int mm = 0; mm < 2; ++mm) {
#pragma unroll
                    for (int bj = 0; bj < 2; ++bj) {
                        if constexpr (BASE_F32) { if (XP_EPI) { bv[mm][bj][0] = __builtin_bit_cast(f32x4, xp_to_frag(xslot, fr, fq, lane, __builtin_bit_cast(u32x4, bv[mm][bj][0]))); bv[mm][bj][1] = __builtin_bit_cast(f32x4, xp_to_frag(xslot, fr, fq, lane, __builtin_bit_cast(u32x4, bv[mm][bj][1]))); } }
                        else { const u32x4 q = XP_EPI ? xp_to_frag(xslot, fr, fq, lane, bq[mm][bj]) : bq[mm][bj];
                            bv[mm][bj][0] = (f32x4){bf_lo(q.x), bf_hi(q.x), bf_lo(q.y), bf_hi(q.y)}; bv[mm][bj][1] = (f32x4){bf_lo(q.z), bf_hi(q.z), bf_lo(q.w), bf_hi(q.w)}; } } }
#pragma unroll
                for (int mm = 0; mm < 2; ++mm) { const int m = 2 * mp + mm; const size_t off = (size_t)(row0 + ai * HALF + m * 16) * D + col0, offT = (size_t)(rowT + ai * HALF + m * 16) * D + colT; float ss = 0.f;
#pragma unroll
                    for (int bj = 0; bj < 2; ++bj) {
                        float al = alpha; if constexpr (ROWSC) al *= ((const LAS float*)(lds + EPI_LDS_OFF + 4096))[ai * HALF + wr * 64 + m * 16 + fr];
                        const f32x4 h0 = bv[mm][bj][0] + acc[ai][bj][m][0] * al, h1 = bv[mm][bj][1] + acc[ai][bj][m][1] * al;
                        ss += (h0[0] * h0[0] + h0[1] * h0[1]) + (h0[2] * h0[2] + h0[3] * h0[3]) + (h1[0] * h1[0] + h1[1] * h1[1]) + (h1[2] * h1[2] + h1[3] * h1[3]);
                        u32x4 w; w.x = cvt_pk_bf16(h0[0], h0[1]); w.y = cvt_pk_bf16(h0[2], h0[3]); w.z = cvt_pk_bf16(h1[0], h1[1]); w.w = cvt_pk_bf16(h1[2], h1[3]);
                        ST16(xb, (unsigned)(offT + bj * HALF) * 2u, XP_EPI ? xp_to_rows(xslot, fr, fq, lane, w) : w);
                        if constexpr (QOUT == 1) { u32x4 q; q.x = cvt_pk_bf16(qint8(h0[0] * AQ_SCALE), qint8(h0[1] * AQ_SCALE)); q.y = cvt_pk_bf16(qint8(h0[2] * AQ_SCALE), qint8(h0[3] * AQ_SCALE));
                            q.z = cvt_pk_bf16(qint8(h1[0] * AQ_SCALE), qint8(h1[1] * AQ_SCALE)); q.w = cvt_pk_bf16(qint8(h1[2] * AQ_SCALE), qint8(h1[3] * AQ_SCALE));
                            *(u32x4*)((bf16_t*)xq + off + bj * HALF) = q; }
                        if constexpr (QOUT == 2) { u32x2 q; q.x = pk4_i8(h0[0] * AQ_SCALE, h0[1] * AQ_SCALE, h0[2] * AQ_SCALE, h0[3] * AQ_SCALE); q.y = pk4_i8(h1[0] * AQ_SCALE, h1[1] * AQ_SCALE, h1[2] * AQ_SCALE, h1[3] * AQ_SCALE);
#if WIDE8
                            if (mm == 0) qprev[bj] = q;
                            else { const u32x2 sx = __builtin_amdgcn_permlane16_swap(qprev[bj].x, q.x, false, false), sy = __builtin_amdgcn_permlane16_swap(qprev[bj].y, q.y, false, false);
                                const u32x4 q16 = {sx.x, sy.x, sx.y, sy.y}; const size_t ost = (size_t)(row0 + ai * HALF + (2 * mp + (fq & 1)) * 16) * D + (col0 & ~8);
                                *(u32x4*)((unsigned char*)xq + ost + bj * HALF) = q16; } } }
#else
                            *(u32x2*)((unsigned char*)xq + off + bj * HALF) = q; } }
#endif
                    ss += __shfl_xor(ss, 16); ss += __shfl_xor(ss, 32);
                    if (fq == 0) P[(ai * HALF + wr * 64 + m * 16 + fr) * 4 + wc] = ss; } }
        LDS_WAIT(); __builtin_amdgcn_s_barrier(); asm volatile("" ::: "memory");
        if (tid < BM) { const f32x4 q = *(const LAS f32x4*)(P + tid * 4); ps[(size_t)(u.pm * BM + tid) * 16 + u.pn] = (q.x + q.y) + (q.z + q.w); }
    }
};
__device__ __forceinline__ void rstd_table(const float* ps, int pm, LAS unsigned char* lds, int tid) {
    if (pm >= 0 && tid < BM) { const f32x4* p = (const f32x4*)(ps + (size_t)(pm * BM + tid) * 16); const f32x4 a = p[0], b = p[1], c = p[2], d = p[3];
        const float t = (((a.x + a.y) + (a.z + a.w)) + ((b.x + b.y) + (b.z + b.w))) + (((c.x + c.y) + (c.z + c.w)) + ((d.x + d.y) + (d.z + d.w)));
        ((LAS float*)(lds + EPI_LDS_OFF + 4096))[tid] = 1.0f / sqrtf(t * (1.f / D) + NORM_EPS); }
    __syncthreads();
}
__device__ __forceinline__ void rstd2_table(const float* ps2, int pm, LAS unsigned char* lds, int tid) {
    if (pm >= 0 && tid < BM) { const f32x4* p = (const f32x4*)(ps2 + (size_t)(pm * BM + tid) * 16); const f32x4 a = p[0], b = p[1], c = p[2], d = p[3];
        const float tp = ((a.x + a.y) + (a.z + a.w)) + ((b.x + b.y) + (b.z + b.w)), ts = ((c.x + c.y) + (c.z + c.w)) + ((d.x + d.y) + (d.z + d.w));
        const float rp = 1.0f / sqrtf(tp * (1.f / PW) + NORM_EPS), rs = 1.0f / sqrtf(ts * (1.f / SW) + NORM_EPS);
        ((LAS float*)(lds + EPI_LDS_OFF + 4096))[tid] = rs; ((LAS float*)(lds + EPI_LDS_OFF + 5120))[tid] = rp / rs; }
    __syncthreads();
}
struct EpiZ {
    static constexpr bool PERM = true, AFTER_DRAIN = false, IDEMPOTENT = false;
    bf16_t* zpool; bf16_t* as5; const float* ps; int pm0;
    __device__ __forceinline__ void operator()(const Acc& acc, const Unit& u, int wr, int wc, int fr, int fq, LAS unsigned char* lds, int tid) const {
        const int row0 = u.pm * BM + wr * 64 + fr;
        float rs[8]; row_rstd8(ps, u.pm, pm0, wr, fr, fq, lds, rs);
#pragma unroll
        for (int ai = 0; ai < 2; ++ai)
#pragma unroll
            for (int m = 0; m < 4; ++m) { const int row = row0 + ai * HALF + m * 16;
#pragma unroll
                for (int bj = 0; bj < 2; ++bj) { const f32x4 v0 = acc[ai][bj][m][0] * rs[ai * 4 + m], v1 = acc[ai][bj][m][1] * rs[ai * 4 + m];
                    u32x4 w; w.x = cvt_pk_bf16(v0[0], v0[1]); w.y = cvt_pk_bf16(v0[2], v0[3]); w.z = cvt_pk_bf16(v1[0], v1[1]); w.w = cvt_pk_bf16(v1[2], v1[3]);
                    const int col = u.pn * BM + bj * HALF + wc * 32 + 8 * fq;
                    if (u.pn < 8) ST16(zpool, ((unsigned)row * PW + col) * 2u, w);
                    else { const int cs = col - PW, g = cs >> 4, h0 = cs & 15; ST16(as5, (unsigned)((g * CR + (row >> 6)) * AK + (row & 63) * SH + h0) * 2u, w); } } }
    }
};
__device__ __forceinline__ void tile_row_ss(float (&ss8)[8], float* ps, int pm, int slot, int wr, int wc, int fr, int fq, LAS unsigned char* lds, int tid) {
    LAS float* P = (LAS float*)(lds + EPI_LDS_OFF);
#pragma unroll
    for (int i = 0; i < 8; ++i) { float t = ss8[i]; t += __shfl_xor(t, 16); t += __shfl_xor(t, 32); if (fq == 0) P[((i >> 2) * HALF + wr * 64 + (i & 3) * 16 + fr) * 4 + wc] = t; }
    LDS_WAIT(); __builtin_amdgcn_s_barrier(); asm volatile("" ::: "memory");
    if (tid < BM) { const f32x4 q = *(const LAS f32x4*)(P + tid * 4); ps[(size_t)(pm * BM + tid) * 16 + slot] = (q.x + q.y) + (q.z + q.w); }
}
struct EpiPool {
    static constexpr bool PERM = true, AFTER_DRAIN = false, IDEMPOTENT = false;
    bf16_t* O; const float* scale; float* ps2;
    __device__ __forceinline__ void operator()(const Acc& acc, const Unit& u, int wr, int wc, int fr, int fq, LAS unsigned char* lds, int tid) const {
        const int row0 = u.pm * BM + wr * 64 + fr, col0 = u.g * PGW + u.pn * BM + wc * 32 + 8 * fq;
        f32x4 sv[2][2];
#pragma unroll
        for (int bj = 0; bj < 2; ++bj)
#pragma unroll
            for (int n = 0; n < 2; ++n) sv[bj][n] = *(const f32x4*)(scale + col0 + bj * HALF + 4 * n);
        float ss8[8];
#pragma unroll
        for (int ai = 0; ai < 2; ++ai)
#pragma unroll
            for (int m = 0; m < 4; ++m) { bf16_t* rowp = O + (size_t)(row0 + ai * HALF + m * 16) * D + col0; float ss = 0.f;
#pragma unroll
                for (int bj = 0; bj < 2; ++bj) { const f32x4 v0 = acc[ai][bj][m][0] * sv[bj][0], v1 = acc[ai][bj][m][1] * sv[bj][1];
                    ss += (v0[0] * v0[0] + v0[1] * v0[1]) + (v0[2] * v0[2] + v0[3] * v0[3]) + (v1[0] * v1[0] + v1[1] * v1[1]) + (v1[2] * v1[2] + v1[3] * v1[3]);
                    u32x4 w; w.x = cvt_pk_bf16(v0[0], v0[1]); w.y = cvt_pk_bf16(v0[2], v0[3]); w.z = cvt_pk_bf16(v1[0], v1[1]); w.w = cvt_pk_bf16(v1[2], v1[3]);
                    *(u32x4*)(rowp + bj * HALF) = w; }
                ss8[ai * 4 + m] = ss; }
        tile_row_ss(ss8, ps2, u.pm, u.g * 2 + u.pn, wr, wc, fr, fq, lds, tid);
    }
};
struct EpiComb {
    static constexpr bool PERM = true, AFTER_DRAIN = false, IDEMPOTENT = false;
    bf16_t* O; const float* gain;
    __device__ __forceinline__ void operator()(const Acc& acc, const Unit& u, int wr, int wc, int fr, int fq, LAS unsigned char* lds, int tid) const {
        const int row0 = u.g * PGW + u.pm * BM + wr * 64 + fr, col0 = u.pn * BM + wc * 32 + 8 * fq;
        f32x4 gv[2][2];
#pragma unroll
        for (int bj = 0; bj < 2; ++bj)
#pragma unroll
            for (int n = 0; n < 2; ++n) gv[bj][n] = *(const f32x4*)(gain + col0 + bj * HALF + 4 * n);
#pragma unroll
        for (int ai = 0; ai < 2; ++ai)
#pragma unroll
            for (int m = 0; m < 4; ++m) { bf16_t* rowp = O + (size_t)(row0 + ai * HALF + m * 16) * D + col0;
#pragma unroll
                for (int bj = 0; bj < 2; ++bj) { const f32x4 v0 = acc[ai][bj][m][0] * gv[bj][0], v1 = acc[ai][bj][m][1] * gv[bj][1];
                    u32x4 w; w.x = cvt_pk_bf16(v0[0], v0[1]); w.y = cvt_pk_bf16(v0[2], v0[3]); w.z = cvt_pk_bf16(v1[0], v1[1]); w.w = cvt_pk_bf16(v1[2], v1[3]);
                    *(u32x4*)(rowp + bj * HALF) = w; } }
    }
};
struct EpiS5Y {
    static constexpr bool PERM = true, AFTER_DRAIN = false, IDEMPOTENT = false;
    bf16_t* Y;
    __device__ __forceinline__ void operator()(const Acc& acc, const Unit& u, int wr, int wc, int fr, int fq, LAS unsigned char* lds, int tid) const {
        const int cr0 = wr * 64 + fr, h0 = 8 * (fq & 1);
#pragma unroll
        for (int ai = 0; ai < 2; ++ai)
#pragma unroll
            for (int m = 0; m < 4; ++m) { const int cr = cr0 + ai * HALF + m * 16;
#pragma unroll
                for (int bj = 0; bj < 2; ++bj) { const f32x4 v0 = acc[ai][bj][m][0], v1 = acc[ai][bj][m][1];
                    u32x4 w; w.x = cvt_pk_bf16(gelu_tanh_f(v0[0]), gelu_tanh_f(v0[1])); w.y = cvt_pk_bf16(gelu_tanh_f(v0[2]), gelu_tanh_f(v0[3]));
                    w.z = cvt_pk_bf16(gelu_tanh_f(v1[0]), gelu_tanh_f(v1[1])); w.w = cvt_pk_bf16(gelu_tanh_f(v1[2]), gelu_tanh_f(v1[3]));
                    const int j = u.pn * 16 + bj * 8 + wc * 2 + (fq >> 1);
                    ST16(Y, ((unsigned)(cr * CL + j) * SW + u.g * SH + h0) * 2u, w); } }
    }
};
struct EpiGLU {
    static constexpr bool PERM = true, AFTER_DRAIN = false, IDEMPOTENT = false;
    const bf16_t* Y; bf16_t* O; const float* bias; float* ps2;
    __device__ __forceinline__ void operator()(const Acc& acc, const Unit& u, int wr, int wc, int fr, int fq, LAS unsigned char* lds, int tid) const {
        const int row0 = u.pm * BM + wr * 64 + fr, col0 = u.pn * BM + wc * 32 + 8 * fq;
        f32x4 bv[2][2];
#pragma unroll
        for (int bj = 0; bj < 2; ++bj)
#pragma unroll
            for (int n = 0; n < 2; ++n) bv[bj][n] = *(const f32x4*)(bias + col0 + bj * HALF + 4 * n);
        float ss8[8];
#pragma unroll
        for (int ai = 0; ai < 2; ++ai)
#pragma unroll
            for (int m = 0; m < 4; ++m) { const int row = row0 + ai * HALF + m * 16; float ss = 0.f;
#pragma unroll
                for (int bj = 0; bj < 2; ++bj) { const f32x4 v0 = acc[ai][bj][m][0] + bv[bj][0], v1 = acc[ai][bj][m][1] + bv[bj][1];
                    const u32x4 yv = *(const u32x4*)(Y + (size_t)row * SW + col0 + bj * HALF);
                    float o[8]; o[0] = bf_lo(yv.x) * fast_sigmoid(v0[0]); o[1] = bf_hi(yv.x) * fast_sigmoid(v0[1]); o[2] = bf_lo(yv.y) * fast_sigmoid(v0[2]); o[3] = bf_hi(yv.y) * fast_sigmoid(v0[3]);
                    o[4] = bf_lo(yv.z) * fast_sigmoid(v1[0]); o[5] = bf_hi(yv.z) * fast_sigmoid(v1[1]); o[6] = bf_lo(yv.w) * fast_sigmoid(v1[2]); o[7] = bf_hi(yv.w) * fast_sigmoid(v1[3]);
                    ss += (o[0] * o[0] + o[1] * o[1]) + (o[2] * o[2] + o[3] * o[3]) + (o[4] * o[4] + o[5] * o[5]) + (o[6] * o[6] + o[7] * o[7]);
                    u32x4 w; w.x = cvt_pk_bf16(o[0], o[1]); w.y = cvt_pk_bf16(o[2], o[3]); w.z = cvt_pk_bf16(o[4], o[5]); w.w = cvt_pk_bf16(o[6], o[7]);
                    ST16(O, ((unsigned)row * D + SW + col0 + bj * HALF) * 2u, w); }
                ss8[ai * 4 + m] = ss; }
        tile_row_ss(ss8, ps2, u.pm, 8 + u.pn, wr, wc, fr, fq, lds, tid);
    }
};
struct EpiCarry {
    static constexpr bool PERM = false, AFTER_DRAIN = true, IDEMPOTENT = false;
    bf16_t* as5; const float* lp;
    __device__ __forceinline__ void fused(const Acc& acc, const Unit& u, int wr, int wc, int fr, int fq, LAS unsigned char* lds, int wid, int lane) const {
        LAS float* S = (LAS float*)lds;
#pragma unroll
        for (int ai = 0; ai < 2; ++ai)
#pragma unroll
            for (int m = 0; m < 4; ++m) { const int r = ai * HALF + wr * 64 + m * 16 + fr;
#pragma unroll
                for (int n = 0; n < 2; ++n) *(LAS f32x4*)(S + r * 128 + wc * 32 + n * 16 + 4 * fq) = acc[ai][0][m][n]; }
        LDS_WAIT(); __builtin_amdgcn_s_barrier(); asm volatile("" ::: "memory");
        const int b = wid, p = lane;
        const f32x2 L = *(const f32x2*)(lp + ((size_t)u.g * SP + p) * 2);
        float xr = 0.f, xi = 0.f;
        bf16_t* dst = as5 + (size_t)(u.g * CR + b * 32) * AK + CL * SH;
        for (int c = 0; c < 32; ++c) {
            const float sr = S[(b * 32 + c) * 128 + p], si = S[(b * 32 + c) * 128 + 64 + p];
            dst[(size_t)c * AK + p] = (bf16_t)f2bf(xr); dst[(size_t)c * AK + 64 + p] = (bf16_t)f2bf(xi);
            const float nr = L.x * xr - L.y * xi + sr, ni = L.x * xi + L.y * xr + si; xr = nr; xi = ni; }
    }
};

typedef int i32x4 __attribute__((ext_vector_type(4)));
typedef int i32x8 __attribute__((ext_vector_type(8)));
__device__ __forceinline__ i32x8 cat8(bf16x8 a, bf16x8 b) { return __builtin_shufflevector(__builtin_bit_cast(i32x4, a), __builtin_bit_cast(i32x4, b), 0, 1, 2, 3, 4, 5, 6, 7); }
template <class Epi, class Prob, bool ALIGN_EPI, bool SP2, int MODE = 0>
__device__ __forceinline__ void gemm_phase(LAS unsigned char* lds, const Prob& S, const Epi& E) {
    const int tid = threadIdx.x, wid = __builtin_amdgcn_readfirstlane(tid >> 6), lane = tid & 63, wr = wid >> 2, wc = wid & 3, fr = lane & 15, fq = lane >> 4;
    constexpr bool FP8 = (MODE == 1);
    int nt = S.nt, ksu = Prob::TWOSEG ? S.ks : 0; long skipA = 0;
    unsigned voffA0, voffB0, voffB20;
    { int R, C; stage_rc(tid * 16, R, C); const int Rb = Epi::PERM ? ((R & ~31) + perm32(R & 31)) : R;
      voffA0 = S.voffA(R, C); voffB0 = S.voffB(Rb, C); voffB20 = Prob::TWOSEG ? S.voffB2(Rb, C) : 0u; }
    const long dA = (long)S.voffA(64, 0) - (long)S.voffA(0, 0), dB = (long)S.voffB(64, 0) - (long)S.voffB(0, 0), dB2 = Prob::TWOSEG ? ((long)S.voffB2(64, 0) - (long)S.voffB2(0, 0)) : 0;
    const long kstepA = S.kstepA, kstepB = S.kstepB, hstepA = S.hstepA, hstepB = S.hstepB;
    const unsigned ldsw = (unsigned)wid * 1024u;
    const int aoff = lds_byte(wr * 64 + fr, fq * 8), boff = lds_byte(wc * 32 + fr, fq * 8);
#define PG8_SA(b, h) (((b) * 2 + (h)) * HTB)
#define PG8_SB(b, h) ((4 + (b) * 2 + (h)) * HTB)
#define PG8_STAGE(bufoff, gbase, v0, d) do { const unsigned _v0 = (v0); const char* _g0 = (const char*)(gbase); const char* _g1 = _g0 + (d); asm volatile("" : "+s"(_g0), "+s"(_g1)); \
        __builtin_amdgcn_global_load_lds((const unsigned*)(_g0 + _v0), (LAS unsigned*)(lds + (bufoff) + ldsw), 16, 0, 0); \
        __builtin_amdgcn_global_load_lds((const unsigned*)(_g1 + _v0), (LAS unsigned*)(lds + (bufoff) + ldsw + 8192), 16, 0, 0); } while (0)
#define PG8_STA(bufoff, gbase) PG8_STAGE(bufoff, gbase, voffA0, dA)
#define PG8_LDA(dst, b, h) do { _Pragma("unroll") for (int m = 0; m < 4; ++m) { if constexpr (FP8) { dst##8[m].lo = *(const LAS i32x4*)(lds + PG8_SA(b, h) + aoff + m * 2048); dst##8[m].hi = *(const LAS i32x4*)(lds + PG8_SA(b, h) + aoff + m * 2048 + 1024); } \
        else { _Pragma("unroll") for (int k = 0; k < 2; ++k) dst[m][k] = *(const LAS bf16x8*)(lds + PG8_SA(b, h) + aoff + m * 2048 + k * 1024); } } } while (0)
#define PG8_LDB(dst, b, h) do { _Pragma("unroll") for (int n = 0; n < 2; ++n) { if constexpr (FP8) { dst##8[n].lo = *(const LAS i32x4*)(lds + PG8_SB(b, h) + boff + n * 2048); dst##8[n].hi = *(const LAS i32x4*)(lds + PG8_SB(b, h) + boff + n * 2048 + 1024); } \
        else { _Pragma("unroll") for (int k = 0; k < 2; ++k) dst[n][k] = *(const LAS bf16x8*)(lds + PG8_SB(b, h) + boff + n * 2048 + k * 1024); } } } while (0)
#define PG8_MMA(ai, bj, At, Bt) do { __builtin_amdgcn_s_setprio(1); \
        if constexpr (FP8) { _Pragma("unroll") for (int m = 0; m < 4; ++m) _Pragma("unroll") for (int n = 0; n < 2; ++n) \
            acc[ai][bj][m][n] = __builtin_amdgcn_mfma_scale_f32_16x16x128_f8f6f4(Bt##8[n], At##8[m], acc[ai][bj][m][n], 0, 0, 0, FP8_SCALE_ARG, 0, FP8_SCALE_ARG); } \
        else if constexpr (MODE == 2) { _Pragma("unroll") for (int o_ = 0; o_ < 8; ++o_) _Pragma("unroll") for (int k = 0; k < 2; ++k) { const int m = MMA_NM ? (o_ & 3) : (o_ >> 1), n = MMA_NM ? (o_ >> 2) : (o_ & 1); \
            acc[ai][bj][m][n] = __builtin_bit_cast(f32x4, __builtin_amdgcn_mfma_i32_16x16x64_i8(__builtin_bit_cast(i32x4, Bt[n][k]), __builtin_bit_cast(i32x4, At[m][k]), __builtin_bit_cast(i32x4, acc[ai][bj][m][n]), 0, 0, 0)); if (MMA_PIN) __builtin_amdgcn_sched_barrier(0); } } \
        else { _Pragma("unroll") for (int o_ = 0; o_ < 8; ++o_) _Pragma("unroll") for (int k = 0; k < 2; ++k) { const int m = MMA_NM ? (o_ & 3) : (o_ >> 1), n = MMA_NM ? (o_ >> 2) : (o_ & 1); \
            acc[ai][bj][m][n] = (F16 && MODE != 3) ? __builtin_amdgcn_mfma_f32_16x16x32_f16(__builtin_bit_cast(f16x8, Bt[n][k]), __builtin_bit_cast(f16x8, At[m][k]), acc[ai][bj][m][n], 0, 0, 0) \
                                    : __builtin_amdgcn_mfma_f32_16x16x32_bf16(Bt[n][k], At[m][k], acc[ai][bj][m][n], 0, 0, 0); if (MMA_PIN) __builtin_amdgcn_sched_barrier(0); \
            if (DUP_MFMA) dummy[(m * 2 + n) & 3] = __builtin_amdgcn_mfma_f32_16x16x32_bf16(Bt[n][k], At[m][k], dummy[(m * 2 + n) & 3], 0, 0, 0); } } \
        __builtin_amdgcn_s_setprio(0); } while (0)
#define PG8_WAIT_V(n) asm volatile("s_waitcnt vmcnt(" #n ")" ::: "memory")
#define PG8_WAIT_L(n) asm volatile("s_waitcnt lgkmcnt(" #n ")" ::: "memory")
#define PG8_BAR __builtin_amdgcn_s_barrier()
#define PG8_SCHED __builtin_amdgcn_sched_barrier(0)
    Unit cur, nxt; int ui = 0;
    if (!S.next(0, cur)) return;
    f32x4 acc[2][2][4][2];
#pragma unroll
    for (int a = 0; a < 2; ++a)
#pragma unroll
        for (int b = 0; b < 2; ++b)
#pragma unroll
            for (int m = 0; m < 4; ++m)
#pragma unroll
                for (int n = 0; n < 2; ++n) acc[a][b][m][n] = (f32x4){0.f, 0.f, 0.f, 0.f};
    bf16x8 At[4][2], B0[2][2], B1[2][2]; i32x8 At8[4], B08[2], B18[2];
    f32x4 dummy[4] = {{0.f, 0.f, 0.f, 0.f}, {0.f, 0.f, 0.f, 0.f}, {0.f, 0.f, 0.f, 0.f}, {0.f, 0.f, 0.f, 0.f}};
    const char* cA = S.a_base(cur); const char* cB = S.b_base(cur); const char* cB2 = Prob::TWOSEG ? S.b_base2(cur) : cB;
    if constexpr (Prob::KSKIP) { ksu = S.ks_of(cur); nt = ksu + (S.nt - S.ks); skipA = (long)(S.ks - ksu) * S.kstepA; }
    if constexpr (SP2) {
        PG8_STAGE(PG8_SB(0, 0), cB, voffB0, dB); PG8_STAGE(PG8_SB(0, 1), cB + hstepB, voffB0, dB); PG8_STA(PG8_SA(0, 0), cA); PG8_STA(PG8_SA(0, 1), cA + hstepA);
        if (wr == 1) PG8_BAR;
        PG8_WAIT_V(2); PG8_BAR;
        PG8_STAGE(PG8_SB(1, 0), cB + kstepB, voffB0, dB); PG8_STA(PG8_SA(1, 0), cA + kstepA); PG8_STAGE(PG8_SB(1, 1), cB + hstepB + kstepB, voffB0, dB);
        PG8_WAIT_V(6); PG8_BAR;
    } else {
        PG8_STAGE(PG8_SB(0, 0), cB, voffB0, dB); PG8_STA(PG8_SA(0, 0), cA); PG8_STAGE(PG8_SB(0, 1), cB + hstepB, voffB0, dB); PG8_STA(PG8_SA(0, 1), cA + hstepA);
        if (wr == 1) PG8_BAR;
        PG8_WAIT_V(4); PG8_BAR;
        PG8_STAGE(PG8_SB(1, 0), cB + kstepB, voffB0, dB); PG8_STA(PG8_SA(1, 0), cA + kstepA); PG8_STAGE(PG8_SB(1, 1), cB + hstepB + kstepB, voffB0, dB);
        PG8_WAIT_V(6); PG8_BAR;
    }
    for (;;) {
        const bool has_next = S.next(ui + 1, nxt);
        const char* nA = has_next ? S.a_base(nxt) : cA; const char* nB = has_next ? S.b_base(nxt) : cB; const char* nB2 = (Prob::TWOSEG && has_next) ? S.b_base2(nxt) : cB2;
        for (int t = 0; t < nt; t += 2) {
            asm volatile("" : "+v"(voffA0), "+v"(voffB0), "+v"(voffB20));
            if (S.tmid >= 0 && t == S.tmid) {
                const LAS float* RAT = (const LAS float*)(lds + EPI_LDS_OFF + 5120);
#pragma unroll
                for (int ai = 0; ai < 2; ++ai)
#pragma unroll
                    for (int m = 0; m < 4; ++m) { const float r = RAT[ai * HALF + wr * 64 + m * 16 + fr];
#pragma unroll
                        for (int bj = 0; bj < 2; ++bj)
#pragma unroll
                            for (int n = 0; n < 2; ++n) acc[ai][bj][m][n] = acc[ai][bj][m][n] * r; } }
            const bool last = (t == nt - 2);
            const char* a1 = cA + (long)(t + 1) * kstepA + ((Prob::KSKIP && t >= ksu) ? skipA : 0);
            const char* a2; const char* b2; long kb = kstepB, hb = hstepB, db = dB; unsigned vb0 = voffB0;
            if (last) { a2 = nA; b2 = nB; }
            else { a2 = cA + (long)(t + 2) * kstepA + ((Prob::KSKIP && t + 2 >= ksu) ? skipA : 0);
                   if (Prob::TWOSEG && t + 2 >= ksu) { b2 = cB2 + (long)(t + 2 - ksu) * S.kstepB2; kb = S.kstepB2; hb = S.hstepB2; vb0 = voffB20; db = dB2; }
                   else b2 = cB + (long)(t + 2) * kstepB; }
            const char* a3 = a2 + kstepA; const char* b3 = b2 + kb;
            if constexpr (SP2) {
            PG8_LDB(B0, 0, 0); PG8_LDB(B1, 0, 1); PG8_SCHED; PG8_LDA(At, 0, 0); PG8_STA(PG8_SA(1, 1), a1 + hstepA);
            PG8_WAIT_V(8); PG8_WAIT_L(0); PG8_BAR; PG8_MMA(0, 0, At, B0); PG8_MMA(0, 1, At, B1); PG8_BAR; PG8_SCHED;
#if PG8_SPLIT
            PG8_LDA(At, 0, 1); PG8_STAGE(PG8_SB(0, 0), b2, vb0, db);
            PG8_WAIT_V(4); PG8_WAIT_L(0); PG8_BAR; PG8_MMA(1, 0, At, B0); PG8_SCHED; PG8_STAGE(PG8_SB(0, 1), b2 + hb, vb0, db); PG8_SCHED; PG8_MMA(1, 1, At, B1); PG8_SCHED; PG8_STA(PG8_SA(0, 0), a2); PG8_BAR; PG8_SCHED;
#else
            PG8_LDA(At, 0, 1); PG8_STAGE(PG8_SB(0, 0), b2, vb0, db); PG8_STAGE(PG8_SB(0, 1), b2 + hb, vb0, db); PG8_STA(PG8_SA(0, 0), a2);
            PG8_WAIT_V(8); PG8_WAIT_L(0); PG8_BAR; PG8_MMA(1, 0, At, B0); PG8_MMA(1, 1, At, B1); PG8_BAR; PG8_SCHED;
#endif
            PG8_LDB(B0, 1, 0); PG8_LDB(B1, 1, 1); PG8_SCHED; PG8_LDA(At, 1, 0); PG8_STA(PG8_SA(0, 1), a2 + hstepA);
            PG8_WAIT_V(8); PG8_WAIT_L(0); PG8_BAR; PG8_MMA(0, 0, At, B0); PG8_MMA(0, 1, At, B1); PG8_BAR; PG8_SCHED;
#if PG8_SPLIT
            PG8_LDA(At, 1, 1); PG8_STAGE(PG8_SB(1, 0), b3, vb0, db);
            PG8_WAIT_V(4); PG8_WAIT_L(0); PG8_BAR; PG8_MMA(1, 0, At, B0); PG8_SCHED; PG8_STAGE(PG8_SB(1, 1), b3 + hb, vb0, db); PG8_SCHED; PG8_MMA(1, 1, At, B1); PG8_SCHED; PG8_STA(PG8_SA(1, 0), a3); PG8_BAR; PG8_SCHED;
#else
            PG8_LDA(At, 1, 1); PG8_STAGE(PG8_SB(1, 0), b3, vb0, db); PG8_STAGE(PG8_SB(1, 1), b3 + hb, vb0, db); PG8_STA(PG8_SA(1, 0), a3);
            PG8_WAIT_V(8); PG8_WAIT_L(0); PG8_BAR; PG8_MMA(1, 0, At, B0); PG8_MMA(1, 1, At, B1); PG8_BAR; PG8_SCHED;
#endif
            } else {
            PG8_LDB(B0, 0, 0); PG8_SCHED; PG8_LDA(At, 0, 0); PG8_STA(PG8_SA(1, 1), a1 + hstepA);
            PG8_WAIT_L(8); PG8_BAR; PG8_WAIT_L(0); PG8_MMA(0, 0, At, B0); PG8_BAR; PG8_SCHED;
            PG8_LDB(B1, 0, 1); PG8_STAGE(PG8_SB(0, 0), b2, vb0, db);
            PG8_BAR; PG8_WAIT_L(0); PG8_MMA(0, 1, At, B1); PG8_BAR;
            PG8_LDA(At, 0, 1); PG8_STA(PG8_SA(0, 0), a2);
            PG8_BAR; PG8_WAIT_L(0); PG8_MMA(1, 0, At, B0); PG8_BAR; PG8_SCHED;
            PG8_STAGE(PG8_SB(0, 1), b2 + hb, vb0, db);
            PG8_WAIT_V(6); PG8_BAR; PG8_MMA(1, 1, At, B1); PG8_BAR;
            PG8_LDB(B0, 1, 0); PG8_SCHED; PG8_LDA(At, 1, 0); PG8_STA(PG8_SA(0, 1), a2 + hstepA);
            PG8_WAIT_L(8); PG8_BAR; PG8_WAIT_L(0); PG8_MMA(0, 0, At, B0); PG8_BAR; PG8_SCHED;
            PG8_LDB(B1, 1, 1); PG8_STAGE(PG8_SB(1, 0), b3, vb0, db);
            PG8_BAR; PG8_WAIT_L(0); PG8_MMA(0, 1, At, B1); PG8_BAR;
            PG8_LDA(At, 1, 1); PG8_STA(PG8_SA(1, 0), a3);
            PG8_BAR; PG8_WAIT_L(0); PG8_MMA(1, 0, At, B0); PG8_BAR; PG8_SCHED;
            PG8_STAGE(PG8_SB(1, 1), b3 + hb, vb0, db);
            PG8_WAIT_V(6); PG8_BAR; PG8_MMA(1, 1, At, B1); PG8_BAR;
            }
        }
        if constexpr (ALIGN_EPI) { if (wr == 0) PG8_BAR; }
        if constexpr (!Epi::AFTER_DRAIN) {
            int tz = threadIdx.x; asm volatile("" : "+v"(tz)); const int lz = tz & 63;
            E(acc, cur, wr, wc, lz & 15, lz >> 4, lds, tz);
            if (EPI_TWICE && Epi::IDEMPOTENT) E(acc, cur, wr, wc, lz & 15, lz >> 4, lds, tz); }
        if (!has_next) break;
#pragma unroll
        for (int a = 0; a < 2; ++a)
#pragma unroll
            for (int b = 0; b < 2; ++b)
#pragma unroll
                for (int m = 0; m < 4; ++m)
#pragma unroll
                    for (int n = 0; n < 2; ++n) acc[a][b][m][n] = (f32x4){0.f, 0.f, 0.f, 0.f};
        cur = nxt; cA = nA; cB = nB; cB2 = nB2; ++ui;
        if constexpr (Prob::KSKIP) { ksu = S.ks_of(cur); nt = ksu + (S.nt - S.ks); skipA = (long)(S.ks - ksu) * S.kstepA; }
        if constexpr (ALIGN_EPI) { if (wr == 1) PG8_BAR; }
    }
    if (DUP_MFMA) asm volatile("" :: "v"(dummy[0]), "v"(dummy[1]), "v"(dummy[2]), "v"(dummy[3]));
    PG8_WAIT_V(0);
    if constexpr (!ALIGN_EPI) { if (wr == 0) PG8_BAR; }
    PG8_BAR;
    if constexpr (Epi::AFTER_DRAIN) { E.fused(acc, cur, wr, wc, fr, fq, lds, wid, lane); }
#undef PG8_SA
#undef PG8_SB
#undef PG8_STAGE
#undef PG8_STA
#undef PG8_LDA
#undef PG8_LDB
#undef PG8_MMA
#undef PG8_WAIT_V
#undef PG8_WAIT_L
#undef PG8_BAR
#undef PG8_SCHED
}
}

#define XB_TMO      128
#define XB_XCNT(j)  (256  + 64 * (j))
#define XB_XSUB(j)  (1280 + 64 * (j))
#define XB_XGEN(j)  (2304 + 64 * (j))
#define XB_TOP      3328
#define XB_TOPGEN   3392
#define XCD_BAR_WORDS 3456
#define XB_SPIN_CAP (1u << 18)
__device__ __forceinline__ unsigned xb_ld(unsigned* p)              { return __hip_atomic_load(p, __ATOMIC_RELAXED, __HIP_MEMORY_SCOPE_AGENT); }
__device__ __forceinline__ unsigned xb_add(unsigned* p, unsigned v) { return __hip_atomic_fetch_add(p, v, __ATOMIC_RELAXED, __HIP_MEMORY_SCOPE_AGENT); }
__device__ __forceinline__ unsigned xb_xcc_id() { return (unsigned)__builtin_amdgcn_s_getreg((3 << 11) | 20) & 0xFu; }
#define XB_SPIN(cond, bar) do { unsigned _sp = 0; while (cond) { __builtin_amdgcn_s_sleep(1); \
    if ((++_sp & 255u) == 0u) { if (xb_ld(&(bar)[XB_TMO])) break; if (_sp > XB_SPIN_CAP) { atomicAdd(&(bar)[XB_TMO], 1u); break; } } } } while (0)
struct XcdBarrier { unsigned* bar; unsigned x; volatile LAS unsigned* st; };
__device__ __forceinline__ XcdBarrier xcd_barrier_post(unsigned* bar, volatile LAS unsigned* st) {
    XcdBarrier b; b.bar = bar; b.x = xb_xcc_id(); b.st = st;
    if (threadIdx.x == 0) (void)xb_add(&bar[XB_XCNT(b.x)], 1u);
    return b;
}
__device__ __forceinline__ void xcd_barrier_complete(unsigned* bar, unsigned x, unsigned& nloc, unsigned& nx) {
    const unsigned G = gridDim.x * gridDim.y * gridDim.z;
    unsigned sum, cnt, mine, sp = 0u;
    for (;;) {
        sum = 0u; cnt = 0u; mine = 0u;
#pragma unroll
        for (unsigned j = 0; j < 16; ++j) { const unsigned c = xb_ld(&bar[XB_XCNT(j)]); sum += c; cnt += (c > 0u) ? 1u : 0u; mine = (j == x) ? c : mine; }
        if (sum == G) break;
        __builtin_amdgcn_s_sleep(1);
        if ((++sp & 255u) == 0u) { if (xb_ld(&bar[XB_TMO])) break; if (sp > XB_SPIN_CAP) { atomicAdd(&bar[XB_TMO], 1u); break; } }
    }
    nloc = mine > 0u ? mine : 1u; nx = cnt > 0u ? cnt : 1u;
}
__device__ __forceinline__ void xcd_barrier(const XcdBarrier& b) {
    asm volatile("s_waitcnt vmcnt(0)" ::: "memory");
    __syncthreads();
    if (threadIdx.x == 0) {
        unsigned* bar = b.bar;
        __builtin_amdgcn_s_waitcnt(0);
        unsigned nloc = b.st[0], nx = b.st[1];
        if (nloc == 0u) { xcd_barrier_complete(bar, b.x, nloc, nx); b.st[0] = nloc; b.st[1] = nx; }
        const unsigned old = xb_add(&bar[XB_XSUB(b.x)], 1u);
        const unsigned gen = old / nloc;
        if (old + 1u == (gen + 1u) * nloc) {
            __builtin_amdgcn_fence(__ATOMIC_RELEASE, "agent");
            asm volatile("s_waitcnt vmcnt(0)" ::: "memory");
            const unsigned og = xb_add(&bar[XB_TOP], 1u);
            const unsigned tg = og / nx;
            if (og + 1u == (tg + 1u) * nx) xb_add(&bar[XB_TOPGEN], 1u);
            else XB_SPIN(xb_ld(&bar[XB_TOPGEN]) == tg, bar);
            __builtin_amdgcn_fence(__ATOMIC_ACQUIRE, "agent");
            xb_add(&bar[XB_XGEN(b.x)], 1u);
            asm volatile("s_waitcnt vmcnt(0)" ::: "memory");
        } else {
            XB_SPIN(xb_ld(&bar[XB_XGEN(b.x)]) == gen, bar);
            __builtin_amdgcn_fence(__ATOMIC_ACQUIRE, "agent");
            asm volatile("s_waitcnt vmcnt(0)" ::: "memory");
        }
    }
    __syncthreads();
}

enum In { I_X = 0, I_N1, I_G1, I_U1, I_D1, I_MIXN, I_WIN, I_WPOOL, I_PSCALE, I_LRE, I_LIM, I_LOGDT, I_BRE, I_BIM, I_CRE, I_CIM, I_DSKIP, I_WGLU, I_BGLU, I_PON, I_SON, I_WOUT, I_N2, I_G2, I_U2, I_D2, I_FN, N_IN };
struct Args { const float* in[N_IN]; float* out; unsigned char* ws; int ph_lo, ph_hi, li, pad; };
struct Frame {
    LAS unsigned char* lds; volatile LAS unsigned* MISC; unsigned* ctl;
    int tid, lane, wave, vcu, G;
};

#ifndef P0_KFAST
#define P0_KFAST 1
#endif
#define P0_DECODE(item, dim) const int kb = P0_KFAST ? (item) % (dim) : (item) / (dim), nb = P0_KFAST ? (item) / (dim) : (item) % (dim)
#define P0_DIM(K_, N_) (P0_KFAST ? (K_) / 128 : (N_) / 256)
__device__ __forceinline__ void p0_item_load(const float* W, int ld, int item, int nblk, int wave, int lane, f32x4 (&v)[16]) {
    P0_DECODE(item, nblk);
    const float* src = W + (size_t)(128 * kb + 16 * wave) * ld + 256 * nb + 4 * lane;
#pragma unroll
    for (int r = 0; r < 16; ++r) v[r] = __builtin_nontemporal_load((const f32x4*)(src + (size_t)r * ld));
}
typedef const __attribute__((address_space(4))) float* CFP;
__device__ __forceinline__ CFP scalar_gain_ptr(const float* gain, int k0, int wave) { const unsigned long long a = (unsigned long long)(gain + k0 + 16 * wave);
    return (CFP)(((unsigned long long)(unsigned)__builtin_amdgcn_readfirstlane((int)(a >> 32)) << 32) | (unsigned long long)(unsigned)__builtin_amdgcn_readfirstlane((int)(unsigned)a)); }
__device__ __forceinline__ void p0_item_store(const f32x4 (&v)[16], int K, bf16_t* WT, const float* gain, int rs, int ro, int item, int nblk, LAS unsigned* T, int tid, int wave, int lane, int qf = 0) {
    P0_DECODE(item, nblk); const int k0 = 128 * kb, n0 = 256 * nb; const CFP gs = scalar_gain_ptr(gain, k0, wave);
#pragma unroll
    for (int i = 0; i < 8; ++i) { const int kp = 8 * wave + i;
        float ge = 1.f, go = 1.f; if (gain) { ge = gs[2 * i]; go = gs[2 * i + 1]; }
        if (INT8_GU2 == 1 && qf == 2) { ge *= WQ_SCALE; go *= WQ_SCALE; }
#define WQ(x) ((INT8_GU2 == 1 && qf == 2) ? qint8(x) : ((EMU_FP8 && qf == 1) ? q8(x) : (x)))
        if (qf == 4) { u32x4 wb; wb.x = cvt_pk_truebf16(v[2 * i].x * ge, v[2 * i + 1].x * go); wb.y = cvt_pk_truebf16(v[2 * i].y * ge, v[2 * i + 1].y * go); wb.z = cvt_pk_truebf16(v[2 * i].z * ge, v[2 * i + 1].z * go); wb.w = cvt_pk_truebf16(v[2 * i].w * ge, v[2 * i + 1].w * go);
            *(LAS u32x4*)(T + kp * 256 + 4 * (lane ^ ((kp >> 2) & 7))) = wb; continue; }
        u32x4 w; w.x = cvt_pk_bf16(WQ(v[2 * i].x * ge), WQ(v[2 * i + 1].x * go)); w.y = cvt_pk_bf16(WQ(v[2 * i].y * ge), WQ(v[2 * i + 1].y * go)); w.z = cvt_pk_bf16(WQ(v[2 * i].z * ge), WQ(v[2 * i + 1].z * go)); w.w = cvt_pk_bf16(WQ(v[2 * i].w * ge), WQ(v[2 * i + 1].w * go));
#undef WQ
        *(LAS u32x4*)(T + kp * 256 + 4 * (lane ^ ((kp >> 2) & 7))) = w; }
    LDS_WAIT(); __builtin_amdgcn_s_barrier(); asm volatile("" ::: "memory");
    const int q = tid & 15;
#pragma unroll
    for (int j = 0; j < 8; ++j) { const int n = (tid >> 4) + 32 * j; const LAS unsigned* r = T + (4 * q) * 256 + 4 * ((n >> 2) ^ (q & 7)) + (n & 3);
        u32x4 w; w.x = r[0]; w.y = r[256]; w.z = r[512]; w.w = r[768];
        const int ng = n0 + n, drow = (ng >> 7) * rs + (ng & 127) + ro;
        if (rs == 0) *(GAS u32x4*)(WT + ((size_t)((k0 + 8 * q) >> 6) * ro + ng) * 64 + ((k0 + 8 * q) & 63)) = w;
        else *(GAS u32x4*)(WT + (size_t)drow * K + k0 + 8 * q) = w; }
    LDS_WAIT(); __builtin_amdgcn_s_barrier(); asm volatile("" ::: "memory");
}
__device__ __forceinline__ void p0_item_store_fp8(const f32x4 (&v)[16], int K, unsigned char* WT, int item, int nblk, LAS unsigned* T, int tid, int wave, int lane) {
    P0_DECODE(item, nblk); const int k0 = 128 * kb, n0 = 256 * nb;
#pragma unroll
    for (int i = 0; i < 4; ++i) { const int kq = 4 * wave + i;
        u32x4 w; w.x = pk4_fp8(v[4 * i].x * W8_SCALE, v[4 * i + 1].x * W8_SCALE, v[4 * i + 2].x * W8_SCALE, v[4 * i + 3].x * W8_SCALE);
        w.y = pk4_fp8(v[4 * i].y * W8_SCALE, v[4 * i + 1].y * W8_SCALE, v[4 * i + 2].y * W8_SCALE, v[4 * i + 3].y * W8_SCALE);
        w.z = pk4_fp8(v[4 * i].z * W8_SCALE, v[4 * i + 1].z * W8_SCALE, v[4 * i + 2].z * W8_SCALE, v[4 * i + 3].z * W8_SCALE);
        w.w = pk4_fp8(v[4 * i].w * W8_SCALE, v[4 * i + 1].w * W8_SCALE, v[4 * i + 2].w * W8_SCALE, v[4 * i + 3].w * W8_SCALE);
        *(LAS u32x4*)(T + kq * 256 + 4 * (lane ^ ((kq >> 2) & 7))) = w; }
    LDS_WAIT(); __builtin_amdgcn_s_barrier(); asm volatile("" ::: "memory");
    const int q = tid & 7;
#pragma unroll
    for (int j = 0; j < 4; ++j) { const int n = (tid >> 3) + 64 * j; const LAS unsigned* r = T + (4 * q) * 256 + 4 * ((n >> 2) ^ (q & 7)) + (n & 3);
        u32x4 w; w.x = r[0]; w.y = r[256]; w.z = r[512]; w.w = r[768];
        *(GAS u32x4*)(WT + (size_t)(n0 + n) * K + k0 + 16 * q) = w; }
    LDS_WAIT(); __builtin_amdgcn_s_barrier(); asm volatile("" ::: "memory");
}
__device__ __forceinline__ void p0_item_store_i8(const f32x4 (&v)[16], int K, unsigned char* WT, const float* gain, int rs, int ro, int item, int nblk, LAS unsigned* T, int tid, int wave, int lane) {
    P0_DECODE(item, nblk); const int k0 = 128 * kb, n0 = 256 * nb; const CFP gs = scalar_gain_ptr(gain, k0, wave);
#pragma unroll
    for (int i = 0; i < 4; ++i) { const int kq = 4 * wave + i;
        float g0 = WQ_SCALE, g1 = WQ_SCALE, g2 = WQ_SCALE, g3 = WQ_SCALE;
        if (gain) { g0 *= gs[4 * i]; g1 *= gs[4 * i + 1]; g2 *= gs[4 * i + 2]; g3 *= gs[4 * i + 3]; }
        u32x4 w; w.x = pk4_i8(v[4 * i].x * g0, v[4 * i + 1].x * g1, v[4 * i + 2].x * g2, v[4 * i + 3].x * g3);
        w.y = pk4_i8(v[4 * i].y * g0, v[4 * i + 1].y * g1, v[4 * i + 2].y * g2, v[4 * i + 3].y * g3);
        w.z = pk4_i8(v[4 * i].z * g0, v[4 * i + 1].z * g1, v[4 * i + 2].z * g2, v[4 * i + 3].z * g3);
        w.w = pk4_i8(v[4 * i].w * g0, v[4 * i + 1].w * g1, v[4 * i + 2].w * g2, v[4 * i + 3].w * g3);
        *(LAS u32x4*)(T + kq * 256 + 4 * (lane ^ ((kq >> 2) & 7))) = w; }
    LDS_WAIT(); __builtin_amdgcn_s_barrier(); asm volatile("" ::: "memory");
    const int q = tid & 7;
#pragma unroll
    for (int j = 0; j < 4; ++j) { const int n = (tid >> 3) + 64 * j; const LAS unsigned* r = T + (4 * q) * 256 + 4 * ((n >> 2) ^ (q & 7)) + (n & 3);
        u32x4 w; w.x = r[0]; w.y = r[256]; w.z = r[512]; w.w = r[768];
        const int ng = n0 + n, drow = (ng >> 7) * rs + (ng & 127) + ro;
        *(GAS u32x4*)(WT + (size_t)drow * K + k0 + 16 * q) = w; }
    LDS_WAIT(); __builtin_amdgcn_s_barrier(); asm volatile("" ::: "memory");
}
struct TDesc { const float* src; bf16_t* dst; const float* gain; const float* gain2; int K, N, rs, ro, first, pad, ld, pad2; };
constexpr int N_TDESC = 13;

__device__ __forceinline__ void rms_row_to_bf16(const float* xrow, const float* gain, bf16_t* orow, int lane) {
    const GAS f32x4* xr = (const GAS f32x4*)xrow + lane;
    f32x4 v[16]; float s = 0.f;
#pragma unroll
    for (int j = 0; j < 16; ++j) { v[j] = xr[64 * j]; s += (v[j].x * v[j].x + v[j].y * v[j].y) + (v[j].z * v[j].z + v[j].w * v[j].w); }
    const float rstd = 1.0f / sqrtf(wave_sum(s) * (1.f / D) + NORM_EPS);
    const GAS f32x4* gr = (const GAS f32x4*)gain + lane;
    GAS u32x2* o8 = (GAS u32x2*)orow + lane;
#pragma unroll
    for (int j = 0; j < 16; ++j) { const f32x4 g = gr[64 * j]; u32x2 w; w.x = cvt_pk_bf16(v[j].x * rstd * g.x, v[j].y * rstd * g.y); w.y = cvt_pk_bf16(v[j].z * rstd * g.z, v[j].w * rstd * g.w); o8[64 * j] = w; }
}
__device__ __forceinline__ void rms_row_to_i8(const float* xrow, const float* gain, unsigned char* orow, int lane) {
    const GAS f32x4* xr = (const GAS f32x4*)xrow + lane;
    f32x4 v[16]; float s = 0.f;
#pragma unroll
    for (int j = 0; j < 16; ++j) { v[j] = xr[64 * j]; s += (v[j].x * v[j].x + v[j].y * v[j].y) + (v[j].z * v[j].z + v[j].w * v[j].w); }
    const float rstd = AQ1_SCALE / sqrtf(wave_sum(s) * (1.f / D) + NORM_EPS);
    const GAS f32x4* gr = (const GAS f32x4*)gain + lane;
    GAS unsigned* o4 = (GAS unsigned*)orow + lane;
#pragma unroll
    for (int j = 0; j < 16; ++j) { const f32x4 g = gr[64 * j]; o4[64 * j] = pk4_i8(v[j].x * rstd * g.x, v[j].y * rstd * g.y, v[j].z * rstd * g.z, v[j].w * rstd * g.w); }
}
__device__ __forceinline__ void norm_phase_i8(Frame& F, const float* src, const float* gain, unsigned char* dst) {
    const int gw = F.vcu * NWAVES + F.wave, NGW = F.G * NWAVES;
    LAS f32x4* GL = (LAS f32x4*)(F.lds + RING_OFF);
    __syncthreads();
    for (int e = F.tid; e < D / 4; e += NWAVES * 64) GL[e] = ((const f32x4*)gain)[e];
    __syncthreads();
    f32x4 vn[16];
    int m = gw;
    if (m < M) { const GAS f32x4* xr = (const GAS f32x4*)(src + (size_t)m * D) + F.lane;
#pragma unroll
        for (int j = 0; j < 16; ++j) vn[j] = xr[64 * j]; }
#define XN_ROW(m_, more_) do { f32x4 v[16]; \
        _Pragma("unroll") for (int j = 0; j < 16; ++j) v[j] = vn[j]; \
        if (more_) { const GAS f32x4* xr = (const GAS f32x4*)(src + (size_t)((m_) + NGW) * D) + F.lane; \
            _Pragma("unroll") for (int j = 0; j < 16; ++j) vn[j] = xr[64 * j]; } \
        asm volatile("" ::: "memory");        \
        float s = 0.f; \
        _Pragma("unroll") for (int j = 0; j < 16; ++j) s += (v[j].x * v[j].x + v[j].y * v[j].y) + (v[j].z * v[j].z + v[j].w * v[j].w); \
        const float rstd = AQ1_SCALE / sqrtf(wave_sum(s) * (1.f / D) + NORM_EPS); \
        GAS unsigned* o4 = (GAS unsigned*)(dst + (size_t)(m_) * D) + F.lane; \
        _Pragma("unroll") for (int j = 0; j < 16; ++j) { const f32x4 gj = GL[64 * j + F.lane]; o4[64 * j] = pk4_i8(v[j].x * rstd * gj.x, v[j].y * rstd * gj.y, v[j].z * rstd * gj.z, v[j].w * rstd * gj.w); } } while (0)
    constexpr int RPW = M / (256 * NWAVES);
    if (NGW == 256 * NWAVES) {
#pragma unroll
        for (int r = 0; r < RPW; ++r) XN_ROW(gw + r * NGW, r + 1 < RPW);
    } else { for (; m < M; m += NGW) XN_ROW(m, m + NGW < M); }
#undef XN_ROW
}
__device__ __forceinline__ void norm_phase_bf16(Frame& F, const float* src, const float* gain, bf16_t* dst) {
    const int gw = F.vcu * NWAVES + F.wave, NGW = F.G * NWAVES;
    for (int m = gw; m < M; m += NGW) rms_row_to_bf16(src + (size_t)m * D, gain, dst + (size_t)m * D, F.lane);
}
__device__ __forceinline__ void norm_phase_final(Frame& F, const bf16_t* h, const float* ps, const float* gain, float* out) {
    const int gw = F.vcu * NWAVES + F.wave, NGW = F.G * NWAVES;
    int tz = threadIdx.x; asm volatile("" : "+v"(tz)); const int ln = tz & 63;
    LAS f32x4* GL = (LAS f32x4*)(F.lds + RING_OFF);
    __syncthreads();
    for (int e = tz; e < D / 4; e += NWAVES * 64) GL[e] = ((const f32x4*)gain)[e];
    __syncthreads();
    u32x4 vn[8]; float pvn = 0.f;
    if (gw < M) { const GAS u32x4* hr = (const GAS u32x4*)(h + (size_t)gw * D) + ln;
#pragma unroll
        for (int j = 0; j < 8; ++j) vn[j] = hr[64 * j];
        pvn = (ln < 16) ? ps[(size_t)gw * 16 + ln] : 0.f; }
#define FN_ROW(m_, more_) do { \
        u32x4 v[8]; const float pv = pvn; \
        _Pragma("unroll") for (int j = 0; j < 8; ++j) v[j] = vn[j]; \
        if (more_) { const GAS u32x4* hr = (const GAS u32x4*)(h + (size_t)((m_) + NGW) * D) + ln; \
            _Pragma("unroll") for (int j = 0; j < 8; ++j) vn[j] = hr[64 * j]; \
            pvn = (ln < 16) ? ps[(size_t)((m_) + NGW) * 16 + ln] : 0.f; } \
        asm volatile("" ::: "memory");        \
        const float rstd = 1.0f / sqrtf(wave_sum(pv) * (1.f / D) + NORM_EPS); \
        GAS f32x4* o = (GAS f32x4*)(out + (size_t)(m_) * D) + 2 * ln; \
        _Pragma("unroll") for (int j = 0; j < 8; ++j) { const f32x4 ga = GL[(64 * j + ln) * 2], gb = GL[(64 * j + ln) * 2 + 1]; \
            o[128 * j] = (f32x4){bf_lo(v[j].x) * rstd * ga.x, bf_hi(v[j].x) * rstd * ga.y, bf_lo(v[j].y) * rstd * ga.z, bf_hi(v[j].y) * rstd * ga.w}; \
            o[128 * j + 1] = (f32x4){bf_lo(v[j].z) * rstd * gb.x, bf_hi(v[j].z) * rstd * gb.y, bf_lo(v[j].w) * rstd * gb.z, bf_hi(v[j].w) * rstd * gb.w}; } } while (0)
    constexpr int RPW = M / (256 * NWAVES);
    if (NGW == 256 * NWAVES) {
#pragma unroll 1
        for (int r0 = 0; r0 < RPW; r0 += 4) {
#pragma unroll
            for (int rr = 0; rr < 4; ++rr) FN_ROW(gw + (r0 + rr) * NGW, r0 + rr + 1 < RPW); }
    } else { for (int m = gw; m < M; m += NGW) FN_ROW(m, m + NGW < M); }
#undef FN_ROW
}
__device__ __forceinline__ void norm_phase_merged(Frame& F, const bf16_t* yp, const bf16_t* ys, const float* gp, const float* gs, bf16_t* dst) {
    const int gw = F.vcu * NWAVES + F.wave, NGW = F.G * NWAVES;
    for (int m = gw; m < M; m += NGW) {
#pragma unroll
        for (int half = 0; half < 2; ++half) {
            const GAS u32x4* src = (const GAS u32x4*)((half ? ys : yp) + (size_t)m * PW) + F.lane; const float* gn = half ? gs : gp;
            u32x4 v[4]; float s = 0.f;
#pragma unroll
            for (int j = 0; j < 4; ++j) { v[j] = src[64 * j];
                const float a0 = bf_lo(v[j].x), a1 = bf_hi(v[j].x), a2 = bf_lo(v[j].y), a3 = bf_hi(v[j].y), a4 = bf_lo(v[j].z), a5 = bf_hi(v[j].z), a6 = bf_lo(v[j].w), a7 = bf_hi(v[j].w);
                s += (a0 * a0 + a1 * a1) + (a2 * a2 + a3 * a3) + (a4 * a4 + a5 * a5) + (a6 * a6 + a7 * a7); }
            const float rstd = 1.0f / sqrtf(wave_sum(s) * (1.f / PW) + NORM_EPS);
            GAS u32x4* o = (GAS u32x4*)(dst + (size_t)m * D + half * PW) + F.lane;
#pragma unroll
            for (int j = 0; j < 4; ++j) { const GAS f32x4* g4 = (const GAS f32x4*)(gn + (64 * j + F.lane) * 8); const f32x4 ga = g4[0], gb = g4[1];
                u32x4 w; w.x = cvt_pk_bf16(bf_lo(v[j].x) * rstd * ga.x, bf_hi(v[j].x) * rstd * ga.y); w.y = cvt_pk_bf16(bf_lo(v[j].y) * rstd * ga.z, bf_hi(v[j].y) * rstd * ga.w);
                w.z = cvt_pk_bf16(bf_lo(v[j].z) * rstd * gb.x, bf_hi(v[j].z) * rstd * gb.y); w.w = cvt_pk_bf16(bf_lo(v[j].w) * rstd * gb.z, bf_hi(v[j].w) * rstd * gb.w);
                o[64 * j] = w; }
        }
    }
}
__device__ __forceinline__ void unpack8(const u32x4 v, float (&f)[8]) { f[0] = bf_lo(v.x); f[1] = bf_hi(v.x); f[2] = bf_lo(v.y); f[3] = bf_hi(v.y); f[4] = bf_lo(v.z); f[5] = bf_hi(v.z); f[6] = bf_lo(v.w); f[7] = bf_hi(v.w); }
__device__ __forceinline__ void pool_diff_phase(Frame& F, const bf16_t* z, bf16_t* d, int first_wg, int n_wg) {
    const int gw = (F.vcu - first_wg) * NWAVES + F.wave, NGW = n_wg * NWAVES;
    if (F.vcu < first_wg || F.vcu >= first_wg + n_wg) return;
    for (int it = gw; it < (M / 32) * 4; it += NGW) {
        const int g = it & 3, run = it >> 2, tok0 = run * 32, t0 = tok0 & (SEQ - 1), w = 2 << g;
        const GAS u32x4* zp = (const GAS u32x4*)(z + (size_t)tok0 * PW + g * PGW) + F.lane;
        GAS u32x4* dp = (GAS u32x4*)(d + (size_t)tok0 * PW + g * PGW) + F.lane;
        float sum[8];
#pragma unroll
        for (int e = 0; e < 8; ++e) sum[e] = 0.f;
        for (int s = 1; s < w; ++s) { if (t0 - s >= 0) { float f[8]; unpack8(zp[-(long)s * (PW / 8)], f);
#pragma unroll
            for (int e = 0; e < 8; ++e) sum[e] += f[e]; } }
        for (int r = 0; r < 32; ++r) {
            const int t = t0 + r; float f[8]; unpack8(zp[(long)r * (PW / 8)], f);
#pragma unroll
            for (int e = 0; e < 8; ++e) sum[e] += f[e];
            const int cnt = (t + 1 < w) ? (t + 1) : w; const float inv = 1.0f / (float)cnt;
            u32x4 o; o.x = cvt_pk_bf16(sum[0] * inv - f[0], sum[1] * inv - f[1]); o.y = cvt_pk_bf16(sum[2] * inv - f[2], sum[3] * inv - f[3]);
            o.z = cvt_pk_bf16(sum[4] * inv - f[4], sum[5] * inv - f[5]); o.w = cvt_pk_bf16(sum[6] * inv - f[6], sum[7] * inv - f[7]);
            dp[(long)r * (PW / 8)] = o;
            if (t - w + 1 >= 0) { float q[8]; unpack8(zp[(long)(r - w + 1) * (PW / 8)], q);
#pragma unroll
                for (int e = 0; e < 8; ++e) sum[e] -= q[e]; }
        }
    }
}

__device__ __forceinline__ void pool_out_phase(Frame& F, const bf16_t* z, bf16_t* ym, const float* scale, float* ps2, int first_wg, int n_wg) {
    const int gw = (F.vcu - first_wg) * NWAVES + F.wave, NGW = n_wg * NWAVES;
    if (F.vcu < first_wg || F.vcu >= first_wg + n_wg) return;
    for (int it = gw; it < (M / 32) * 4; it += NGW) {
        const int g = it & 3, run = it >> 2, tok0 = run * 32, t0 = tok0 & (SEQ - 1), w = 2 << g;
        const GAS u32x4* zp = (const GAS u32x4*)(z + (size_t)tok0 * PW + g * PGW) + F.lane;
        GAS u32x4* yp = (GAS u32x4*)(ym + (size_t)tok0 * D + g * PGW) + F.lane;
        const GAS f32x4* sp = (const GAS f32x4*)(scale + g * PGW + F.lane * 8); const f32x4 sa = sp[0], sb = sp[1];
        const float sc[8] = {sa.x, sa.y, sa.z, sa.w, sb.x, sb.y, sb.z, sb.w};
        float sum[8];
#pragma unroll
        for (int e = 0; e < 8; ++e) sum[e] = 0.f;
        for (int s = 1; s < w; ++s) { if (t0 - s >= 0) { float f[8]; unpack8(zp[-(long)s * (PW / 8)], f);
#pragma unroll
            for (int e = 0; e < 8; ++e) sum[e] += f[e]; } }
        for (int r = 0; r < 32; ++r) {
            const int t = t0 + r; float f[8]; unpack8(zp[(long)r * (PW / 8)], f);
#pragma unroll
            for (int e = 0; e < 8; ++e) sum[e] += f[e];
            const int cnt = (t + 1 < w) ? (t + 1) : w; const float inv = 1.0f / (float)cnt;
            float o[8]; float ss = 0.f;
#pragma unroll
            for (int e = 0; e < 8; ++e) { o[e] = (sum[e] * inv - f[e]) * sc[e]; ss += o[e] * o[e]; }
            u32x4 ov; ov.x = cvt_pk_bf16(o[0], o[1]); ov.y = cvt_pk_bf16(o[2], o[3]); ov.z = cvt_pk_bf16(o[4], o[5]); ov.w = cvt_pk_bf16(o[6], o[7]);
            yp[(long)r * (D / 8)] = ov;
            ss = wave_sum(ss);
            if (F.lane == 0) { ps2[(size_t)(tok0 + r) * 16 + g] = ss; ps2[(size_t)(tok0 + r) * 16 + 4 + g] = 0.f; }
            if (t - w + 1 >= 0) { float q[8]; unpack8(zp[(long)(r - w + 1) * (PW / 8)], q);
#pragma unroll
                for (int e = 0; e < 8; ++e) sum[e] -= q[e]; }
        }
    }
}
constexpr int PST = 65;
__device__ __forceinline__ void s5_tables_group(Frame& F, const Args& a, int g, int part) {
    LAS float* Bre = (LAS float*)(F.lds + RING_OFF);
    LAS float* Bim = Bre + 64 * 16;
    LAS float* Pre = Bim + 64 * 16;
    LAS float* Pim = Pre + 65 * PST;
    LAS float* Cre = Pim + 65 * PST;
    LAS float* Cim = Cre + 16 * PST;
    const int t = F.tid;
    const float dt = expf(a.in[I_LOGDT][g]);
    if (t < 64) {
        const int p = t;
        const float lr = a.in[I_LRE][g * SP + p], li = a.in[I_LIM][g * SP + p];
        const float mag = expf(lr * dt), ang = li * dt;
        const float br = mag * cosf(ang), bi = mag * sinf(ang);
        const float nr = br - 1.0f, ni = bi, den = 1.0f / (lr * lr + li * li);
        const float cr = (nr * lr + ni * li) * den, ci = (ni * lr - nr * li) * den;
        for (int h = 0; h < SH; ++h) { const float xr = a.in[I_BRE][(g * SP + p) * SH + h], xi = a.in[I_BIM][(g * SP + p) * SH + h]; Bre[p * 16 + h] = cr * xr - ci * xi; Bim[p * 16 + h] = cr * xi + ci * xr; }
        float pr = 1.0f, pi = 0.0f;
        for (int k = 0; k <= 64; ++k) { Pre[k * PST + p] = pr; Pim[k * PST + p] = pi; const float qr = pr * br - pi * bi, qi = pr * bi + pi * br; pr = qr; pi = qi; }
        if (part == 0) { float* lp = (float*)(a.ws + WS_LP) + ((size_t)g * SP + p) * 2; lp[0] = Pre[64 * PST + p]; lp[1] = Pim[64 * PST + p]; }
    }
    for (int e = t; e < SH * SP; e += NWAVES * 64) { Cre[(e >> 6) * PST + (e & 63)] = a.in[I_CRE][(size_t)g * SH * SP + e]; Cim[(e >> 6) * PST + (e & 63)] = a.in[I_CIM][(size_t)g * SH * SP + e]; }
    __syncthreads();
    if (part == 0) {
        bf16_t* kl = (bf16_t*)(a.ws + WS_KL) + (size_t)g * 32768;
        for (int ci = t; ci < 64 * 16; ci += NWAVES * 64) {
            const int lag = ci >> 4, hp = ci & 15;
            float acc[16];
#pragma unroll
            for (int h = 0; h < 16; ++h) acc[h] = 0.f;
#pragma unroll 2
            for (int p = 0; p < 64; ++p) {
                const float c1 = Cre[hp * PST + p], c2 = Cim[hp * PST + p], p1 = Pre[lag * PST + p], p2 = Pim[lag * PST + p];
                const float ar = c1 * p1 - c2 * p2, ai = c1 * p2 + c2 * p1;
#pragma unroll
                for (int h4 = 0; h4 < 4; ++h4) { const f32x4 b1 = *(const LAS f32x4*)(Bre + p * 16 + 4 * h4), b2 = *(const LAS f32x4*)(Bim + p * 16 + 4 * h4);
                    acc[4 * h4 + 0] += ar * b1.x - ai * b2.x; acc[4 * h4 + 1] += ar * b1.y - ai * b2.y; acc[4 * h4 + 2] += ar * b1.z - ai * b2.z; acc[4 * h4 + 3] += ar * b1.w - ai * b2.w; }
            }
            if (lag == 0) {
                const float dsk = a.in[I_DSKIP][g * SH + hp];
#pragma unroll
                for (int h = 0; h < 16; ++h) acc[h] += (h == hp) ? dsk : 0.f;
            }
            u32x4 w0, w1; w0.x = pk2(acc[0], acc[1]); w0.y = pk2(acc[2], acc[3]); w0.z = pk2(acc[4], acc[5]); w0.w = pk2(acc[6], acc[7]);
            w1.x = pk2(acc[8], acc[9]); w1.y = pk2(acc[10], acc[11]); w1.z = pk2(acc[12], acc[13]); w1.w = pk2(acc[14], acc[15]);
            GAS u32x4* o = (GAS u32x4*)(kl + (lag + 63) * 256 + hp * 16); o[0] = w0; o[1] = w1;
        }
        const u32x4 zz = {0u, 0u, 0u, 0u};
        for (int e = t; e < 63 * 32; e += NWAVES * 64) ((GAS u32x4*)kl)[e] = zz;
        for (int e = t; e < 32; e += NWAVES * 64) ((GAS u32x4*)(kl + 127 * 256))[e] = zz;
    }
    if (part == 1) {
        bf16_t* wcp = (bf16_t*)(a.ws + WS_WC) + (size_t)g * 1024 * 128;
        for (int e8 = t; e8 < 1024 * 16; e8 += NWAVES * 64) { const int q0 = (e8 & 15) * 8, n = e8 >> 4, j = n >> 4, hp = n & 15, p0 = q0 & 63; const bool im = q0 >= 64;
            float v[8];
#pragma unroll
            for (int x = 0; x < 8; ++x) { const float c1 = Cre[hp * PST + p0 + x], c2 = Cim[hp * PST + p0 + x], p1 = Pre[(j + 1) * PST + p0 + x], p2 = Pim[(j + 1) * PST + p0 + x];
                v[x] = im ? -(c1 * p2 + c2 * p1) : (c1 * p1 - c2 * p2); }
            u32x4 w; w.x = pk2(v[0], v[1]); w.y = pk2(v[2], v[3]); w.z = pk2(v[4], v[5]); w.w = pk2(v[6], v[7]);
            ((GAS u32x4*)wcp)[e8] = w; }
    }
    if (part == 1) {
        bf16_t* wsp = (bf16_t*)(a.ws + WS_WS) + (size_t)g * 128 * 1024;
        for (int e8 = t; e8 < 128 * 128; e8 += NWAVES * 64) { const int k0 = (e8 & 127) * 8, q = e8 >> 7, i = k0 >> 4, h0 = k0 & 15, p = q & 63; const bool im = q >= 64;
            const float p1 = Pre[(63 - i) * PST + p], p2 = Pim[(63 - i) * PST + p];
            float v[8];
#pragma unroll
            for (int x = 0; x < 8; ++x) { const float b1 = Bre[p * 16 + h0 + x], b2 = Bim[p * 16 + h0 + x]; v[x] = im ? (p1 * b2 + p2 * b1) : (p1 * b1 - p2 * b2); }
            u32x4 w; w.x = pk2(v[0], v[1]); w.y = pk2(v[2], v[3]); w.z = pk2(v[4], v[5]); w.w = pk2(v[6], v[7]);
            ((GAS u32x4*)wsp)[e8] = w; }
    }
    __syncthreads();
}

typedef const __attribute__((address_space(4))) Args* KArgsT;
__device__ __forceinline__ void p0_prologue(Frame& F) {
    KArgsT ap0 = (KArgsT)__builtin_amdgcn_kernarg_segment_ptr(); asm volatile("" : "+s"(ap0)); Args a;
#pragma unroll
    for (int i = 0; i < N_IN; ++i) a.in[i] = ap0->in[i];
    a.out = ap0->out; a.ws = ap0->ws; a.ph_lo = 0; a.ph_hi = 0; a.li = 0; a.pad = 0;
#ifndef PRO_REP
#define PRO_REP 0
#endif
    for (int rp = 0; rp <= (PRO_REP & 1); ++rp)
    for (int w = F.vcu; w < 2 * SG; w += F.G) s5_tables_group(F, a, w & (SG - 1), w >> 7);
    __syncthreads();
    LAS TDesc* td = (LAS TDesc*)(F.lds + RING_OFF + RING_BYTES - 1024);
    if (F.tid == 0) {
        int first = 0, k = 0;
#define TD(SRC, DST, K_, N_, RS, RO, GAIN) do { td[k].src = (SRC); td[k].dst = (bf16_t*)(DST); td[k].gain = (GAIN); td[k].gain2 = nullptr; td[k].K = (K_); td[k].N = (N_); td[k].ld = (N_); td[k].pad2 = 0; td[k].rs = (RS); td[k].ro = (RO); td[k].first = first; td[k].pad = (k == 12) ? 1 : ((k == 10 || k == 11) ? 2 : ((k == 0 || k == 1) ? 3 : ((k == 2 && F16 && DOWN1_BF16) ? 4 : 0))); first += ((K_) / 128) * ((N_) / 256); ++k; } while (0)
        TD(a.in[I_G1], a.ws + WS_WGU1, D, FF, 256, 0, nullptr);
        TD(a.in[I_U1], a.ws + WS_WGU1, D, FF, 256, 128, nullptr);
        if (WD_TILED) TD(a.in[I_D1], a.ws + WS_WD1, FF, D, 0, D, nullptr); else TD(a.in[I_D1], a.ws + WS_WD1, FF, D, 128, 0, nullptr);
        if (POOL_PREMUL) { TD(a.in[I_WIN] + PW, a.ws + WS_WIN, D, SW, 128, PW, a.in[I_MIXN]); td[k - 1].ld = D; }
        else TD(a.in[I_WIN], a.ws + WS_WIN, D, D, 128, 0, a.in[I_MIXN]);
        TD(a.in[I_WPOOL] + 0 * PGW * PGW, a.ws + WS_WPOOL + 0 * PGW * PGW * 2, PGW, PGW, 128, 0, nullptr);
        TD(a.in[I_WPOOL] + 1 * PGW * PGW, a.ws + WS_WPOOL + 1 * PGW * PGW * 2, PGW, PGW, 128, 0, nullptr);
        TD(a.in[I_WPOOL] + 2 * PGW * PGW, a.ws + WS_WPOOL + 2 * PGW * PGW * 2, PGW, PGW, 128, 0, nullptr);
        TD(a.in[I_WPOOL] + 3 * PGW * PGW, a.ws + WS_WPOOL + 3 * PGW * PGW * 2, PGW, PGW, 128, 0, nullptr);
        TD(a.in[I_WGLU], a.ws + WS_WGLU, SW, SW, 128, 0, nullptr);
        TD(a.in[I_WOUT], a.ws + WS_WOUT, D, D, 128, 0, a.in[I_PON]); td[k - 1].gain2 = a.in[I_SON];
        TD(a.in[I_G2], a.ws + WS_WGU2, D, FF, 256, 0, a.in[I_N2]);
        TD(a.in[I_U2], a.ws + WS_WGU2, D, FF, 256, 128, a.in[I_N2]);
        if (WD_TILED && !FP8_DOWN2) TD(a.in[I_D2], a.ws + WS_WD2, FF, D, 0, D, nullptr); else TD(a.in[I_D2], a.ws + WS_WD2, FF, D, 128, 0, nullptr);
#undef TD
        ((LAS int*)(td + N_TDESC))[0] = first;
    }
    __syncthreads();
    const int nitems = ((LAS int*)(td + N_TDESC))[0];
    LAS unsigned* T = (LAS unsigned*)(F.lds + RING_OFF);
    for (int rp = 0; rp <= ((PRO_REP >> 1) & 1); ++rp) {
    f32x4 vn[16];
    int it = F.vcu;
#define TD_FIND(IT, KK) do { KK = 0; _Pragma("unroll") for (int q_ = 1; q_ < N_TDESC; ++q_) KK += ((IT) >= td[q_].first) ? 1 : 0; } while (0)
    if (it < nitems) { int k; TD_FIND(it, k); p0_item_load(td[k].src, td[k].ld, it - td[k].first, P0_DIM(td[k].K, td[k].N), F.wave, F.lane, vn); }
    for (; it < nitems; it += F.G) {
        f32x4 vc[16];
#pragma unroll
        for (int r = 0; r < 16; ++r) vc[r] = vn[r];
        const int nx = it + F.G;
        if (nx < nitems) { int k; TD_FIND(nx, k); p0_item_load(td[k].src, td[k].ld, nx - td[k].first, P0_DIM(td[k].K, td[k].N), F.wave, F.lane, vn); }
        int k; TD_FIND(it, k);
        if ((INT8_GU2 == 2 && td[k].pad == 2) || (INT8_GU1 && td[k].pad == 3)) p0_item_store_i8(vc, td[k].K, (unsigned char*)td[k].dst, td[k].gain, td[k].rs, td[k].ro, it - td[k].first, P0_DIM(td[k].K, td[k].N), T, F.tid, F.wave, F.lane);
        else if (FP8_DOWN2 && td[k].pad == 1) p0_item_store_fp8(vc, td[k].K, (unsigned char*)td[k].dst, it - td[k].first, P0_DIM(td[k].K, td[k].N), T, F.tid, F.wave, F.lane);
        else { const int itl = it - td[k].first, nblk = P0_DIM(td[k].K, td[k].N); const float* gn = td[k].gain; if (td[k].gain2 && 128 * (P0_KFAST ? itl % nblk : itl / nblk) >= td[k].K / 2) gn = td[k].gain2 - td[k].K / 2;
            p0_item_store(vc, td[k].K, td[k].dst, gn, td[k].rs, td[k].ro, itl, nblk, T, F.tid, F.wave, F.lane, td[k].pad); }
    }
    }
#undef TD_FIND
    for (int rp = 0; rp <= ((PRO_REP >> 2) & 1); ++rp)
    if (POOL_PREMUL) {
        const int gt = F.vcu * (NWAVES * 64) + F.tid, NT = F.G * NWAVES * 64; const float* wi = a.in[I_WIN]; bf16_t* wp = (bf16_t*)(a.ws + WS_WINP);
        for (int e = gt; e < D * (PW / 8); e += NT) { const int k = e >> 8, c8 = e & 255; const f32x4 v0 = __builtin_nontemporal_load((const f32x4*)(wi + (size_t)k * D + c8 * 8)), v1 = __builtin_nontemporal_load((const f32x4*)(wi + (size_t)k * D + c8 * 8 + 4));
            u32x4 w; w.x = cvt_pk_bf16(v0.x, v0.y); w.y = cvt_pk_bf16(v0.z, v0.w); w.z = cvt_pk_bf16(v1.x, v1.y); w.w = cvt_pk_bf16(v1.z, v1.w); *(GAS u32x4*)(wp + (size_t)k * PW + c8 * 8) = w; } }
    if (INT8_GU1) norm_phase_i8(F, a.in[I_X], a.in[I_N1], a.ws + WS_XN); else
    norm_phase_bf16(F, a.in[I_X], a.in[I_N1], (bf16_t*)(a.ws + WS_XN));
}

constexpr int N_PHASES = 14;
__global__ void __launch_bounds__(NWAVES * 64, 2) fwd_kernel(Args args) {
    extern __shared__ __attribute__((aligned(16))) unsigned char lds[];
    Frame F;
    F.lds = (LAS unsigned char*)lds;
    F.MISC = (volatile LAS unsigned*)(F.lds + MISC_OFF);
    F.tid = threadIdx.x; F.lane = F.tid & 63; F.wave = __builtin_amdgcn_readfirstlane(F.tid >> 6);
    F.G = gridDim.x; { const int bx = blockIdx.x; F.vcu = (F.G % 8 == 0) ? (bx % 8) * (F.G / 8) + bx / 8 : bx; }
    typedef const __attribute__((address_space(4))) Args* KArgs;
#define FRESH_ARGS() KArgs ap = (KArgs)__builtin_amdgcn_kernarg_segment_ptr(); asm volatile("" : "+s"(ap)); unsigned char* const ws = ap->ws; (void)ws
    int lo, hi;
    { FRESH_ARGS(); F.ctl = (unsigned*)(ws + WS_CTL); lo = ap->ph_lo; hi = ap->ph_hi; }
    for (int u = F.tid; u < (LDS_BYTES - LDSCTL_OFF) / 4; u += NWAVES * 64) ((LAS unsigned*)(F.lds + LDSCTL_OFF))[u] = 0u;
    __syncthreads();
    XcdBarrier bar; bar.bar = F.ctl + CW_BAR; bar.x = 0; bar.st = nullptr;
    if (MK_N_LAUNCHES == 1) bar = xcd_barrier_post(F.ctl + CW_BAR, F.MISC + 8);
#define GRID_BAR() do { if (MK_N_LAUNCHES == 1) xcd_barrier(bar); } while (0)
#ifndef PH_MASK
#define PH_MASK 0x3fff
#endif
#define IN(k) (((PH_MASK >> (k)) & 1) && lo <= (k) && (k) < hi)
#define BOTH(k) (IN(k) && IN((k) + 1))
#define XN ((bf16_t*)(ws + WS_XN))
#define HB ((bf16_t*)(ws + WS_H))
#define ZPOOL ((bf16_t*)(ws + WS_ZPOOL))
#define AS5 ((bf16_t*)(ws + WS_AS5))
#define DPOOL ((bf16_t*)(ws + WS_DPOOL))
#define YB ((bf16_t*)(ws + WS_Y))
#define YPOOL ((bf16_t*)(ws + WS_YPOOL))
#define YSSM ((bf16_t*)(ws + WS_YSSM))
#define X1 ((bf16_t*)(ws + WS_X1))
#define X2 ((bf16_t*)(ws + WS_X2))
#define PS ((float*)(ws + WS_PS))
    const int bx = (int)blockIdx.x;
#ifndef WGM_DOWN
#define WGM_DOWN 2
#endif
#ifndef WGM_GU
#define WGM_GU 8
#endif
#ifndef REP_MASK
#define REP_MASK 0
#endif
#define PHASE(k) if (IN(k)) for (int rep_ = 0; rep_ <= ((REP_MASK >> (k)) & 1); ++rep_)
#define SEAM(k) if (BOTH(k)) GRID_BAR()
    PHASE(0) { FRESH_ARGS(); p0_prologue(F); } SEAM(0);
    PHASE(1) { FRESH_ARGS(); pg8::PlainGemm P;
        if (INT8_GU1) P.init(XN, ws + WS_WGU1, M, 2 * FF, D / 2, D / 2, D / 2, F.G, bx, WGM_GU); else P.init(XN, ws + WS_WGU1, M, 2 * FF, D, D, D, F.G, bx);
        pg8::EpiSwiGLU<false, false, INT8_GU1 != 0, (F16 && DOWN1_BF16)> E{HB, nullptr, -1, INT8_GU1 ? 1.0f / (AQ1_SCALE * WQ_SCALE) : 1.0f};
        pg8::gemm_phase<pg8::EpiSwiGLU<false, false, INT8_GU1 != 0, (F16 && DOWN1_BF16)>, pg8::PlainGemm, PG8_ALIGN, PG8_SP2, INT8_GU1 ? 2 : 0>(F.lds + RING_OFF, P, E);
        if (POOL_PREMUL) {
            __syncthreads();
            const int half = F.G / 2; const bool tailidle = (F.G == 256);
            pg8::CombGemm C; C.init(ws + WS_WPOOL, ws + WS_WINP, tailidle ? half : F.G, tailidle ? (bx >= half ? bx - half : -1) : bx); pg8::EpiComb EC{(bf16_t*)(ws + WS_WIN), ap->in[I_MIXN]};
            pg8::gemm_phase<pg8::EpiComb, pg8::CombGemm, PG8_ALIGN, PG8_SP2>(F.lds + RING_OFF, C, EC); } } SEAM(1);
    PHASE(2) { FRESH_ARGS(); pg8::PlainGemm P; if (H_TILED && WD_TILED) P.init_tiledAB(HB, ws + WS_WD1, M, D, FF, F.G, bx, WGM_DOWN); else if (H_TILED) P.init_tiledA(HB, ws + WS_WD1, M, D, FF, FF, F.G, bx, WGM_DOWN); else P.init(HB, ws + WS_WD1, M, D, FF, FF, FF, F.G, bx, WGM_DOWN); if (DOWN_REVK) P.reverse_k(); pg8::EpiResNorm<true> E{ap->in[I_X], 0.5f, X1, PS, nullptr};
        pg8::gemm_phase<pg8::EpiResNorm<true>, pg8::PlainGemm, PG8_ALIGN, PG8_SP2, (F16 && DOWN1_BF16) ? 3 : 0>(F.lds + RING_OFF, P, E); } SEAM(2);
    PHASE(4) { FRESH_ARGS(); pg8::PlainGemm P; P.init(X1, ws + WS_WIN, M, D, D, D, D, F.G, bx); pg8::Unit u0; const int pm0 = P.next(0, u0) ? u0.pm : -1; pg8::rstd_table(PS, pm0, F.lds, F.tid); pg8::EpiZ E{ZPOOL, AS5, PS, pm0};
        pg8::gemm_phase<pg8::EpiZ, pg8::PlainGemm, PG8_ALIGN, PG8_SP2>(F.lds + RING_OFF, P, E); } SEAM(4);
    PHASE(5) { FRESH_ARGS();
        const bool split = (F.G == 2 * SG);
        if (POOL_PREMUL) { if (split) pool_out_phase(F, ZPOOL, XN, ap->in[I_PSCALE], (float*)(ws + WS_PS2), SG, F.G - SG); else pool_out_phase(F, ZPOOL, XN, ap->in[I_PSCALE], (float*)(ws + WS_PS2), 0, F.G); }
        else if (split) pool_diff_phase(F, ZPOOL, DPOOL, SG, F.G - SG); else pool_diff_phase(F, ZPOOL, DPOOL, 0, F.G);
        VM_WAIT(); __syncthreads();
        pg8::S5CarryGemm P; P.init(AS5, ws + WS_WS, split ? SG : F.G, split ? (F.vcu < SG ? F.vcu : SG) : bx); pg8::EpiCarry E{AS5, (const float*)(ws + WS_LP)};
        pg8::gemm_phase<pg8::EpiCarry, pg8::S5CarryGemm, false, PG8_SP2>(F.lds + RING_OFF, P, E); __syncthreads(); } SEAM(5);
    PHASE(6) { FRESH_ARGS(); if (!POOL_PREMUL) { pg8::PoolGemm P; P.init(DPOOL, ws + WS_WPOOL, F.G, bx); pg8::EpiPool E{XN, ap->in[I_PSCALE], (float*)(ws + WS_PS2)};
          pg8::gemm_phase<pg8::EpiPool, pg8::PoolGemm, PG8_ALIGN, PG8_SP2>(F.lds + RING_OFF, P, E); }
        { pg8::S5OutGemm P; P.init(AS5, ws + WS_KL, ws + WS_WC, F.G, bx); pg8::EpiS5Y E{YB};
          pg8::gemm_phase<pg8::EpiS5Y, pg8::S5OutGemm, PG8_ALIGN, PG8_SP2>(F.lds + RING_OFF, P, E); } } SEAM(6);
    PHASE(7) { FRESH_ARGS(); pg8::PlainGemm P; P.init(YB, ws + WS_WGLU, M, SW, SW, SW, SW, F.G, bx); pg8::EpiGLU E{YB, XN, ap->in[I_BGLU], (float*)(ws + WS_PS2)};
        pg8::gemm_phase<pg8::EpiGLU, pg8::PlainGemm, PG8_ALIGN, PG8_SP2>(F.lds + RING_OFF, P, E); } SEAM(7);
    PHASE(9) { FRESH_ARGS(); pg8::PlainGemm P; P.init(XN, ws + WS_WOUT, M, D, D, D, D, F.G, bx); P.tmid = PW / pg8::BK;
        pg8::Unit u0; const int pm0 = P.next(0, u0) ? u0.pm : -1; pg8::rstd2_table((const float*)(ws + WS_PS2), pm0, F.lds, F.tid);
        pg8::EpiResNorm<false, INT8_GU2, true> E{X1, 1.0f, X2, PS, ws + WS_X2Q};
        pg8::gemm_phase<pg8::EpiResNorm<false, INT8_GU2, true>, pg8::PlainGemm, PG8_ALIGN, PG8_SP2>(F.lds + RING_OFF, P, E); } SEAM(9);
    PHASE(11) { FRESH_ARGS(); pg8::PlainGemm P;
        if (INT8_GU2 == 2) P.init(ws + WS_X2Q, ws + WS_WGU2, M, 2 * FF, D / 2, D / 2, D / 2, F.G, bx, WGM_GU);
        else P.init(INT8_GU2 == 1 ? (bf16_t*)(ws + WS_X2Q) : X2, ws + WS_WGU2, M, 2 * FF, D, D, D, F.G, bx);
        pg8::Unit u0; const int pm0 = P.next(0, u0) ? u0.pm : -1; pg8::rstd_table(PS, pm0, F.lds, F.tid);
        pg8::EpiSwiGLU<true, FP8_DOWN2 != 0, INT8_GU2 == 2> E{HB, PS, pm0, INT8_GU2 ? 1.0f / (AQ_SCALE * WQ_SCALE) : 1.0f};
        pg8::gemm_phase<pg8::EpiSwiGLU<true, FP8_DOWN2 != 0, INT8_GU2 == 2>, pg8::PlainGemm, PG8_ALIGN, PG8_SP2, INT8_GU2 == 2 ? 2 : 0>(F.lds + RING_OFF, P, E); } SEAM(11);
#if FP8_DOWN2
    PHASE(12) { FRESH_ARGS(); pg8::PlainGemm P; P.init_tiledA(HB, ws + WS_WD2, M, D, FF / 2, FF / 2, F.G, bx, WGM_DOWN); pg8::EpiResNorm<false> E{X2, 0.5f / (H8_SCALE * W8_SCALE), X1, PS, nullptr};
        pg8::gemm_phase<pg8::EpiResNorm<false>, pg8::PlainGemm, PG8_ALIGN, PG8_SP2, 1>(F.lds + RING_OFF, P, E); } SEAM(12);
#else
    PHASE(12) { FRESH_ARGS(); pg8::PlainGemm P; if (H_TILED && WD_TILED) P.init_tiledAB(HB, ws + WS_WD2, M, D, FF, F.G, bx, WGM_DOWN); else if (H_TILED) P.init_tiledA(HB, ws + WS_WD2, M, D, FF, FF, F.G, bx, WGM_DOWN); else P.init(HB, ws + WS_WD2, M, D, FF, FF, FF, F.G, bx, WGM_DOWN); if (DOWN_REVK) P.reverse_k(); pg8::EpiResNorm<false> E{X2, 0.5f, X1, PS, nullptr};
        pg8::gemm_phase<pg8::EpiResNorm<false>, pg8::PlainGemm, PG8_ALIGN, PG8_SP2>(F.lds + RING_OFF, P, E); } SEAM(12);
#endif
    PHASE(13) { FRESH_ARGS(); norm_phase_final(F, X1, PS, ap->in[I_FN], ap->out); }
#undef PHASE
#undef SEAM
#undef IN
#undef BOTH
#undef FRESH_ARGS
#undef GRID_BAR
}

extern "C" void kernel_launch(void* const* d_in, const int* in_sizes, int n_in, void* d_out, int out_size, void* d_ws, size_t ws_size, hipStream_t stream) {
    static int grid = 0;
    if (grid == 0) {
        if (n_in != N_IN || in_sizes[0] != M * D || out_size != M * D || ws_size < WS_END) { fprintf(stderr, "kernel_launch: unexpected shapes (n_in %d, in0 %d, out %d, ws %zu)\n", n_in, n_in > 0 ? in_sizes[0] : -1, out_size, ws_size); grid = -1; return; }
        int dev = 0, cus = 0, per_cu = 0;
        if (hipGetDevice(&dev) != hipSuccess || hipDeviceGetAttribute(&cus, hipDeviceAttributeMultiprocessorCount, dev) != hipSuccess) { grid = -1; return; }
        if (hipFuncSetAttribute((const void*)fwd_kernel, hipFuncAttributeMaxDynamicSharedMemorySize, LDS_BYTES) != hipSuccess) { fprintf(stderr, "kernel_launch: hipFuncSetAttribute failed\n"); grid = -1; return; }
        if (hipOccupancyMaxActiveBlocksPerMultiprocessor(&per_cu, (const void*)fwd_kernel, NWAVES * 64, LDS_BYTES) != hipSuccess || per_cu < 1) fprintf(stderr, "kernel_launch: occupancy query says %d\n", per_cu);
        (void)hipGetLastError();
        grid = cus;
    }
    if (grid < 0) return;
    if (hipMemsetAsync((char*)d_ws + WS_CTL, 0, CTL_ZERO_BYTES, stream) != hipSuccess) return;
    Args a{};
    for (int i = 0; i < N_IN; ++i) a.in[i] = (const float*)d_in[i];
    a.out = (float*)d_out; a.ws = (unsigned char*)d_ws; a.pad = 0;
    if (MK_N_LAUNCHES == 1) { a.ph_lo = 0; a.ph_hi = N_PHASES; a.li = 0; hipLaunchKernelGGL(fwd_kernel, dim3(grid), dim3(NWAVES * 64), LDS_BYTES, stream, a); }
    else for (int p = 0; p < N_PHASES; ++p) { a.ph_lo = p; a.ph_hi = p + 1; a.li = p; hipLaunchKernelGGL(fwd_kernel, dim3(grid), dim3(NWAVES * 64), LDS_BYTES, stream, a); }
}
```

```cpp
#include <hip/hip_runtime.h>
#include <cstdio>
#include <cstdint>

#define LAS __attribute__((address_space(3)))
#define GAS __attribute__((address_space(1)))
typedef unsigned short bf16_t;
typedef short bf16x8 __attribute__((ext_vector_type(8)));
typedef float f32x4 __attribute__((ext_vector_type(4)));
typedef float f32x2 __attribute__((ext_vector_type(2)));
typedef unsigned u32x4 __attribute__((ext_vector_type(4)));
typedef unsigned u32x2 __attribute__((ext_vector_type(2)));

#ifndef MK_N_LAUNCHES
#define MK_N_LAUNCHES 1
#endif
#ifndef PG8_SP2
#define PG8_SP2 true
#endif
#ifndef PG8_ALIGN
#define PG8_ALIGN true
#endif
#ifndef EPI_TWICE
#define EPI_TWICE 0
#endif
#ifndef DUP_MFMA
#define DUP_MFMA 0
#endif
#ifndef PG8_SPLIT
#define PG8_SPLIT 0
#endif
#ifndef FAST_ENTRY
#define FAST_ENTRY 1
#endif
#ifndef FP8_SCALE_ARG
#define FP8_SCALE_ARG 0
#endif
#ifndef MMA_NM
#define MMA_NM 1
#endif
#ifndef MMA_PIN
#define MMA_PIN 1
#endif

constexpr int BATCH = 8, SEQ = 2048, D = 4096, M = BATCH * SEQ, FF = 11008;
constexpr int PW = 2048, SW = 2048, PGW = 512;
constexpr int SG = 128, SH = 16, SP = 64;
constexpr int CL = 64, CR = M / CL;
constexpr int AK = CL * SH + 2 * SP;
constexpr float NORM_EPS = 1e-6f;

constexpr size_t MiB = 1u << 20;
constexpr size_t WS_CTL = 0, CTL_ZERO_BYTES = 65536;
constexpr size_t WS_WGU1 = 1 * MiB, WS_WD1 = 173 * MiB, WS_WGU2 = 259 * MiB, WS_WD2 = 431 * MiB;
constexpr size_t WS_WIN = 517 * MiB, WS_WOUT = 549 * MiB, WS_WGLU = 581 * MiB, WS_WPOOL = 589 * MiB;
constexpr size_t WS_KL = 591 * MiB;
constexpr size_t WS_WC = 599 * MiB;
constexpr size_t WS_WS = 631 * MiB;
constexpr size_t WS_LP = 663 * MiB;
constexpr size_t WS_XN = 664 * MiB;
constexpr size_t WS_H = 792 * MiB;
constexpr size_t WS_ZPOOL = 792 * MiB;
constexpr size_t WS_AS5 = 856 * MiB;
constexpr size_t WS_DPOOL = 928 * MiB;
constexpr size_t WS_Y = 992 * MiB;
constexpr size_t WS_YPOOL = 1056 * MiB;
constexpr size_t WS_YSSM = WS_ZPOOL;
constexpr size_t WS_X2Q = 88 * MiB;
constexpr size_t WS_X2Q_OLD = 968 * MiB;
constexpr size_t WS_X1 = 1136 * MiB;
constexpr size_t WS_X2 = 1264 * MiB;
constexpr size_t WS_PS = 1392 * MiB;
constexpr size_t WS_PS2 = 1394 * MiB;
constexpr size_t WS_WINP = 1396 * MiB;
constexpr size_t WS_END = 1412 * MiB;
static_assert(WS_H + (size_t)M * FF * 2 <= WS_X1 && WS_YPOOL + (size_t)M * PW * 2 <= WS_H + (size_t)M * FF * 2, "ws map");
constexpr int CW_TMO = 0, CW_CODE = 1, CW_BAR = 4096;

constexpr int RING_OFF = 0, RING_BYTES = 131072;
constexpr int LDSCTL_OFF = RING_BYTES, MISC_OFF = LDSCTL_OFF + 320;
constexpr int LDS_BYTES = 147456;
constexpr int EPI_LDS_OFF = RING_BYTES + 1024;
constexpr int NWAVES = 8;

#define RLX_AGENT __ATOMIC_RELAXED, __HIP_MEMORY_SCOPE_AGENT
#define LDS_WAIT() asm volatile("s_waitcnt lgkmcnt(0)" ::: "memory")
#define VM_WAIT() asm volatile("s_waitcnt vmcnt(0)" ::: "memory")
#ifndef F16
#define F16 1
#endif
typedef _Float16 f16x2 __attribute__((ext_vector_type(2)));
typedef _Float16 f16x8 __attribute__((ext_vector_type(8)));
__device__ __forceinline__ unsigned cvt_pk_truebf16(float lo, float hi) { unsigned r; asm volatile("v_cvt_pk_bf16_f32 %0, %1, %2" : "=v"(r) : "v"(lo), "v"(hi)); return r; }
#ifndef MIX_BF16
#define MIX_BF16 1
#endif
#ifndef DOWN1_BF16
#define DOWN1_BF16 1
#endif
#if F16
__device__ __forceinline__ unsigned cvt_pk_bf16(float lo, float hi) { return __builtin_bit_cast(unsigned, __builtin_convertvector((f32x2){lo, hi}, f16x2)); }
__device__ __forceinline__ unsigned f2bf(float f) { return (unsigned)__builtin_bit_cast(unsigned short, (_Float16)f); }
__device__ __forceinline__ unsigned pk2(float lo, float hi) { return cvt_pk_bf16(lo, hi); }
__device__ __forceinline__ unsigned pk16m(float lo, float hi) { return MIX_BF16 ? cvt_pk_truebf16(lo, hi) : cvt_pk_bf16(lo, hi); }
__device__ __forceinline__ float bf_lo(unsigned w) { return (float)__builtin_bit_cast(f16x2, w).x; }
__device__ __forceinline__ float bf_hi(unsigned w) { return (float)__builtin_bit_cast(f16x2, w).y; }
#else
__device__ __forceinline__ unsigned cvt_pk_bf16(float lo, float hi) { unsigned r; asm volatile("v_cvt_pk_bf16_f32 %0, %1, %2" : "=v"(r) : "v"(lo), "v"(hi)); return r; }
__device__ __forceinline__ unsigned f2bf(float f) { unsigned u = __builtin_bit_cast(unsigned, f); return (u + 0x7fffu + ((u >> 16) & 1u)) >> 16; }
__device__ __forceinline__ unsigned pk2(float lo, float hi) { return f2bf(lo) | (f2bf(hi) << 16); }
__device__ __forceinline__ unsigned pk16m(float lo, float hi) { return cvt_pk_bf16(lo, hi); }
__device__ __forceinline__ float bf_lo(unsigned w) { return __builtin_bit_cast(float, w << 16); }
__device__ __forceinline__ float bf_hi(unsigned w) { return __builtin_bit_cast(float, w & 0xffff0000u); }
#endif
#ifndef EMU_FP8
#define EMU_FP8 0
#endif
#ifndef INT8_GU1
#define INT8_GU1 1
#endif
#ifndef INT8_GU2
#define INT8_GU2 2
#endif
#ifndef FP8_DOWN2
#define FP8_DOWN2 1
#endif
__device__ __forceinline__ float q8(float x) { unsigned u = __builtin_bit_cast(unsigned, x); u += 0x7FFFFu + ((u >> 20) & 1u); u &= 0xFFF00000u; return __builtin_bit_cast(float, u); }
__device__ __forceinline__ float clamp448(float x) { return __builtin_fminf(__builtin_fmaxf(x, -448.f), 448.f); }
__device__ __forceinline__ unsigned pk4_fp8(float a, float b, float c, float d) { int r = 0; r = __builtin_amdgcn_cvt_pk_fp8_f32(clamp448(a), clamp448(b), r, false); r = __builtin_amdgcn_cvt_pk_fp8_f32(clamp448(c), clamp448(d), r, true); return (unsigned)r; }
static_assert(INT8_GU1 == 1 && INT8_GU2 == 2, "WS_X2Q placement assumes int8 FFN1 gate/up weights and a 64 MiB int8 h2");
constexpr float H8_SCALE = 8.0f, W8_SCALE = 4096.0f;
constexpr float AQ1_SCALE = 31.75f;
constexpr float AQ_SCALE = 21.96f, WQ_SCALE = 2032.0f;
__device__ __forceinline__ unsigned pk4_i8(float a, float b, float c, float d) { const int ia = (int)__builtin_rintf(__builtin_fminf(__builtin_fmaxf(a, -127.f), 127.f)), ib = (int)__builtin_rintf(__builtin_fminf(__builtin_fmaxf(b, -127.f), 127.f)), ic = (int)__builtin_rintf(__builtin_fminf(__builtin_fmaxf(c, -127.f), 127.f)), id = (int)__builtin_rintf(__builtin_fminf(__builtin_fmaxf(d, -127.f), 127.f));
    return ((unsigned)ia & 0xffu) | (((unsigned)ib & 0xffu) << 8) | (((unsigned)ic & 0xffu) << 16) | ((unsigned)id << 24); }
__device__ __forceinline__ float qint8(float x) { return __builtin_rintf(__builtin_fminf(__builtin_fmaxf(x, -127.f), 127.f)); }
__device__ __forceinline__ float fast_sigmoid(float x) { return __builtin_amdgcn_rcpf(1.0f + __builtin_amdgcn_exp2f(-1.4426950408889634f * x)); }
__device__ __forceinline__ float silu_f(float x) { return x * fast_sigmoid(x); }
__device__ __forceinline__ float gelu_tanh_f(float x) { const float z = 0.7978845608028654f * (x + 0.044715f * x * x * x); return x * fast_sigmoid(2.0f * z); }
__device__ __forceinline__ float wave_sum(float v) {
#pragma unroll
    for (int o = 1; o < 64; o <<= 1) v += __shfl_xor(v, o);
    return v;
}

namespace pg8 {
constexpr int BM = 256, BK = 64, HALF = 128, HTB = HALF * BK * 2, STAGE_BYTES = 8 * HTB, NXCD = 8, WGM = 8;
__host__ __device__ __forceinline__ int lds_byte(int r, int c) { const int st = (r >> 4) * 2 + (c >> 5), rr = r & 15, cc = c & 31, ob = rr * 64 + cc * 2; return st * 1024 + (ob ^ (((ob >> 9) & 1) << 5)); }
__host__ __device__ __forceinline__ void stage_rc(int b, int& R, int& C) { const int st = b / 1024, sb = b % 1024, swz = sb ^ (((sb >> 9) & 1) << 5); R = (st >> 1) * 16 + swz / 64; C = (st & 1) * 32 + (swz % 64) / 2; }
__host__ __device__ __forceinline__ int perm32(int rho) { const int n = rho >> 4, i = rho & 15; return 8 * (i >> 2) + 4 * n + (i & 3); }

struct Unit { int pm, pn, g; };

struct TileOrder {
    int nM, nN, nwg, G, c, wgm;
    __device__ __forceinline__ void init(int Mr, int Nc, int G_, int c_, int wgm_) { nM = Mr / BM; nN = Nc / BM; nwg = nM * nN; G = G_; c = c_; wgm = wgm_; }
    __device__ __forceinline__ bool next(int i, Unit& u) const {
        const long L = (long)i * G + c; if (L >= nwg) return false;
        int wgid = (int)L; { const int q = nwg / NXCD, r = nwg % NXCD, xcd = wgid % NXCD, off = wgid / NXCD; wgid = (xcd < r ? xcd * (q + 1) : r * (q + 1) + (xcd - r) * q) + off; }
        const int nig = wgm * nN, gid = wgid / nig, fm = gid * wgm, gsz = (nM - fm) < wgm ? (nM - fm) : wgm;
        u.pm = fm + ((wgid % nig) % gsz); u.pn = (wgid % nig) / gsz; u.g = 0; return true;
    }
};

struct PlainGemm {
    static constexpr bool TWOSEG = false, KSKIP = false;
    int tmid = -1;
    const char* A; const char* Bt; int lda, ldb; int nt; long kstepA, kstepB, hstepA, hstepB; TileOrder ord;
    __device__ __forceinline__ void init(const void* A_, const void* Bt_, int Mr, int Nc, int K, int lda_, int ldb_, int G, int c, int wgm = WGM) {
        A = (const char*)A_; Bt = (const char*)Bt_; lda = lda_; ldb = ldb_; nt = K / BK; kstepA = kstepB = BK * 2; hstepA = (long)HALF * lda * 2; hstepB = (long)HALF * ldb * 2; ord.init(Mr, Nc, G, c, wgm); }
    __device__ __forceinline__ void init_tiledA(const void* A_, const void* Bt_, int Mr, int Nc, int K, int ldb_, int G, int c, int wgm) {
        init(A_, Bt_, Mr, Nc, K, 64, ldb_, G, c, wgm); kstepA = (long)Mr * 64 * 2; hstepA = (long)HALF * 64 * 2; }
    __device__ __forceinline__ void init_tiledAB(const void* A_, const void* Bt_, int Mr, int Nc, int K, int G, int c, int wgm) {
        init(A_, Bt_, Mr, Nc, K, 64, 64, G, c, wgm); kstepA = (long)Mr * 64 * 2; hstepA = (long)HALF * 64 * 2; kstepB = (long)Nc * 64 * 2; hstepB = (long)HALF * 64 * 2; }
    __device__ __forceinline__ void reverse_k() { A += (long)(nt - 1) * kstepA; Bt += (long)(nt - 1) * kstepB; kstepA = -kstepA; kstepB = -kstepB; }
    __device__ __forceinline__ bool next(int i, Unit& u) const { return ord.next(i, u); }
    __device__ __forceinline__ const char* a_base(const Unit& u) const { return A + (size_t)u.pm * 2 * hstepA; }
    __device__ __forceinline__ const char* b_base(const Unit& u) const { return Bt + (size_t)u.pn * 2 * hstepB; }
    __device__ __forceinline__ unsigned voffA(int R, int C) const { return (unsigned)(R * lda + C) * 2u; }
    __device__ __forceinline__ unsigned voffB(int R, int C) const { return (unsigned)(R * ldb + C) * 2u; }
    int ks; long kstepB2, hstepB2;
    __device__ __forceinline__ const char* b_base2(const Unit&) const { return Bt; }
    __device__ __forceinline__ unsigned voffB2(int, int) const { return 0u; }
};
struct PoolGemm {
    static constexpr int tmid = -1;
    static constexpr bool TWOSEG = false, KSKIP = false;
    const char* A; const char* Bt; int nt; long kstepA, kstepB, hstepA, hstepB; int G, c;
    __device__ __forceinline__ void init(const void* A_, const void* Bt_, int G_, int c_) { A = (const char*)A_; Bt = (const char*)Bt_; nt = PGW / BK; kstepA = kstepB = BK * 2; hstepA = (long)HALF * PW * 2; hstepB = (long)HALF * PGW * 2; G = G_; c = c_; }
    __device__ __forceinline__ bool next(int i, Unit& u) const { const int L = i * G + c; if (L >= 512) return false; u.pm = L >> 3; u.g = (L >> 1) & 3; u.pn = L & 1; return true; }
    __device__ __forceinline__ const char* a_base(const Unit& u) const { return A + ((size_t)u.pm * BM * PW + (size_t)u.g * PGW) * 2; }
    __device__ __forceinline__ const char* b_base(const Unit& u) const { return Bt + ((size_t)u.g * PGW * PGW + (size_t)u.pn * BM * PGW) * 2; }
    __device__ __forceinline__ unsigned voffA(int R, int C) const { return (unsigned)(R * PW + C) * 2u; }
    __device__ __forceinline__ unsigned voffB(int R, int C) const { return (unsigned)(R * PGW + C) * 2u; }
    int ks; long kstepB2, hstepB2;
    __device__ __forceinline__ const char* b_base2(const Unit&) const { return Bt; }
    __device__ __forceinline__ unsigned voffB2(int, int) const { return 0u; }
};
struct CombGemm {
    static constexpr bool TWOSEG = false, KSKIP = false; static constexpr int tmid = -1;
    const char* A; const char* Bt; int nt; long kstepA, kstepB, hstepA, hstepB; int G, c;
    __device__ __forceinline__ void init(const void* A_, const void* Bt_, int G_, int c_) { A = (const char*)A_; Bt = (const char*)Bt_; nt = PGW / BK; kstepA = kstepB = BK * 2; hstepA = (long)HALF * PGW * 2; hstepB = (long)HALF * PW * 2; G = G_; c = c_; }
    __device__ __forceinline__ bool next(int i, Unit& u) const { const int L = i * G + c; if (c < 0 || L >= 128) return false; u.g = L >> 5; u.pm = (L >> 4) & 1; u.pn = L & 15; return true; }
    __device__ __forceinline__ const char* a_base(const Unit& u) const { return A + ((size_t)u.g * PGW * PGW + (size_t)u.pm * BM * PGW) * 2; }
    __device__ __forceinline__ const char* b_base(const Unit& u) const { return Bt + ((size_t)u.pn * BM * PW + (size_t)u.g * PGW) * 2; }
    __device__ __forceinline__ unsigned voffA(int R, int C) const { return (unsigned)(R * PGW + C) * 2u; }
    __device__ __forceinline__ unsigned voffB(int R, int C) const { return (unsigned)(R * PW + C) * 2u; }
    int ks; long kstepB2, hstepB2;
    __device__ __forceinline__ const char* b_base2(const Unit&) const { return Bt; }
    __device__ __forceinline__ unsigned voffB2(int, int) const { return 0u; }
};
struct S5CarryGemm {
    static constexpr int tmid = -1;
    static constexpr bool TWOSEG = false, KSKIP = false;
    const char* A; const char* Bt; int nt; long kstepA, kstepB, hstepA, hstepB; int G, c;
    __device__ __forceinline__ void init(const void* A_, const void* Bt_, int G_, int c_) { A = (const char*)A_; Bt = (const char*)Bt_; nt = (CL * SH) / BK; kstepA = kstepB = BK * 2; hstepA = (long)HALF * AK * 2; hstepB = 0; G = G_; c = c_; }
    __device__ __forceinline__ bool next(int i, Unit& u) const { const int L = i * G + c; if (L >= SG) return false; u.pm = 0; u.pn = 0; u.g = L; return true; }
    __device__ __forceinline__ const char* a_base(const Unit& u) const { return A + (size_t)u.g * CR * AK * 2; }
    __device__ __forceinline__ const char* b_base(const Unit& u) const { return Bt + (size_t)u.g * 128 * 1024 * 2; }
    __device__ __forceinline__ unsigned voffA(int R, int C) const { return (unsigned)(R * AK + C) * 2u; }
    __device__ __forceinline__ unsigned voffB(int R, int C) const { return (unsigned)(R * 1024 + C) * 2u; }
    int ks; long kstepB2, hstepB2;
    __device__ __forceinline__ const char* b_base2(const Unit&) const { return Bt; }
    __device__ __forceinline__ unsigned voffB2(int, int) const { return 0u; }
};
#ifndef S5_KSKIP
#define S5_KSKIP 1
#endif
struct S5OutGemm {
    static constexpr int tmid = -1;
    static constexpr bool TWOSEG = true, KSKIP = S5_KSKIP != 0;
    __device__ __forceinline__ int ks_of(const Unit& u) const { return 4 * (u.pn + 1); }
    const char* A; const char* KLt; const char* WCt; int nt; long kstepA, kstepB, hstepA, hstepB; int ks; long kstepB2, hstepB2; int G, c;
    __device__ __forceinline__ void init(const void* A_, const void* KL_, const void* WC_, int G_, int c_) { A = (const char*)A_; KLt = (const char*)KL_; WCt = (const char*)WC_; nt = AK / BK; kstepA = BK * 2; hstepA = (long)HALF * AK * 2;
        kstepB = -2048; hstepB = 4096; ks = (CL * SH) / BK; kstepB2 = BK * 2; hstepB2 = (long)HALF * 128 * 2; G = G_; c = c_; }
    __device__ __forceinline__ bool next(int i, Unit& u) const { const int L = i * G + c; if (L >= SG * 4) return false; u.pm = 0; u.g = L >> 2; u.pn = (KSKIP && (i & 1)) ? 3 - (L & 3) : (L & 3); return true; }
    __device__ __forceinline__ const char* a_base(const Unit& u) const { return A + (size_t)u.g * CR * AK * 2; }
    __device__ __forceinline__ const char* b_base(const Unit& u) const { return KLt + (size_t)u.g * 65536 + (size_t)(16 * u.pn + 60) * 512; }
    __device__ __forceinline__ const char* b_base2(const Unit& u) const { return WCt + ((size_t)u.g * 1024 * 128 + (size_t)u.pn * BM * 128) * 2; }
    __device__ __forceinline__ unsigned voffA(int R, int C) const { return (unsigned)(R * AK + C) * 2u; }
    __device__ __forceinline__ unsigned voffB(int R, int C) const { return (unsigned)((((R >> 4) - (C >> 4) + 3) * 256) + (R & 15) * 16 + (C & 15)) * 2u; }
    __device__ __forceinline__ unsigned voffB2(int R, int C) const { return (unsigned)(R * 128 + C) * 2u; }
};

typedef f32x4 Acc[2][2][4][2];
#ifndef WIDE8
#define WIDE8 1
#endif
#ifndef WT_EPI
#define WT_EPI 1
#endif
#if WT_EPI
__device__ __forceinline__ void st16_wt(const void* base, unsigned byte_off, u32x4 v) { __builtin_amdgcn_raw_buffer_store_b128(v, __builtin_amdgcn_make_buffer_rsrc((void*)base, 0, 0x7fffffff, 0x00020000), (int)byte_off, 0, 16); }
#define ST16(base, byte_off, v) st16_wt((base), (unsigned)(byte_off), (v))
#else
#define ST16(base, byte_off, v) (*(u32x4*)((unsigned char*)(base) + (size_t)(unsigned)(byte_off)) = (v))
#endif
#ifndef XP_EPI
#define XP_EPI 1
#endif
constexpr int XP_OFF = EPI_LDS_OFF + 6144;
static_assert(XP_OFF + 8192 <= LDS_BYTES, "lds map");
__device__ __forceinline__ u32x4 xp_to_rows(LAS unsigned char* slot, int fr, int fq, int lane, u32x4 w) { *(LAS u32x4*)(slot + (fr * 4 + fq) * 16) = w; return *(const LAS u32x4*)(slot + lane * 16); }
__device__ __forceinline__ u32x4 xp_to_frag(LAS unsigned char* slot, int fr, int fq, int lane, u32x4 w) { *(LAS u32x4*)(slot + lane * 16) = w; return *(const LAS u32x4*)(slot + (fr * 4 + fq) * 16); }

__device__ __forceinline__ void row_rstd8(const float* ps, int pm, int pm0, int wr, int fr, int fq, LAS unsigned char* lds, float (&rs)[8]);
#ifndef H_TILED
#define H_TILED 1
#endif
#ifndef POOL_PREMUL
#define POOL_PREMUL 1
#endif
#ifndef DOWN_REVK
#define DOWN_REVK 0
#endif
#ifndef WD_TILED
#define WD_TILED 1
#endif
__device__ __forceinline__ f32x4 swg4(f32x4 g, f32x4 u, float c1, float c2) {
    const f32x4 t = g * c1;
    f32x4 e; e[0] = __builtin_amdgcn_exp2f(t[0]); e[1] = __builtin_amdgcn_exp2f(t[1]); e[2] = __builtin_amdgcn_exp2f(t[2]); e[3] = __builtin_amdgcn_exp2f(t[3]);
    const f32x4 d = e + 1.0f;
    f32x4 rc; rc[0] = __builtin_amdgcn_rcpf(d[0]); rc[1] = __builtin_amdgcn_rcpf(d[1]); rc[2] = __builtin_amdgcn_rcpf(d[2]); rc[3] = __builtin_amdgcn_rcpf(d[3]);
    return ((g * u) * c2) * rc;
}
template <bool RSTD, bool F8OUT = false, bool INTACC = false, bool HBF16 = false> struct EpiSwiGLU {
    static constexpr bool PERM = true, AFTER_DRAIN = false, IDEMPOTENT = true;
    bf16_t* H; const float* ps; int pm0; float qs;
    __device__ __forceinline__ void operator()(const Acc& acc, const Unit& u, int wr, int wc, int fr, int fq, LAS unsigned char* lds, int tid) const {
        const int row0 = u.pm * BM + wr * 64 + fr, col0 = u.pn * HALF + wc * 32 + 8 * fq;
        const int lane = tid & 63, rowT = u.pm * BM + wr * 64 + (lane >> 2), colT = u.pn * HALF + wc * 32 + 8 * (lane & 3); LAS unsigned char* const xslot = lds + XP_OFF + (wr * 4 + wc) * 1024; (void)rowT; (void)colT; (void)xslot;
        float rs[8]; u32x2 w8prev = {0u, 0u}; (void)w8prev;
        if constexpr (RSTD) row_rstd8(ps, u.pm, pm0, wr, fr, fq, lds, rs);
#pragma unroll
        for (int ai = 0; ai < 2; ++ai)
#pragma unroll
            for (int m = 0; m < 4; ++m) {
                f32x4 g0 = acc[ai][0][m][0], g1 = acc[ai][0][m][1], u0 = acc[ai][1][m][0], u1 = acc[ai][1][m][1];
                if constexpr (INTACC) {
                    typedef int i32x4v __attribute__((ext_vector_type(4)));
                    g0 = __builtin_convertvector(__builtin_bit_cast(i32x4v, g0), f32x4); g1 = __builtin_convertvector(__builtin_bit_cast(i32x4v, g1), f32x4);
                    u0 = __builtin_convertvector(__builtin_bit_cast(i32x4v, u0), f32x4); u1 = __builtin_convertvector(__builtin_bit_cast(i32x4v, u1), f32x4); }
                const float r = RSTD ? rs[ai * 4 + m] * qs : (INTACC ? qs : 1.0f);
                const float c1 = -1.4426950408889634f * r, c2 = r * r * (F8OUT ? H8_SCALE : 1.0f);
#define SWG(gv, uv) (((gv) * (uv)) * c2 * __builtin_amdgcn_rcpf(1.0f + __builtin_amdgcn_exp2f((gv) * c1)))
#define HQ(x) ((EMU_FP8 && RSTD) ? q8(x) : (x))
#define PK16(a, b) (HBF16 ? cvt_pk_truebf16(a, b) : cvt_pk_bf16(a, b))
                u32x4 w;
                const f32x4 o0 = swg4(g0, u0, c1, c2), o1 = swg4(g1, u1, c1, c2);
                if constexpr (!F8OUT) {
                w.x = PK16(HQ(o0[0]), HQ(o0[1])); w.y = PK16(HQ(o0[2]), HQ(o0[3]));
                w.z = PK16(HQ(o1[0]), HQ(o1[1])); w.w = PK16(HQ(o1[2]), HQ(o1[3])); }
#undef PK16
#undef HQ
                if constexpr (F8OUT) {
                    u32x2 w8; w8.x = pk4_fp8(o0[0], o0[1], o0[2], o0[3]); w8.y = pk4_fp8(o1[0], o1[1], o1[2], o1[3]);
#if WIDE8
                    if ((m & 1) == 0) { w8prev = w8; continue; }
                    const u32x2 sx = __builtin_amdgcn_permlane16_swap(w8prev.x, w8.x, false, false), sy = __builtin_amdgcn_permlane16_swap(w8prev.y, w8.y, false, false);
                    const u32x4 w16 = {sx.x, sy.x, sx.y, sy.y}; const int rst = row0 + ai * HALF + (m - 1 + (fq & 1)) * 16, cst = col0 & ~8;
                    *(u32x4*)((unsigned char*)H + ((size_t)(cst >> 7) * M + rst) * 128 + (cst & 127)) = w16; continue; }
#else
                    *(u32x2*)((unsigned char*)H + ((size_t)(col0 >> 7) * M + (row0 + ai * HALF + m * 16)) * 128 + (col0 & 127)) = w8; continue; }
#endif
#if H_TILED
                if (XP_EPI) ST16(H, (((unsigned)(colT >> 6) * M + (rowT + ai * HALF + m * 16)) * 64 + (colT & 63)) * 2u, xp_to_rows(xslot, fr, fq, lane, w));
                else ST16(H, (((unsigned)(col0 >> 6) * M + (row0 + ai * HALF + m * 16)) * 64 + (col0 & 63)) * 2u, w); }
#else
                *(u32x4*)(H + (size_t)(row0 + ai * HALF + m * 16) * FF + col0) = w; }
#endif
#undef SWG
    }
};
struct EpiResF32 {
    static constexpr bool PERM = false, AFTER_DRAIN = false, IDEMPOTENT = false;
    const float* base; float* out; float alpha;
    __device__ __forceinline__ void operator()(const Acc& acc, const Unit& u, int wr, int wc, int fr, int fq, LAS unsigned char* lds, int tid) const {
        const int row0 = u.pm * BM + wr * 64 + fr, col0 = u.pn * BM + wc * 32 + 4 * fq;
#pragma unroll
        for (int ai = 0; ai < 2; ++ai)
#pragma unroll
            for (int m = 0; m < 4; ++m) { const size_t off = (size_t)(row0 + ai * HALF + m * 16) * D + col0;
#pragma unroll
                for (int bj = 0; bj < 2; ++bj)
#pragma unroll
                    for (int n = 0; n < 2; ++n) { const f32x4 b = *(const f32x4*)(base + off + bj * HALF + n * 16); *(f32x4*)(out + off + bj * HALF + n * 16) = b + acc[ai][bj][m][n] * alpha; } }
    }
};
__device__ __forceinline__ void row_rstd8(const float* ps, int pm, int pm0, int wr, int fr, int fq, LAS unsigned char* lds, float (&rs)[8]) {
    if (pm == pm0) {
        const LAS float* RS = (const LAS float*)(lds + EPI_LDS_OFF + 4096);
#pragma unroll
        for (int ai = 0; ai < 2; ++ai)
#pragma unroll
            for (int m = 0; m < 4; ++m) rs[ai * 4 + m] = RS[ai * HALF + wr * 64 + m * 16 + fr];
        return; }
    f32x4 p[8];
#pragma unroll
    for (int ai = 0; ai < 2; ++ai)
#pragma unroll
        for (int m = 0; m < 4; ++m) p[ai * 4 + m] = *(const f32x4*)(ps + (size_t)(pm * BM + ai * HALF + wr * 64 + m * 16 + fr) * 16 + 4 * fq);
#pragma unroll
    for (int i = 0; i < 8; ++i) { float t = (p[i].x + p[i].y) + (p[i].z + p[i].w); t += __shfl_xor(t, 16); t += __shfl_xor(t, 32); rs[i] = 1.0f / sqrtf(t * (1.f / D) + NORM_EPS); }
}
template <bool BASE_F32, int QOUT = 0, bool ROWSC = false, bool OUT_MIX = false, bool BASE_MIX = false> struct EpiResNorm {
    static constexpr bool PERM = true, AFTER_DRAIN = false, IDEMPOTENT = false;
    const void* base; float alpha; bf16_t* xb; float* ps; void* xq;
    __device__ __forceinline__ void operator()(const Acc& acc, const Unit& u, int wr, int wc, int fr, int fq, LAS unsigned char* lds, int tid) const {
        const int row0 = u.pm * BM + wr * 64 + fr, col0 = u.pn * BM + wc * 32 + 8 * fq;
        const int lane = tid & 63, rowT = XP_EPI ? u.pm * BM + wr * 64 + (lane >> 2) : row0, colT = XP_EPI ? u.pn * BM + wc * 32 + 8 * (lane & 3) : col0; LAS unsigned char* const xslot = lds + XP_OFF + (wr * 4 + wc) * 1024;
        LAS float* P = (LAS float*)(lds + EPI_LDS_OFF);
#pragma unroll
        for (int ai = 0; ai < 2; ++ai)
#pragma unroll
            for (int mp = 0; mp < 2; ++mp) {
                f32x4 bv[2][2][2]; u32x4 bq[2][2]; (void)bq; u32x2 qprev[2] = {{0u, 0u}, {0u, 0u}}; (void)qprev;
#pragma unroll
                for (int mm = 0; mm < 2; ++mm) { const size_t off = (size_t)(rowT + ai * HALF + (2 * mp + mm) * 16) * D + colT;
#pragma unroll
                    for (int bj = 0; bj < 2; ++bj) {
                        if constexpr (BASE_F32) { bv[mm][bj][0] = *(const f32x4*)((const float*)base + off + bj * HALF); bv[mm][bj][1] = *(const f32x4*)((const float*)base + off + bj * HALF + 4); }
                        else { bq[mm][bj] = *(const u32x4*)((const bf16_t*)base + off + bj * HALF); } } }
#pragma unroll
                for (int mm = 0; mm < 2; ++mm) {
#pragma unroll
                    for (int bj = 0; bj < 2; ++bj) {
                        if constexpr (BASE_F32) { if (XP_EPI) { bv[mm][bj][0] = __builtin_bit_cast(f32x4, xp_to_frag(xslot, fr, fq, lane, __builtin_bit_cast(u32x4, bv[mm][bj][0]))); bv[mm][bj][1] = __builtin_bit_cast(f32x4, xp_to_frag(xslot, fr, fq, lane, __builtin_bit_cast(u32x4, bv[mm][bj][1]))); } }
                        else { const u32x4 q = XP_EPI ? xp_to_frag(xslot, fr, fq, lane, bq[mm][bj]) : bq[mm][bj];
                            if constexpr (BASE_MIX && F16 && MIX_BF16) { bv[mm][bj][0] = (f32x4){__builtin_bit_cast(float, q.x << 16), __builtin_bit_cast(float, q.x & 0xffff0000u), __builtin_bit_cast(float, q.y << 16), __builtin_bit_cast(float, q.y & 0xffff0000u)};
                                bv[mm][bj][1] = (f32x4){__builtin_bit_cast(float, q.z << 16), __builtin_bit_cast(float, q.z & 0xffff0000u), __builtin_bit_cast(float, q.w << 16), __builtin_bit_cast(float, q.w & 0xffff0000u)}; }
                            else { bv[mm][bj][0] = (f32x4){bf_lo(q.x), bf_hi(q.x), bf_lo(q.y), bf_hi(q.y)}; bv[mm][bj][1] = (f32x4){bf_lo(q.z), bf_hi(q.z), bf_lo(q.w), bf_hi(q.w)}; } } } }
#pragma unroll
                for (int mm = 0; mm < 2; ++mm) { const int m = 2 * mp + mm; const size_t off = (size_t)(row0 + ai * HALF + m * 16) * D + col0, offT = (size_t)(rowT + ai * HALF + m * 16) * D + colT; float ss = 0.f;
#pragma unroll
                    for (int bj = 0; bj < 2; ++bj) {
                        float al = alpha; if constexpr (ROWSC) al *= ((const LAS float*)(lds + EPI_LDS_OFF + 4096))[ai * HALF + wr * 64 + m * 16 + fr];
                        const f32x4 h0 = bv[mm][bj][0] + acc[ai][bj][m][0] * al, h1 = bv[mm][bj][1] + acc[ai][bj][m][1] * al;
                        ss += (h0[0] * h0[0] + h0[1] * h0[1]) + (h0[2] * h0[2] + h0[3] * h0[3]) + (h1[0] * h1[0] + h1[1] * h1[1]) + (h1[2] * h1[2] + h1[3] * h1[3]);
                        u32x4 w; if constexpr (OUT_MIX) { w.x = pk16m(h0[0], h0[1]); w.y = pk16m(h0[2], h0[3]); w.z = pk16m(h1[0], h1[1]); w.w = pk16m(h1[2], h1[3]); } else { w.x = cvt_pk_bf16(h0[0], h0[1]); w.y = cvt_pk_bf16(h0[2], h0[3]); w.z = cvt_pk_bf16(h1[0], h1[1]); w.w = cvt_pk_bf16(h1[2], h1[3]); }
                        ST16(xb, (unsigned)(offT + bj * HALF) * 2u, XP_EPI ? xp_to_rows(xslot, fr, fq, lane, w) : w);
                        if constexpr (QOUT == 1) { u32x4 q; q.x = cvt_pk_bf16(qint8(h0[0] * AQ_SCALE), qint8(h0[1] * AQ_SCALE)); q.y = cvt_pk_bf16(qint8(h0[2] * AQ_SCALE), qint8(h0[3] * AQ_SCALE));
                            q.z = cvt_pk_bf16(qint8(h1[0] * AQ_SCALE), qint8(h1[1] * AQ_SCALE)); q.w = cvt_pk_bf16(qint8(h1[2] * AQ_SCALE), qint8(h1[3] * AQ_SCALE));
                            *(u32x4*)((bf16_t*)xq + off + bj * HALF) = q; }
                        if constexpr (QOUT == 2) { u32x2 q; q.x = pk4_i8(h0[0] * AQ_SCALE, h0[1] * AQ_SCALE, h0[2] * AQ_SCALE, h0[3] * AQ_SCALE); q.y = pk4_i8(h1[0] * AQ_SCALE, h1[1] * AQ_SCALE, h1[2] * AQ_SCALE, h1[3] * AQ_SCALE);
#if WIDE8
                            if (mm == 0) qprev[bj] = q;
                            else { const u32x2 sx = __builtin_amdgcn_permlane16_swap(qprev[bj].x, q.x, false, false), sy = __builtin_amdgcn_permlane16_swap(qprev[bj].y, q.y, false, false);
                                const u32x4 q16 = {sx.x, sy.x, sx.y, sy.y}; const size_t ost = (size_t)(row0 + ai * HALF + (2 * mp + (fq & 1)) * 16) * D + (col0 & ~8);
                                *(u32x4*)((unsigned char*)xq + ost + bj * HALF) = q16; } } }
#else
                            *(u32x2*)((unsigned char*)xq + off + bj * HALF) = q; } }
#endif
                    ss += __shfl_xor(ss, 16); ss += __shfl_xor(ss, 32);
                    if (fq == 0) P[(ai * HALF + wr * 64 + m * 16 + fr) * 4 + wc] = ss; } }
        LDS_WAIT(); __builtin_amdgcn_s_barrier(); asm volatile("" ::: "memory");
        if (tid < BM) { const f32x4 q = *(const LAS f32x4*)(P + tid * 4); ps[(size_t)(u.pm * BM + tid) * 16 + u.pn] = (q.x + q.y) + (q.z + q.w); }
    }
};
__device__ __forceinline__ void rstd_table(const float* ps, int pm, LAS unsigned char* lds, int tid) {
    if (pm >= 0 && tid < BM) { const f32x4* p = (const f32x4*)(ps + (size_t)(pm * BM + tid) * 16); const f32x4 a = p[0], b = p[1], c = p[2], d = p[3];
        const float t = (((a.x + a.y) + (a.z + a.w)) + ((b.x + b.y) + (b.z + b.w))) + (((c.x + c.y) + (c.z + c.w)) + ((d.x + d.y) + (d.z + d.w)));
        ((LAS float*)(lds + EPI_LDS_OFF + 4096))[tid] = 1.0f / sqrtf(t * (1.f / D) + NORM_EPS); }
    __syncthreads();
}
__device__ __forceinline__ void rstd2_table(const float* ps2, int pm, LAS unsigned char* lds, int tid) {
    if (pm >= 0 && tid < BM) { const f32x4* p = (const f32x4*)(ps2 + (size_t)(pm * BM + tid) * 16); const f32x4 a = p[0], b = p[1], c = p[2], d = p[3];
        const float tp = ((a.x + a.y) + (a.z + a.w)) + ((b.x + b.y) + (b.z + b.w)), ts = ((c.x + c.y) + (c.z + c.w)) + ((d.x + d.y) + (d.z + d.w));
        const float rp = 1.0f / sqrtf(tp * (1.f / PW) + NORM_EPS), rs = 1.0f / sqrtf(ts * (1.f / SW) + NORM_EPS);
        ((LAS float*)(lds + EPI_LDS_OFF + 4096))[tid] = rs; ((LAS float*)(lds + EPI_LDS_OFF + 5120))[tid] = rp / rs; }
    __syncthreads();
}
struct EpiZ {
    static constexpr bool PERM = true, AFTER_DRAIN = false, IDEMPOTENT = false;
    bf16_t* zpool; bf16_t* as5; const float* ps; int pm0;
    __device__ __forceinline__ void operator()(const Acc& acc, const Unit& u, int wr, int wc, int fr, int fq, LAS unsigned char* lds, int tid) const {
        const int row0 = u.pm * BM + wr * 64 + fr;
        float rs[8]; row_rstd8(ps, u.pm, pm0, wr, fr, fq, lds, rs);
#pragma unroll
        for (int ai = 0; ai < 2; ++ai)
#pragma unroll
            for (int m = 0; m < 4; ++m) { const int row = row0 + ai * HALF + m * 16;
#pragma unroll
                for (int bj = 0; bj < 2; ++bj) { const f32x4 v0 = acc[ai][bj][m][0] * rs[ai * 4 + m], v1 = acc[ai][bj][m][1] * rs[ai * 4 + m];
                    u32x4 w; w.x = cvt_pk_bf16(v0[0], v0[1]); w.y = cvt_pk_bf16(v0[2], v0[3]); w.z = cvt_pk_bf16(v1[0], v1[1]); w.w = cvt_pk_bf16(v1[2], v1[3]);
                    const int col = u.pn * BM + bj * HALF + wc * 32 + 8 * fq;
                    if (u.pn < 8) ST16(zpool, ((unsigned)row * PW + col) * 2u, w);
                    else { const int cs = col - PW, g = cs >> 4, h0 = cs & 15; ST16(as5, (unsigned)((g * CR + (row >> 6)) * AK + (row & 63) * SH + h0) * 2u, w); } } }
    }
};
__device__ __forceinline__ void tile_row_ss(float (&ss8)[8], float* ps, int pm, int slot, int wr, int wc, int fr, int fq, LAS unsigned char* lds, int tid) {
    LAS float* P = (LAS float*)(lds + EPI_LDS_OFF);
#pragma unroll
    for (int i = 0; i < 8; ++i) { float t = ss8[i]; t += __shfl_xor(t, 16); t += __shfl_xor(t, 32); if (fq == 0) P[((i >> 2) * HALF + wr * 64 + (i & 3) * 16 + fr) * 4 + wc] = t; }
    LDS_WAIT(); __builtin_amdgcn_s_barrier(); asm volatile("" ::: "memory");
    if (tid < BM) { const f32x4 q = *(const LAS f32x4*)(P + tid * 4); ps[(size_t)(pm * BM + tid) * 16 + slot] = (q.x + q.y) + (q.z + q.w); }
}
struct EpiPool {
    static constexpr bool PERM = true, AFTER_DRAIN = false, IDEMPOTENT = false;
    bf16_t* O; const float* scale; float* ps2;
    __device__ __forceinline__ void operator()(const Acc& acc, const Unit& u, int wr, int wc, int fr, int fq, LAS unsigned char* lds, int tid) const {
        const int row0 = u.pm * BM + wr * 64 + fr, col0 = u.g * PGW + u.pn * BM + wc * 32 + 8 * fq;
        f32x4 sv[2][2];
#pragma unroll
        for (int bj = 0; bj < 2; ++bj)
#pragma unroll
            for (int n = 0; n < 2; ++n) sv[bj][n] = *(const f32x4*)(scale + col0 + bj * HALF + 4 * n);
        float ss8[8];
#pragma unroll
        for (int ai = 0; ai < 2; ++ai)
#pragma unroll
            for (int m = 0; m < 4; ++m) { bf16_t* rowp = O + (size_t)(row0 + ai * HALF + m * 16) * D + col0; float ss = 0.f;
#pragma unroll
                for (int bj = 0; bj < 2; ++bj) { const f32x4 v0 = acc[ai][bj][m][0] * sv[bj][0], v1 = acc[ai][bj][m][1] * sv[bj][1];
                    ss += (v0[0] * v0[0] + v0[1] * v0[1]) + (v0[2] * v0[2] + v0[3] * v0[3]) + (v1[0] * v1[0] + v1[1] * v1[1]) + (v1[2] * v1[2] + v1[3] * v1[3]);
                    u32x4 w; w.x = cvt_pk_bf16(v0[0], v0[1]); w.y = cvt_pk_bf16(v0[2], v0[3]); w.z = cvt_pk_bf16(v1[0], v1[1]); w.w = cvt_pk_bf16(v1[2], v1[3]);
                    *(u32x4*)(rowp + bj * HALF) = w; }
                ss8[ai * 4 + m] = ss; }
        tile_row_ss(ss8, ps2, u.pm, u.g * 2 + u.pn, wr, wc, fr, fq, lds, tid);
    }
};
struct EpiComb {
    static constexpr bool PERM = true, AFTER_DRAIN = false, IDEMPOTENT = false;
    bf16_t* O; const float* gain;
    __device__ __forceinline__ void operator()(const Acc& acc, const Unit& u, int wr, int wc, int fr, int fq, LAS unsigned char* lds, int tid) const {
        const int row0 = u.g * PGW + u.pm * BM + wr * 64 + fr, col0 = u.pn * BM + wc * 32 + 8 * fq;
        f32x4 gv[2][2];
#pragma unroll
        for (int bj = 0; bj < 2; ++bj)
#pragma unroll
            for (int n = 0; n < 2; ++n) gv[bj][n] = *(const f32x4*)(gain + col0 + bj * HALF + 4 * n);
#pragma unroll
        for (int ai = 0; ai < 2; ++ai)
#pragma unroll
            for (int m = 0; m < 4; ++m) { bf16_t* rowp = O + (size_t)(row0 + ai * HALF + m * 16) * D + col0;
#pragma unroll
                for (int bj = 0; bj < 2; ++bj) { const f32x4 v0 = acc[ai][bj][m][0] * gv[bj][0], v1 = acc[ai][bj][m][1] * gv[bj][1];
                    u32x4 w; w.x = pk16m(v0[0], v0[1]); w.y = pk16m(v0[2], v0[3]); w.z = pk16m(v1[0], v1[1]); w.w = pk16m(v1[2], v1[3]);
                    *(u32x4*)(rowp + bj * HALF) = w; } }
    }
};
struct EpiS5Y {
    static constexpr bool PERM = true, AFTER_DRAIN = false, IDEMPOTENT = false;
    bf16_t* Y;
    __device__ __forceinline__ void operator()(const Acc& acc, const Unit& u, int wr, int wc, int fr, int fq, LAS unsigned char* lds, int tid) const {
        const int cr0 = wr * 64 + fr, h0 = 8 * (fq & 1);
#pragma unroll
        for (int ai = 0; ai < 2; ++ai)
#pragma unroll
            for (int m = 0; m < 4; ++m) { const int cr = cr0 + ai * HALF + m * 16;
#pragma unroll
                for (int bj = 0; bj < 2; ++bj) { const f32x4 v0 = acc[ai][bj][m][0], v1 = acc[ai][bj][m][1];
                    u32x4 w; w.x = cvt_pk_bf16(gelu_tanh_f(v0[0]), gelu_tanh_f(v0[1])); w.y = cvt_pk_bf16(gelu_tanh_f(v0[2]), gelu_tanh_f(v0[3]));
                    w.z = cvt_pk_bf16(gelu_tanh_f(v1[0]), gelu_tanh_f(v1[1])); w.w = cvt_pk_bf16(gelu_tanh_f(v1[2]), gelu_tanh_f(v1[3]));
                    const int j = u.pn * 16 + bj * 8 + wc * 2 + (fq >> 1);
                    ST16(Y, ((unsigned)(cr * CL + j) * SW + u.g * SH + h0) * 2u, w); } }
    }
};
struct EpiGLU {
    static constexpr bool PERM = true, AFTER_DRAIN = false, IDEMPOTENT = false;
    const bf16_t* Y; bf16_t* O; const float* bias; float* ps2;
    __device__ __forceinline__ void operator()(const Acc& acc, const Unit& u, int wr, int wc, int fr, int fq, LAS unsigned char* lds, int tid) const {
        const int row0 = u.pm * BM + wr * 64 + fr, col0 = u.pn * BM + wc * 32 + 8 * fq;
        f32x4 bv[2][2];
#pragma unroll
        for (int bj = 0; bj < 2; ++bj)
#pragma unroll
            for (int n = 0; n < 2; ++n) bv[bj][n] = *(const f32x4*)(bias + col0 + bj * HALF + 4 * n);
        float ss8[8];
#pragma unroll
        for (int ai = 0; ai < 2; ++ai)
#pragma unroll
            for (int m = 0; m < 4; ++m) { const int row = row0 + ai * HALF + m * 16; float ss = 0.f;
#pragma unroll
                for (int bj = 0; bj < 2; ++bj) { const f32x4 v0 = acc[ai][bj][m][0] + bv[bj][0], v1 = acc[ai][bj][m][1] + bv[bj][1];
                    const u32x4 yv = *(const u32x4*)(Y + (size_t)row * SW + col0 + bj * HALF);
                    float o[8]; o[0] = bf_lo(yv.x) * fast_sigmoid(v0[0]); o[1] = bf_hi(yv.x) * fast_sigmoid(v0[1]); o[2] = bf_lo(yv.y) * fast_sigmoid(v0[2]); o[3] = bf_hi(yv.y) * fast_sigmoid(v0[3]);
                    o[4] = bf_lo(yv.z) * fast_sigmoid(v1[0]); o[5] = bf_hi(yv.z) * fast_sigmoid(v1[1]); o[6] = bf_lo(yv.w) * fast_sigmoid(v1[2]); o[7] = bf_hi(yv.w) * fast_sigmoid(v1[3]);
                    ss += (o[0] * o[0] + o[1] * o[1]) + (o[2] * o[2] + o[3] * o[3]) + (o[4] * o[4] + o[5] * o[5]) + (o[6] * o[6] + o[7] * o[7]);
                    u32x4 w; w.x = pk16m(o[0], o[1]); w.y = pk16m(o[2], o[3]); w.z = pk16m(o[4], o[5]); w.w = pk16m(o[6], o[7]);
                    ST16(O, ((unsigned)row * D + SW + col0 + bj * HALF) * 2u, w); }
                ss8[ai * 4 + m] = ss; }
        tile_row_ss(ss8, ps2, u.pm, 8 + u.pn, wr, wc, fr, fq, lds, tid);
    }
};
struct EpiCarry {
    static constexpr bool PERM = false, AFTER_DRAIN = true, IDEMPOTENT = false;
    bf16_t* as5; const float* lp;
    __device__ __forceinline__ void fused(const Acc& acc, const Unit& u, int wr, int wc, int fr, int fq, LAS unsigned char* lds, int wid, int lane) const {
        LAS float* S = (LAS float*)lds;
#pragma unroll
        for (int ai = 0; ai < 2; ++ai)
#pragma unroll
            for (int m = 0; m < 4; ++m) { const int r = ai * HALF + wr * 64 + m * 16 + fr;
#pragma unroll
                for (int n = 0; n < 2; ++n) *(LAS f32x4*)(S + r * 128 + wc * 32 + n * 16 + 4 * fq) = acc[ai][0][m][n]; }
        LDS_WAIT(); __builtin_amdgcn_s_barrier(); asm volatile("" ::: "memory");
        const int b = wid, p = lane;
        const f32x2 L = *(const f32x2*)(lp + ((size_t)u.g * SP + p) * 2);
        float xr = 0.f, xi = 0.f;
        bf16_t* dst = as5 + (size_t)(u.g * CR + b * 32) * AK + CL * SH;
        for (int c = 0; c < 32; ++c) {
            const float sr = S[(b * 32 + c) * 128 + p], si = S[(b * 32 + c) * 128 + 64 + p];
            dst[(size_t)c * AK + p] = (bf16_t)f2bf(xr); dst[(size_t)c * AK + 64 + p] = (bf16_t)f2bf(xi);
            const float nr = L.x * xr - L.y * xi + sr, ni = L.x * xi + L.y * xr + si; xr = nr; xi = ni; }
    }
};

typedef int i32x4 __attribute__((ext_vector_type(4)));
typedef int i32x8 __attribute__((ext_vector_type(8)));
__device__ __forceinline__ i32x8 cat8(bf16x8 a, bf16x8 b) { return __builtin_shufflevector(__builtin_bit_cast(i32x4, a), __builtin_bit_cast(i32x4, b), 0, 1, 2, 3, 4, 5, 6, 7); }
template <class Epi, class Prob, bool ALIGN_EPI, bool SP2, int MODE = 0>
__device__ __forceinline__ void gemm_phase(LAS unsigned char* lds, const Prob& S, const Epi& E) {
    const int tid = threadIdx.x, wid = __builtin_amdgcn_readfirstlane(tid >> 6), lane = tid & 63, wr = wid >> 2, wc = wid & 3, fr = lane & 15, fq = lane >> 4;
    constexpr bool FP8 = (MODE == 1);
    int nt = S.nt, ksu = Prob::TWOSEG ? S.ks : 0; long skipA = 0;
    unsigned voffA0, voffB0, voffB20;
    { int R, C; stage_rc(tid * 16, R, C); const int Rb = Epi::PERM ? ((R & ~31) + perm32(R & 31)) : R;
      voffA0 = S.voffA(R, C); voffB0 = S.voffB(Rb, C); voffB20 = Prob::TWOSEG ? S.voffB2(Rb, C) : 0u; }
    const long dA = (long)S.voffA(64, 0) - (long)S.voffA(0, 0), dB = (long)S.voffB(64, 0) - (long)S.voffB(0, 0), dB2 = Prob::TWOSEG ? ((long)S.voffB2(64, 0) - (long)S.voffB2(0, 0)) : 0;
    const long kstepA = S.kstepA, kstepB = S.kstepB, hstepA = S.hstepA, hstepB = S.hstepB;
    const unsigned ldsw = (unsigned)wid * 1024u;
    const int aoff = lds_byte(wr * 64 + fr, fq * 8), boff = lds_byte(wc * 32 + fr, fq * 8);
#define PG8_SA(b, h) (((b) * 2 + (h)) * HTB)
#define PG8_SB(b, h) ((4 + (b) * 2 + (h)) * HTB)
#define PG8_STAGE(bufoff, gbase, v0, d) do { const unsigned _v0 = (v0); const char* _g0 = (const char*)(gbase); const char* _g1 = _g0 + (d); asm volatile("" : "+s"(_g0), "+s"(_g1)); \
        __builtin_amdgcn_global_load_lds((const unsigned*)(_g0 + _v0), (LAS unsigned*)(lds + (bufoff) + ldsw), 16, 0, 0); \
        __builtin_amdgcn_global_load_lds((const unsigned*)(_g1 + _v0), (LAS unsigned*)(lds + (bufoff) + ldsw + 8192), 16, 0, 0); } while (0)
#define PG8_STA(bufoff, gbase) PG8_STAGE(bufoff, gbase, voffA0, dA)
#define PG8_LDA(dst, b, h) do { _Pragma("unroll") for (int m = 0; m < 4; ++m) { if constexpr (FP8) { dst##8[m].lo = *(const LAS i32x4*)(lds + PG8_SA(b, h) + aoff + m * 2048); dst##8[m].hi = *(const LAS i32x4*)(lds + PG8_SA(b, h) + aoff + m * 2048 + 1024); } \
        else { _Pragma("unroll") for (int k = 0; k < 2; ++k) dst[m][k] = *(const LAS bf16x8*)(lds + PG8_SA(b, h) + aoff + m * 2048 + k * 1024); } } } while (0)
#define PG8_LDB(dst, b, h) do { _Pragma("unroll") for (int n = 0; n < 2; ++n) { if constexpr (FP8) { dst##8[n].lo = *(const LAS i32x4*)(lds + PG8_SB(b, h) + boff + n * 2048); dst##8[n].hi = *(const LAS i32x4*)(lds + PG8_SB(b, h) + boff + n * 2048 + 1024); } \
        else { _Pragma("unroll") for (int k = 0; k < 2; ++k) dst[n][k] = *(const LAS bf16x8*)(lds + PG8_SB(b, h) + boff + n * 2048 + k * 1024); } } } while (0)
#define PG8_MMA(ai, bj, At, Bt) do { if (!FAST_ENTRY) __builtin_amdgcn_s_setprio(1); \
        if constexpr (FP8) { _Pragma("unroll") for (int m = 0; m < 4; ++m) _Pragma("unroll") for (int n = 0; n < 2; ++n) \
            acc[ai][bj][m][n] = __builtin_amdgcn_mfma_scale_f32_16x16x128_f8f6f4(Bt##8[n], At##8[m], acc[ai][bj][m][n], 0, 0, 0, FP8_SCALE_ARG, 0, FP8_SCALE_ARG); } \
        else if constexpr (MODE == 2) { _Pragma("unroll") for (int o_ = 0; o_ < 8; ++o_) _Pragma("unroll") for (int k = 0; k < 2; ++k) { const int m = MMA_NM ? (o_ & 3) : (o_ >> 1), n = MMA_NM ? (o_ >> 2) : (o_ & 1); \
            acc[ai][bj][m][n] = __builtin_bit_cast(f32x4, __builtin_amdgcn_mfma_i32_16x16x64_i8(__builtin_bit_cast(i32x4, Bt[n][k]), __builtin_bit_cast(i32x4, At[m][k]), __builtin_bit_cast(i32x4, acc[ai][bj][m][n]), 0, 0, 0)); if (MMA_PIN) __builtin_amdgcn_sched_barrier(0); } } \
        else { _Pragma("unroll") for (int o_ = 0; o_ < 8; ++o_) _Pragma("unroll") for (int k = 0; k < 2; ++k) { const int m = MMA_NM ? (o_ & 3) : (o_ >> 1), n = MMA_NM ? (o_ >> 2) : (o_ & 1); \
            acc[ai][bj][m][n] = (F16 && MODE != 3) ? __builtin_amdgcn_mfma_f32_16x16x32_f16(__builtin_bit_cast(f16x8, Bt[n][k]), __builtin_bit_cast(f16x8, At[m][k]), acc[ai][bj][m][n], 0, 0, 0) \
                                    : __builtin_amdgcn_mfma_f32_16x16x32_bf16(Bt[n][k], At[m][k], acc[ai][bj][m][n], 0, 0, 0); if (MMA_PIN) __builtin_amdgcn_sched_barrier(0); \
            if (DUP_MFMA) dummy[(m * 2 + n) & 3] = __builtin_amdgcn_mfma_f32_16x16x32_bf16(Bt[n][k], At[m][k], dummy[(m * 2 + n) & 3], 0, 0, 0); } } \
        if (!FAST_ENTRY || (bj) == 1) __builtin_amdgcn_s_setprio(0); } while (0)
#define PG8_WAIT_V(n) asm volatile("s_waitcnt vmcnt(" #n ")" ::: "memory")
#define PG8_WAIT_L(n) asm volatile("s_waitcnt lgkmcnt(" #n ")" ::: "memory")
#define PG8_PRE_MMA() do { if (FAST_ENTRY) { asm volatile("" ::: "memory"); __builtin_amdgcn_s_waitcnt(0x0078); asm volatile("" ::: "memory"); __builtin_amdgcn_s_setprio(1); PG8_BAR; __builtin_amdgcn_sched_barrier(0); } else { PG8_WAIT_V(8); PG8_WAIT_L(0); PG8_BAR; } } while (0)
#define PG8_BAR __builtin_amdgcn_s_barrier()
#define PG8_SCHED __builtin_amdgcn_sched_barrier(0)
    Unit cur, nxt; int ui = 0;
    if (!S.next(0, cur)) return;
    f32x4 acc[2][2][4][2];
#pragma unroll
    for (int a = 0; a < 2; ++a)
#pragma unroll
        for (int b = 0; b < 2; ++b)
#pragma unroll
            for (int m = 0; m < 4; ++m)
#pragma unroll
                for (int n = 0; n < 2; ++n) acc[a][b][m][n] = (f32x4){0.f, 0.f, 0.f, 0.f};
    bf16x8 At[4][2], B0[2][2], B1[2][2]; i32x8 At8[4], B08[2], B18[2];
    f32x4 dummy[4] = {{0.f, 0.f, 0.f, 0.f}, {0.f, 0.f, 0.f, 0.f}, {0.f, 0.f, 0.f, 0.f}, {0.f, 0.f, 0.f, 0.f}};
    const char* cA = S.a_base(cur); const char* cB = S.b_base(cur); const char* cB2 = Prob::TWOSEG ? S.b_base2(cur) : cB;
    if constexpr (Prob::KSKIP) { ksu = S.ks_of(cur); nt = ksu + (S.nt - S.ks); skipA = (long)(S.ks - ksu) * S.kstepA; }
    if constexpr (SP2) {
        PG8_STAGE(PG8_SB(0, 0), cB, voffB0, dB); PG8_STAGE(PG8_SB(0, 1), cB + hstepB, voffB0, dB); PG8_STA(PG8_SA(0, 0), cA); PG8_STA(PG8_SA(0, 1), cA + hstepA);
        if (wr == 1) PG8_BAR;
        PG8_WAIT_V(2); PG8_BAR;
        PG8_STAGE(PG8_SB(1, 0), cB + kstepB, voffB0, dB); PG8_STA(PG8_SA(1, 0), cA + kstepA); PG8_STAGE(PG8_SB(1, 1), cB + hstepB + kstepB, voffB0, dB);
        PG8_WAIT_V(6); PG8_BAR;
    } else {
        PG8_STAGE(PG8_SB(0, 0), cB, voffB0, dB); PG8_STA(PG8_SA(0, 0), cA); PG8_STAGE(PG8_SB(0, 1), cB + hstepB, voffB0, dB); PG8_STA(PG8_SA(0, 1), cA + hstepA);
        if (wr == 1) PG8_BAR;
        PG8_WAIT_V(4); PG8_BAR;
        PG8_STAGE(PG8_SB(1, 0), cB + kstepB, voffB0, dB); PG8_STA(PG8_SA(1, 0), cA + kstepA); PG8_STAGE(PG8_SB(1, 1), cB + hstepB + kstepB, voffB0, dB);
        PG8_WAIT_V(6); PG8_BAR;
    }
    for (;;) {
        const bool has_next = S.next(ui + 1, nxt);
        const char* nA = has_next ? S.a_base(nxt) : cA; const char* nB = has_next ? S.b_base(nxt) : cB; const char* nB2 = (Prob::TWOSEG && has_next) ? S.b_base2(nxt) : cB2;
        for (int t = 0; t < nt; t += 2) {
            asm volatile("" : "+v"(voffA0), "+v"(voffB0), "+v"(voffB20));
            if (S.tmid >= 0 && t == S.tmid) {
                const LAS float* RAT = (const LAS float*)(lds + EPI_LDS_OFF + 5120);
#pragma unroll
                for (int ai = 0; ai < 2; ++ai)
#pragma unroll
                    for (int m = 0; m < 4; ++m) { const float r = RAT[ai * HALF + wr * 64 + m * 16 + fr];
#pragma unroll
                        for (int bj = 0; bj < 2; ++bj)
#pragma unroll
                            for (int n = 0; n < 2; ++n) acc[ai][bj][m][n] = acc[ai][bj][m][n] * r; } }
            const bool last = (t == nt - 2);
            const char* a1 = cA + (long)(t + 1) * kstepA + ((Prob::KSKIP && t >= ksu) ? skipA : 0);
            const char* a2; const char* b2; long kb = kstepB, hb = hstepB, db = dB; unsigned vb0 = voffB0;
            if (last) { a2 = nA; b2 = nB; }
            else { a2 = cA + (long)(t + 2) * kstepA + ((Prob::KSKIP && t + 2 >= ksu) ? skipA : 0);
                   if (Prob::TWOSEG && t + 2 >= ksu) { b2 = cB2 + (long)(t + 2 - ksu) * S.kstepB2; kb = S.kstepB2; hb = S.hstepB2; vb0 = voffB20; db = dB2; }
                   else b2 = cB + (long)(t + 2) * kstepB; }
            const char* a3 = a2 + kstepA; const char* b3 = b2 + kb;
            if constexpr (SP2) {
            PG8_LDB(B0, 0, 0); PG8_LDB(B1, 0, 1); PG8_SCHED; PG8_LDA(At, 0, 0); PG8_STA(PG8_SA(1, 1), a1 + hstepA);
            PG8_PRE_MMA(); PG8_MMA(0, 0, At, B0); PG8_MMA(0, 1, At, B1); PG8_BAR; PG8_SCHED;
#if PG8_SPLIT
            PG8_LDA(At, 0, 1); PG8_STAGE(PG8_SB(0, 0), b2, vb0, db);
            PG8_WAIT_V(4); PG8_WAIT_L(0); PG8_BAR; PG8_MMA(1, 0, At, B0); PG8_SCHED; PG8_STAGE(PG8_SB(0, 1), b2 + hb, vb0, db); PG8_SCHED; PG8_MMA(1, 1, At, B1); PG8_SCHED; PG8_STA(PG8_SA(0, 0), a2); PG8_BAR; PG8_SCHED;
#else
            PG8_LDA(At, 0, 1); PG8_STAGE(PG8_SB(0, 0), b2, vb0, db); PG8_STAGE(PG8_SB(0, 1), b2 + hb, vb0, db); PG8_STA(PG8_SA(0, 0), a2);
            PG8_PRE_MMA(); PG8_MMA(1, 0, At, B0); PG8_MMA(1, 1, At, B1); PG8_BAR; PG8_SCHED;
#endif
            PG8_LDB(B0, 1, 0); PG8_LDB(B1, 1, 1); PG8_SCHED; PG8_LDA(At, 1, 0); PG8_STA(PG8_SA(0, 1), a2 + hstepA);
            PG8_PRE_MMA(); PG8_MMA(0, 0, At, B0); PG8_MMA(0, 1, At, B1); PG8_BAR; PG8_SCHED;
#if PG8_SPLIT
            PG8_LDA(At, 1, 1); PG8_STAGE(PG8_SB(1, 0), b3, vb0, db);
            PG8_WAIT_V(4); PG8_WAIT_L(0); PG8_BAR; PG8_MMA(1, 0, At, B0); PG8_SCHED; PG8_STAGE(PG8_SB(1, 1), b3 + hb, vb0, db); PG8_SCHED; PG8_MMA(1, 1, At, B1); PG8_SCHED; PG8_STA(PG8_SA(1, 0), a3); PG8_BAR; PG8_SCHED;
#else
            PG8_LDA(At, 1, 1); PG8_STAGE(PG8_SB(1, 0), b3, vb0, db); PG8_STAGE(PG8_SB(1, 1), b3 + hb, vb0, db); PG8_STA(PG8_SA(1, 0), a3);
            PG8_PRE_MMA(); PG8_MMA(1, 0, At, B0); PG8_MMA(1, 1, At, B1); PG8_BAR; PG8_SCHED;
#endif
            } else {
            PG8_LDB(B0, 0, 0); PG8_SCHED; PG8_LDA(At, 0, 0); PG8_STA(PG8_SA(1, 1), a1 + hstepA);
            PG8_WAIT_L(8); PG8_BAR; PG8_WAIT_L(0); PG8_MMA(0, 0, At, B0); PG8_BAR; PG8_SCHED;
            PG8_LDB(B1, 0, 1); PG8_STAGE(PG8_SB(0, 0), b2, vb0, db);
            PG8_BAR; PG8_WAIT_L(0); PG8_MMA(0, 1, At, B1); PG8_BAR;
            PG8_LDA(At, 0, 1); PG8_STA(PG8_SA(0, 0), a2);
            PG8_BAR; PG8_WAIT_L(0); PG8_MMA(1, 0, At, B0); PG8_BAR; PG8_SCHED;
            PG8_STAGE(PG8_SB(0, 1), b2 + hb, vb0, db);
            PG8_WAIT_V(6); PG8_BAR; PG8_MMA(1, 1, At, B1); PG8_BAR;
            PG8_LDB(B0, 1, 0); PG8_SCHED; PG8_LDA(At, 1, 0); PG8_STA(PG8_SA(0, 1), a2 + hstepA);
            PG8_WAIT_L(8); PG8_BAR; PG8_WAIT_L(0); PG8_MMA(0, 0, At, B0); PG8_BAR; PG8_SCHED;
            PG8_LDB(B1, 1, 1); PG8_STAGE(PG8_SB(1, 0), b3, vb0, db);
            PG8_BAR; PG8_WAIT_L(0); PG8_MMA(0, 1, At, B1); PG8_BAR;
            PG8_LDA(At, 1, 1); PG8_STA(PG8_SA(1, 0), a3);
            PG8_BAR; PG8_WAIT_L(0); PG8_MMA(1, 0, At, B0); PG8_BAR; PG8_SCHED;
            PG8_STAGE(PG8_SB(1, 1), b3 + hb, vb0, db);
            PG8_WAIT_V(6); PG8_BAR; PG8_MMA(1, 1, At, B1); PG8_BAR;
            }
        }
        if constexpr (ALIGN_EPI) { if (wr == 0) PG8_BAR; }
        if constexpr (!Epi::AFTER_DRAIN) {
            int tz = threadIdx.x; asm volatile("" : "+v"(tz)); const int lz = tz & 63;
            E(acc, cur, wr, wc, lz & 15, lz >> 4, lds, tz);
            if (EPI_TWICE && Epi::IDEMPOTENT) E(acc, cur, wr, wc, lz & 15, lz >> 4, lds, tz); }
        if (!has_next) break;
#pragma unroll
        for (int a = 0; a < 2; ++a)
#pragma unroll
            for (int b = 0; b < 2; ++b)
#pragma unroll
                for (int m = 0; m < 4; ++m)
#pragma unroll
                    for (int n = 0; n < 2; ++n) acc[a][b][m][n] = (f32x4){0.f, 0.f, 0.f, 0.f};
        cur = nxt; cA = nA; cB = nB; cB2 = nB2; ++ui;
        if constexpr (Prob::KSKIP) { ksu = S.ks_of(cur); nt = ksu + (S.nt - S.ks); skipA = (long)(S.ks - ksu) * S.kstepA; }
        if constexpr (ALIGN_EPI) { if (wr == 1) PG8_BAR; }
    }
    if (DUP_MFMA) asm volatile("" :: "v"(dummy[0]), "v"(dummy[1]), "v"(dummy[2]), "v"(dummy[3]));
    PG8_WAIT_V(0);
    if constexpr (!ALIGN_EPI) { if (wr == 0) PG8_BAR; }
    PG8_BAR;
    if constexpr (Epi::AFTER_DRAIN) { E.fused(acc, cur, wr, wc, fr, fq, lds, wid, lane); }
#undef PG8_SA
#undef PG8_SB
#undef PG8_STAGE
#undef PG8_STA
#undef PG8_LDA
#undef PG8_LDB
#undef PG8_MMA
#undef PG8_WAIT_V
#undef PG8_WAIT_L
#undef PG8_PRE_MMA
#undef PG8_BAR
#undef PG8_SCHED
}
}

#define XB_TMO      128
#define XB_XCNT(j)  (256  + 64 * (j))
#define XB_XSUB(j)  (1280 + 64 * (j))
#define XB_XGEN(j)  (2304 + 64 * (j))
#define XB_TOP      3328
#define XB_TOPGEN   3392
#define XCD_BAR_WORDS 3456
#define XB_SPIN_CAP (1u << 18)
__device__ __forceinline__ unsigned xb_ld(unsigned* p)              { return __hip_atomic_load(p, __ATOMIC_RELAXED, __HIP_MEMORY_SCOPE_AGENT); }
__device__ __forceinline__ unsigned xb_add(unsigned* p, unsigned v) { return __hip_atomic_fetch_add(p, v, __ATOMIC_RELAXED, __HIP_MEMORY_SCOPE_AGENT); }
__device__ __forceinline__ unsigned xb_xcc_id() { return (unsigned)__builtin_amdgcn_s_getreg((3 << 11) | 20) & 0xFu; }
#define XB_SPIN(cond, bar) do { unsigned _sp = 0; while (cond) { __builtin_amdgcn_s_sleep(1); \
    if ((++_sp & 255u) == 0u) { if (xb_ld(&(bar)[XB_TMO])) break; if (_sp > XB_SPIN_CAP) { atomicAdd(&(bar)[XB_TMO], 1u); break; } } } } while (0)
struct XcdBarrier { unsigned* bar; unsigned x; volatile LAS unsigned* st; };
__device__ __forceinline__ XcdBarrier xcd_barrier_post(unsigned* bar, volatile LAS unsigned* st) {
    XcdBarrier b; b.bar = bar; b.x = xb_xcc_id(); b.st = st;
    if (threadIdx.x == 0) (void)xb_add(&bar[XB_XCNT(b.x)], 1u);
    return b;
}
__device__ __forceinline__ void xcd_barrier_complete(unsigned* bar, unsigned x, unsigned& nloc, unsigned& nx) {
    const unsigned G = gridDim.x * gridDim.y * gridDim.z;
    unsigned sum, cnt, mine, sp = 0u;
    for (;;) {
        sum = 0u; cnt = 0u; mine = 0u;
#pragma unroll
        for (unsigned j = 0; j < 16; ++j) { const unsigned c = xb_ld(&bar[XB_XCNT(j)]); sum += c; cnt += (c > 0u) ? 1u : 0u; mine = (j == x) ? c : mine; }
        if (sum == G) break;
        __builtin_amdgcn_s_sleep(1);
        if ((++sp & 255u) == 0u) { if (xb_ld(&bar[XB_TMO])) break; if (sp > XB_SPIN_CAP) { atomicAdd(&bar[XB_TMO], 1u); break; } }
    }
    nloc = mine > 0u ? mine : 1u; nx = cnt > 0u ? cnt : 1u;
}
__device__ __forceinline__ void xcd_barrier(const XcdBarrier& b) {
    asm volatile("s_waitcnt vmcnt(0)" ::: "memory");
    __syncthreads();
    if (threadIdx.x == 0) {
        unsigned* bar = b.bar;
        __builtin_amdgcn_s_waitcnt(0);
        unsigned nloc = b.st[0], nx = b.st[1];
        if (nloc == 0u) { xcd_barrier_complete(bar, b.x, nloc, nx); b.st[0] = nloc; b.st[1] = nx; }
        const unsigned old = xb_add(&bar[XB_XSUB(b.x)], 1u);
        const unsigned gen = old / nloc;
        if (old + 1u == (gen + 1u) * nloc) {
            __builtin_amdgcn_fence(__ATOMIC_RELEASE, "agent");
            asm volatile("s_waitcnt vmcnt(0)" ::: "memory");
            const unsigned og = xb_add(&bar[XB_TOP], 1u);
            const unsigned tg = og / nx;
            if (og + 1u == (tg + 1u) * nx) xb_add(&bar[XB_TOPGEN], 1u);
            else XB_SPIN(xb_ld(&bar[XB_TOPGEN]) == tg, bar);
            __builtin_amdgcn_fence(__ATOMIC_ACQUIRE, "agent");
            xb_add(&bar[XB_XGEN(b.x)], 1u);
            asm volatile("s_waitcnt vmcnt(0)" ::: "memory");
        } else {
            XB_SPIN(xb_ld(&bar[XB_XGEN(b.x)]) == gen, bar);
            __builtin_amdgcn_fence(__ATOMIC_ACQUIRE, "agent");
            asm volatile("s_waitcnt vmcnt(0)" ::: "memory");
        }
    }
    __syncthreads();
}

enum In { I_X = 0, I_N1, I_G1, I_U1, I_D1, I_MIXN, I_WIN, I_WPOOL, I_PSCALE, I_LRE, I_LIM, I_LOGDT, I_BRE, I_BIM, I_CRE, I_CIM, I_DSKIP, I_WGLU, I_BGLU, I_PON, I_SON, I_WOUT, I_N2, I_G2, I_U2, I_D2, I_FN, N_IN };
struct Args { const float* in[N_IN]; float* out; unsigned char* ws; int ph_lo, ph_hi, li, pad; };
struct Frame {
    LAS unsigned char* lds; volatile LAS unsigned* MISC; unsigned* ctl;
    int tid, lane, wave, vcu, G;
};

#ifndef P0_KFAST
#define P0_KFAST 1
#endif
#define P0_DECODE(item, dim) const int kb = P0_KFAST ? (item) % (dim) : (item) / (dim), nb = P0_KFAST ? (item) / (dim) : (item) % (dim)
#define P0_DIM(K_, N_) (P0_KFAST ? (K_) / 128 : (N_) / 256)
__device__ __forceinline__ void p0_item_load(const float* W, int ld, int item, int nblk, int wave, int lane, f32x4 (&v)[16]) {
    P0_DECODE(item, nblk);
    const float* src = W + (size_t)(128 * kb + 16 * wave) * ld + 256 * nb + 4 * lane;
#pragma unroll
    for (int r = 0; r < 16; ++r) v[r] = __builtin_nontemporal_load((const f32x4*)(src + (size_t)r * ld));
}
typedef const __attribute__((address_space(4))) float* CFP;
__device__ __forceinline__ CFP scalar_gain_ptr(const float* gain, int k0, int wave) { const unsigned long long a = (unsigned long long)(gain + k0 + 16 * wave);
    return (CFP)(((unsigned long long)(unsigned)__builtin_amdgcn_readfirstlane((int)(a >> 32)) << 32) | (unsigned long long)(unsigned)__builtin_amdgcn_readfirstlane((int)(unsigned)a)); }
__device__ __forceinline__ void p0_item_store(const f32x4 (&v)[16], int K, bf16_t* WT, const float* gain, int rs, int ro, int item, int nblk, LAS unsigned* T, int tid, int wave, int lane, int qf = 0) {
    P0_DECODE(item, nblk); const int k0 = 128 * kb, n0 = 256 * nb; const CFP gs = scalar_gain_ptr(gain, k0, wave);
#pragma unroll
    for (int i = 0; i < 8; ++i) { const int kp = 8 * wave + i;
        float ge = 1.f, go = 1.f; if (gain) { ge = gs[2 * i]; go = gs[2 * i + 1]; }
        if (INT8_GU2 == 1 && qf == 2) { ge *= WQ_SCALE; go *= WQ_SCALE; }
#define WQ(x) ((INT8_GU2 == 1 && qf == 2) ? qint8(x) : ((EMU_FP8 && qf == 1) ? q8(x) : (x)))
        if (qf == 4) { u32x4 wb; wb.x = cvt_pk_truebf16(v[2 * i].x * ge, v[2 * i + 1].x * go); wb.y = cvt_pk_truebf16(v[2 * i].y * ge, v[2 * i + 1].y * go); wb.z = cvt_pk_truebf16(v[2 * i].z * ge, v[2 * i + 1].z * go); wb.w = cvt_pk_truebf16(v[2 * i].w * ge, v[2 * i + 1].w * go);
            *(LAS u32x4*)(T + kp * 256 + 4 * (lane ^ ((kp >> 2) & 7))) = wb; continue; }
        u32x4 w; w.x = cvt_pk_bf16(WQ(v[2 * i].x * ge), WQ(v[2 * i + 1].x * go)); w.y = cvt_pk_bf16(WQ(v[2 * i].y * ge), WQ(v[2 * i + 1].y * go)); w.z = cvt_pk_bf16(WQ(v[2 * i].z * ge), WQ(v[2 * i + 1].z * go)); w.w = cvt_pk_bf16(WQ(v[2 * i].w * ge), WQ(v[2 * i + 1].w * go));
#undef WQ
        *(LAS u32x4*)(T + kp * 256 + 4 * (lane ^ ((kp >> 2) & 7))) = w; }
    LDS_WAIT(); __builtin_amdgcn_s_barrier(); asm volatile("" ::: "memory");
    const int q = tid & 15;
#pragma unroll
    for (int j = 0; j < 8; ++j) { const int n = (tid >> 4) + 32 * j; const LAS unsigned* r = T + (4 * q) * 256 + 4 * ((n >> 2) ^ (q & 7)) + (n & 3);
        u32x4 w; w.x = r[0]; w.y = r[256]; w.z = r[512]; w.w = r[768];
        const int ng = n0 + n, drow = (ng >> 7) * rs + (ng & 127) + ro;
        if (rs == 0) *(GAS u32x4*)(WT + ((size_t)((k0 + 8 * q) >> 6) * ro + ng) * 64 + ((k0 + 8 * q) & 63)) = w;
        else *(GAS u32x4*)(WT + (size_t)drow * K + k0 + 8 * q) = w; }
    LDS_WAIT(); __builtin_amdgcn_s_barrier(); asm volatile("" ::: "memory");
}
__device__ __forceinline__ void p0_item_store_fp8(const f32x4 (&v)[16], int K, unsigned char* WT, int item, int nblk, LAS unsigned* T, int tid, int wave, int lane) {
    P0_DECODE(item, nblk); const int k0 = 128 * kb, n0 = 256 * nb;
#pragma unroll
    for (int i = 0; i < 4; ++i) { const int kq = 4 * wave + i;
        u32x4 w; w.x = pk4_fp8(v[4 * i].x * W8_SCALE, v[4 * i + 1].x * W8_SCALE, v[4 * i + 2].x * W8_SCALE, v[4 * i + 3].x * W8_SCALE);
        w.y = pk4_fp8(v[4 * i].y * W8_SCALE, v[4 * i + 1].y * W8_SCALE, v[4 * i + 2].y * W8_SCALE, v[4 * i + 3].y * W8_SCALE);
        w.z = pk4_fp8(v[4 * i].z * W8_SCALE, v[4 * i + 1].z * W8_SCALE, v[4 * i + 2].z * W8_SCALE, v[4 * i + 3].z * W8_SCALE);
        w.w = pk4_fp8(v[4 * i].w * W8_SCALE, v[4 * i + 1].w * W8_SCALE, v[4 * i + 2].w * W8_SCALE, v[4 * i + 3].w * W8_SCALE);
        *(LAS u32x4*)(T + kq * 256 + 4 * (lane ^ ((kq >> 2) & 7))) = w; }
    LDS_WAIT(); __builtin_amdgcn_s_barrier(); asm volatile("" ::: "memory");
    const int q = tid & 7;
#pragma unroll
    for (int j = 0; j < 4; ++j) { const int n = (tid >> 3) + 64 * j; const LAS unsigned* r = T + (4 * q) * 256 + 4 * ((n >> 2) ^ (q & 7)) + (n & 3);
        u32x4 w; w.x = r[0]; w.y = r[256]; w.z = r[512]; w.w = r[768];
        *(GAS u32x4*)(WT + (size_t)(n0 + n) * K + k0 + 16 * q) = w; }
    LDS_WAIT(); __builtin_amdgcn_s_barrier(); asm volatile("" ::: "memory");
}
__device__ __forceinline__ void p0_item_store_i8(const f32x4 (&v)[16], int K, unsigned char* WT, const float* gain, int rs, int ro, int item, int nblk, LAS unsigned* T, int tid, int wave, int lane) {
    P0_DECODE(item, nblk); const int k0 = 128 * kb, n0 = 256 * nb; const CFP gs = scalar_gain_ptr(gain, k0, wave);
#pragma unroll
    for (int i = 0; i < 4; ++i) { const int kq = 4 * wave + i;
        float g0 = WQ_SCALE, g1 = WQ_SCALE, g2 = WQ_SCALE, g3 = WQ_SCALE;
        if (gain) { g0 *= gs[4 * i]; g1 *= gs[4 * i + 1]; g2 *= gs[4 * i + 2]; g3 *= gs[4 * i + 3]; }
        u32x4 w; w.x = pk4_i8(v[4 * i].x * g0, v[4 * i + 1].x * g1, v[4 * i + 2].x * g2, v[4 * i + 3].x * g3);
        w.y = pk4_i8(v[4 * i].y * g0, v[4 * i + 1].y * g1, v[4 * i + 2].y * g2, v[4 * i + 3].y * g3);
        w.z = pk4_i8(v[4 * i].z * g0, v[4 * i + 1].z * g1, v[4 * i + 2].z * g2, v[4 * i + 3].z * g3);
        w.w = pk4_i8(v[4 * i].w * g0, v[4 * i + 1].w * g1, v[4 * i + 2].w * g2, v[4 * i + 3].w * g3);
        *(LAS u32x4*)(T + kq * 256 + 4 * (lane ^ ((kq >> 2) & 7))) = w; }
    LDS_WAIT(); __builtin_amdgcn_s_barrier(); asm volatile("" ::: "memory");
    const int q = tid & 7;
#pragma unroll
    for (int j = 0; j < 4; ++j) { const int n = (tid >> 3) + 64 * j; const LAS unsigned* r = T + (4 * q) * 256 + 4 * ((n >> 2) ^ (q & 7)) + (n & 3);
        u32x4 w; w.x = r[0]; w.y = r[256]; w.z = r[512]; w.w = r[768];
        const int ng = n0 + n, drow = (ng >> 7) * rs + (ng & 127) + ro;
        *(GAS u32x4*)(WT + (size_t)drow * K + k0 + 16 * q) = w; }
    LDS_WAIT(); __builtin_amdgcn_s_barrier(); asm volatile("" ::: "memory");
}
struct TDesc { const float* src; bf16_t* dst; const float* gain; const float* gain2; int K, N, rs, ro, first, pad, ld, pad2; };
constexpr int N_TDESC = 13;

__device__ __forceinline__ void rms_row_to_bf16(const float* xrow, const float* gain, bf16_t* orow, int lane) {
    const GAS f32x4* xr = (const GAS f32x4*)xrow + lane;
    f32x4 v[16]; float s = 0.f;
#pragma unroll
    for (int j = 0; j < 16; ++j) { v[j] = xr[64 * j]; s += (v[j].x * v[j].x + v[j].y * v[j].y) + (v[j].z * v[j].z + v[j].w * v[j].w); }
    const float rstd = 1.0f / sqrtf(wave_sum(s) * (1.f / D) + NORM_EPS);
    const GAS f32x4* gr = (const GAS f32x4*)gain + lane;
    GAS u32x2* o8 = (GAS u32x2*)orow + lane;
#pragma unroll
    for (int j = 0; j < 16; ++j) { const f32x4 g = gr[64 * j]; u32x2 w; w.x = cvt_pk_bf16(v[j].x * rstd * g.x, v[j].y * rstd * g.y); w.y = cvt_pk_bf16(v[j].z * rstd * g.z, v[j].w * rstd * g.w); o8[64 * j] = w; }
}
__device__ __forceinline__ void rms_row_to_i8(const float* xrow, const float* gain, unsigned char* orow, int lane) {
    const GAS f32x4* xr = (const GAS f32x4*)xrow + lane;
    f32x4 v[16]; float s = 0.f;
#pragma unroll
    for (int j = 0; j < 16; ++j) { v[j] = xr[64 * j]; s += (v[j].x * v[j].x + v[j].y * v[j].y) + (v[j].z * v[j].z + v[j].w * v[j].w); }
    const float rstd = AQ1_SCALE / sqrtf(wave_sum(s) * (1.f / D) + NORM_EPS);
    const GAS f32x4* gr = (const GAS f32x4*)gain + lane;
    GAS unsigned* o4 = (GAS unsigned*)orow + lane;
#pragma unroll
    for (int j = 0; j < 16; ++j) { const f32x4 g = gr[64 * j]; o4[64 * j] = pk4_i8(v[j].x * rstd * g.x, v[j].y * rstd * g.y, v[j].z * rstd * g.z, v[j].w * rstd * g.w); }
}
__device__ __forceinline__ void norm_phase_i8(Frame& F, const float* src, const float* gain, unsigned char* dst) {
    const int gw = F.vcu * NWAVES + F.wave, NGW = F.G * NWAVES;
    LAS f32x4* GL = (LAS f32x4*)(F.lds + RING_OFF);
    __syncthreads();
    for (int e = F.tid; e < D / 4; e += NWAVES * 64) GL[e] = ((const f32x4*)gain)[e];
    __syncthreads();
    f32x4 vn[16];
    int m = gw;
    if (m < M) { const GAS f32x4* xr = (const GAS f32x4*)(src + (size_t)m * D) + F.lane;
#pragma unroll
        for (int j = 0; j < 16; ++j) vn[j] = xr[64 * j]; }
#define XN_ROW(m_, more_) do { f32x4 v[16]; \
        _Pragma("unroll") for (int j = 0; j < 16; ++j) v[j] = vn[j]; \
        if (more_) { const GAS f32x4* xr = (const GAS f32x4*)(src + (size_t)((m_) + NGW) * D) + F.lane; \
            _Pragma("unroll") for (int j = 0; j < 16; ++j) vn[j] = xr[64 * j]; } \
        asm volatile("" ::: "memory");        \
        float s = 0.f; \
        _Pragma("unroll") for (int j = 0; j < 16; ++j) s += (v[j].x * v[j].x + v[j].y * v[j].y) + (v[j].z * v[j].z + v[j].w * v[j].w); \
        const float rstd = AQ1_SCALE / sqrtf(wave_sum(s) * (1.f / D) + NORM_EPS); \
        GAS unsigned* o4 = (GAS unsigned*)(dst + (size_t)(m_) * D) + F.lane; \
        _Pragma("unroll") for (int j = 0; j < 16; ++j) { const f32x4 gj = GL[64 * j + F.lane]; o4[64 * j] = pk4_i8(v[j].x * rstd * gj.x, v[j].y * rstd * gj.y, v[j].z * rstd * gj.z, v[j].w * rstd * gj.w); } } while (0)
    constexpr int RPW = M / (256 * NWAVES);
    if (NGW == 256 * NWAVES) {
#pragma unroll
        for (int r = 0; r < RPW; ++r) XN_ROW(gw + r * NGW, r + 1 < RPW);
    } else { for (; m < M; m += NGW) XN_ROW(m, m + NGW < M); }
#undef XN_ROW
}
__device__ __forceinline__ void norm_phase_bf16(Frame& F, const float* src, const float* gain, bf16_t* dst) {
    const int gw = F.vcu * NWAVES + F.wave, NGW = F.G * NWAVES;
    for (int m = gw; m < M; m += NGW) rms_row_to_bf16(src + (size_t)m * D, gain, dst + (size_t)m * D, F.lane);
}
__device__ __forceinline__ void norm_phase_final(Frame& F, const bf16_t* h, const float* ps, const float* gain, float* out) {
    const int gw = F.vcu * NWAVES + F.wave, NGW = F.G * NWAVES;
    int tz = threadIdx.x; asm volatile("" : "+v"(tz)); const int ln = tz & 63;
    LAS f32x4* GL = (LAS f32x4*)(F.lds + RING_OFF);
    __syncthreads();
    for (int e = tz; e < D / 4; e += NWAVES * 64) GL[e] = ((const f32x4*)gain)[e];
    __syncthreads();
    u32x4 vn[8]; float pvn = 0.f;
    if (gw < M) { const GAS u32x4* hr = (const GAS u32x4*)(h + (size_t)gw * D) + ln;
#pragma unroll
        for (int j = 0; j < 8; ++j) vn[j] = hr[64 * j];
        pvn = (ln < 16) ? ps[(size_t)gw * 16 + ln] : 0.f; }
#define FN_ROW(m_, more_) do { \
        u32x4 v[8]; const float pv = pvn; \
        _Pragma("unroll") for (int j = 0; j < 8; ++j) v[j] = vn[j]; \
        if (more_) { const GAS u32x4* hr = (const GAS u32x4*)(h + (size_t)((m_) + NGW) * D) + ln; \
            _Pragma("unroll") for (int j = 0; j < 8; ++j) vn[j] = hr[64 * j]; \
            pvn = (ln < 16) ? ps[(size_t)((m_) + NGW) * 16 + ln] : 0.f; } \
        asm volatile("" ::: "memory");        \
        const float rstd = 1.0f / sqrtf(wave_sum(pv) * (1.f / D) + NORM_EPS); \
        GAS f32x4* o = (GAS f32x4*)(out + (size_t)(m_) * D) + 2 * ln; \
        _Pragma("unroll") for (int j = 0; j < 8; ++j) { const f32x4 ga = GL[(64 * j + ln) * 2], gb = GL[(64 * j + ln) * 2 + 1]; \
            o[128 * j] = (f32x4){bf_lo(v[j].x) * rstd * ga.x, bf_hi(v[j].x) * rstd * ga.y, bf_lo(v[j].y) * rstd * ga.z, bf_hi(v[j].y) * rstd * ga.w}; \
            o[128 * j + 1] = (f32x4){bf_lo(v[j].z) * rstd * gb.x, bf_hi(v[j].z) * rstd * gb.y, bf_lo(v[j].w) * rstd * gb.z, bf_hi(v[j].w) * rstd * gb.w}; } } while (0)
    constexpr int RPW = M / (256 * NWAVES);
    if (NGW == 256 * NWAVES) {
#pragma unroll 1
        for (int r0 = 0; r0 < RPW; r0 += 4) {
#pragma unroll
            for (int rr = 0; rr < 4; ++rr) FN_ROW(gw + (r0 + rr) * NGW, r0 + rr + 1 < RPW); }
    } else { for (int m = gw; m < M; m += NGW) FN_ROW(m, m + NGW < M); }
#undef FN_ROW
}
__device__ __forceinline__ void norm_phase_merged(Frame& F, const bf16_t* yp, const bf16_t* ys, const float* gp, const float* gs, bf16_t* dst) {
    const int gw = F.vcu * NWAVES + F.wave, NGW = F.G * NWAVES;
    for (int m = gw; m < M; m += NGW) {
#pragma unroll
        for (int half = 0; half < 2; ++half) {
            const GAS u32x4* src = (const GAS u32x4*)((half ? ys : yp) + (size_t)m * PW) + F.lane; const float* gn = half ? gs : gp;
            u32x4 v[4]; float s = 0.f;
#pragma unroll
            for (int j = 0; j < 4; ++j) { v[j] = src[64 * j];
                const float a0 = bf_lo(v[j].x), a1 = bf_hi(v[j].x), a2 = bf_lo(v[j].y), a3 = bf_hi(v[j].y), a4 = bf_lo(v[j].z), a5 = bf_hi(v[j].z), a6 = bf_lo(v[j].w), a7 = bf_hi(v[j].w);
                s += (a0 * a0 + a1 * a1) + (a2 * a2 + a3 * a3) + (a4 * a4 + a5 * a5) + (a6 * a6 + a7 * a7); }
            const float rstd = 1.0f / sqrtf(wave_sum(s) * (1.f / PW) + NORM_EPS);
            GAS u32x4* o = (GAS u32x4*)(dst + (size_t)m * D + half * PW) + F.lane;
#pragma unroll
            for (int j = 0; j < 4; ++j) { const GAS f32x4* g4 = (const GAS f32x4*)(gn + (64 * j + F.lane) * 8); const f32x4 ga = g4[0], gb = g4[1];
                u32x4 w; w.x = cvt_pk_bf16(bf_lo(v[j].x) * rstd * ga.x, bf_hi(v[j].x) * rstd * ga.y); w.y = cvt_pk_bf16(bf_lo(v[j].y) * rstd * ga.z, bf_hi(v[j].y) * rstd * ga.w);
                w.z = cvt_pk_bf16(bf_lo(v[j].z) * rstd * gb.x, bf_hi(v[j].z) * rstd * gb.y); w.w = cvt_pk_bf16(bf_lo(v[j].w) * rstd * gb.z, bf_hi(v[j].w) * rstd * gb.w);
                o[64 * j] = w; }
        }
    }
}
__device__ __forceinline__ void unpack8(const u32x4 v, float (&f)[8]) { f[0] = bf_lo(v.x); f[1] = bf_hi(v.x); f[2] = bf_lo(v.y); f[3] = bf_hi(v.y); f[4] = bf_lo(v.z); f[5] = bf_hi(v.z); f[6] = bf_lo(v.w); f[7] = bf_hi(v.w); }
__device__ __forceinline__ void pool_diff_phase(Frame& F, const bf16_t* z, bf16_t* d, int first_wg, int n_wg) {
    const int gw = (F.vcu - first_wg) * NWAVES + F.wave, NGW = n_wg * NWAVES;
    if (F.vcu < first_wg || F.vcu >= first_wg + n_wg) return;
    for (int it = gw; it < (M / 32) * 4; it += NGW) {
        const int g = it & 3, run = it >> 2, tok0 = run * 32, t0 = tok0 & (SEQ - 1), w = 2 << g;
        const GAS u32x4* zp = (const GAS u32x4*)(z + (size_t)tok0 * PW + g * PGW) + F.lane;
        GAS u32x4* dp = (GAS u32x4*)(d + (size_t)tok0 * PW + g * PGW) + F.lane;
        float sum[8];
#pragma unroll
        for (int e = 0; e < 8; ++e) sum[e] = 0.f;
        for (int s = 1; s < w; ++s) { if (t0 - s >= 0) { float f[8]; unpack8(zp[-(long)s * (PW / 8)], f);
#pragma unroll
            for (int e = 0; e < 8; ++e) sum[e] += f[e]; } }
        for (int r = 0; r < 32; ++r) {
            const int t = t0 + r; float f[8]; unpack8(zp[(long)r * (PW / 8)], f);
#pragma unroll
            for (int e = 0; e < 8; ++e) sum[e] += f[e];
            const int cnt = (t + 1 < w) ? (t + 1) : w; const float inv = 1.0f / (float)cnt;
            u32x4 o; o.x = cvt_pk_bf16(sum[0] * inv - f[0], sum[1] * inv - f[1]); o.y = cvt_pk_bf16(sum[2] * inv - f[2], sum[3] * inv - f[3]);
            o.z = cvt_pk_bf16(sum[4] * inv - f[4], sum[5] * inv - f[5]); o.w = cvt_pk_bf16(sum[6] * inv - f[6], sum[7] * inv - f[7]);
            dp[(long)r * (PW / 8)] = o;
            if (t - w + 1 >= 0) { float q[8]; unpack8(zp[(long)(r - w + 1) * (PW / 8)], q);
#pragma unroll
                for (int e = 0; e < 8; ++e) sum[e] -= q[e]; }
        }
    }
}

__device__ __forceinline__ void pool_out_phase(Frame& F, const bf16_t* z, bf16_t* ym, const float* scale, float* ps2, int first_wg, int n_wg) {
    const int gw = (F.vcu - first_wg) * NWAVES + F.wave, NGW = n_wg * NWAVES;
    if (F.vcu < first_wg || F.vcu >= first_wg + n_wg) return;
    for (int it = gw; it < (M / 32) * 4; it += NGW) {
        const int g = it & 3, run = it >> 2, tok0 = run * 32, t0 = tok0 & (SEQ - 1), w = 2 << g;
        const GAS u32x4* zp = (const GAS u32x4*)(z + (size_t)tok0 * PW + g * PGW) + F.lane;
        GAS u32x4* yp = (GAS u32x4*)(ym + (size_t)tok0 * D + g * PGW) + F.lane;
        const GAS f32x4* sp = (const GAS f32x4*)(scale + g * PGW + F.lane * 8); const f32x4 sa = sp[0], sb = sp[1];
        const float sc[8] = {sa.x, sa.y, sa.z, sa.w, sb.x, sb.y, sb.z, sb.w};
        float sum[8];
#pragma unroll
        for (int e = 0; e < 8; ++e) sum[e] = 0.f;
        for (int s = 1; s < w; ++s) { if (t0 - s >= 0) { float f[8]; unpack8(zp[-(long)s * (PW / 8)], f);
#pragma unroll
            for (int e = 0; e < 8; ++e) sum[e] += f[e]; } }
        for (int r = 0; r < 32; ++r) {
            const int t = t0 + r; float f[8]; unpack8(zp[(long)r * (PW / 8)], f);
#pragma unroll
            for (int e = 0; e < 8; ++e) sum[e] += f[e];
            const int cnt = (t + 1 < w) ? (t + 1) : w; const float inv = 1.0f / (float)cnt;
            float o[8]; float ss = 0.f;
#pragma unroll
            for (int e = 0; e < 8; ++e) { o[e] = (sum[e] * inv - f[e]) * sc[e]; ss += o[e] * o[e]; }
            u32x4 ov; ov.x = pk16m(o[0], o[1]); ov.y = pk16m(o[2], o[3]); ov.z = pk16m(o[4], o[5]); ov.w = pk16m(o[6], o[7]);
            yp[(long)r * (D / 8)] = ov;
            ss = wave_sum(ss);
            if (F.lane == 0) { ps2[(size_t)(tok0 + r) * 16 + g] = ss; ps2[(size_t)(tok0 + r) * 16 + 4 + g] = 0.f; }
            if (t - w + 1 >= 0) { float q[8]; unpack8(zp[(long)(r - w + 1) * (PW / 8)], q);
#pragma unroll
                for (int e = 0; e < 8; ++e) sum[e] -= q[e]; }
        }
    }
}
constexpr int PST = 65;
__device__ __forceinline__ void s5_tables_group(Frame& F, const Args& a, int g, int part) {
    LAS float* Bre = (LAS float*)(F.lds + RING_OFF);
    LAS float* Bim = Bre + 64 * 16;
    LAS float* Pre = Bim + 64 * 16;
    LAS float* Pim = Pre + 65 * PST;
    LAS float* Cre = Pim + 65 * PST;
    LAS float* Cim = Cre + 16 * PST;
    const int t = F.tid;
    const float dt = expf(a.in[I_LOGDT][g]);
    if (t < 64) {
        const int p = t;
        const float lr = a.in[I_LRE][g * SP + p], li = a.in[I_LIM][g * SP + p];
        const float mag = expf(lr * dt), ang = li * dt;
        const float br = mag * cosf(ang), bi = mag * sinf(ang);
        const float nr = br - 1.0f, ni = bi, den = 1.0f / (lr * lr + li * li);
        const float cr = (nr * lr + ni * li) * den, ci = (ni * lr - nr * li) * den;
        for (int h = 0; h < SH; ++h) { const float xr = a.in[I_BRE][(g * SP + p) * SH + h], xi = a.in[I_BIM][(g * SP + p) * SH + h]; Bre[p * 16 + h] = cr * xr - ci * xi; Bim[p * 16 + h] = cr * xi + ci * xr; }
        float pr = 1.0f, pi = 0.0f;
        for (int k = 0; k <= 64; ++k) { Pre[k * PST + p] = pr; Pim[k * PST + p] = pi; const float qr = pr * br - pi * bi, qi = pr * bi + pi * br; pr = qr; pi = qi; }
        if (part == 0) { float* lp = (float*)(a.ws + WS_LP) + ((size_t)g * SP + p) * 2; lp[0] = Pre[64 * PST + p]; lp[1] = Pim[64 * PST + p]; }
    }
    for (int e = t; e < SH * SP; e += NWAVES * 64) { Cre[(e >> 6) * PST + (e & 63)] = a.in[I_CRE][(size_t)g * SH * SP + e]; Cim[(e >> 6) * PST + (e & 63)] = a.in[I_CIM][(size_t)g * SH * SP + e]; }
    __syncthreads();
    if (part == 0) {
        bf16_t* kl = (bf16_t*)(a.ws + WS_KL) + (size_t)g * 32768;
        for (int ci = t; ci < 64 * 16; ci += NWAVES * 64) {
            const int lag = ci >> 4, hp = ci & 15;
            float acc[16];
#pragma unroll
            for (int h = 0; h < 16; ++h) acc[h] = 0.f;
#pragma unroll 2
            for (int p = 0; p < 64; ++p) {
                const float c1 = Cre[hp * PST + p], c2 = Cim[hp * PST + p], p1 = Pre[lag * PST + p], p2 = Pim[lag * PST + p];
                const float ar = c1 * p1 - c2 * p2, ai = c1 * p2 + c2 * p1;
#pragma unroll
                for (int h4 = 0; h4 < 4; ++h4) { const f32x4 b1 = *(const LAS f32x4*)(Bre + p * 16 + 4 * h4), b2 = *(const LAS f32x4*)(Bim + p * 16 + 4 * h4);
                    acc[4 * h4 + 0] += ar * b1.x - ai * b2.x; acc[4 * h4 + 1] += ar * b1.y - ai * b2.y; acc[4 * h4 + 2] += ar * b1.z - ai * b2.z; acc[4 * h4 + 3] += ar * b1.w - ai * b2.w; }
            }
            if (lag == 0) {
                const float dsk = a.in[I_DSKIP][g * SH + hp];
#pragma unroll
                for (int h = 0; h < 16; ++h) acc[h] += (h == hp) ? dsk : 0.f;
            }
            u32x4 w0, w1; w0.x = pk2(acc[0], acc[1]); w0.y = pk2(acc[2], acc[3]); w0.z = pk2(acc[4], acc[5]); w0.w = pk2(acc[6], acc[7]);
            w1.x = pk2(acc[8], acc[9]); w1.y = pk2(acc[10], acc[11]); w1.z = pk2(acc[12], acc[13]); w1.w = pk2(acc[14], acc[15]);
            GAS u32x4* o = (GAS u32x4*)(kl + (lag + 63) * 256 + hp * 16); o[0] = w0; o[1] = w1;
        }
        const u32x4 zz = {0u, 0u, 0u, 0u};
        for (int e = t; e < 63 * 32; e += NWAVES * 64) ((GAS u32x4*)kl)[e] = zz;
        for (int e = t; e < 32; e += NWAVES * 64) ((GAS u32x4*)(kl + 127 * 256))[e] = zz;
    }
    if (part == 1) {
        bf16_t* wcp = (bf16_t*)(a.ws + WS_WC) + (size_t)g * 1024 * 128;
        for (int e8 = t; e8 < 1024 * 16; e8 += NWAVES * 64) { const int q0 = (e8 & 15) * 8, n = e8 >> 4, j = n >> 4, hp = n & 15, p0 = q0 & 63; const bool im = q0 >= 64;
            float v[8];
#pragma unroll
            for (int x = 0; x < 8; ++x) { const float c1 = Cre[hp * PST + p0 + x], c2 = Cim[hp * PST + p0 + x], p1 = Pre[(j + 1) * PST + p0 + x], p2 = Pim[(j + 1) * PST + p0 + x];
                v[x] = im ? -(c1 * p2 + c2 * p1) : (c1 * p1 - c2 * p2); }
            u32x4 w; w.x = pk2(v[0], v[1]); w.y = pk2(v[2], v[3]); w.z = pk2(v[4], v[5]); w.w = pk2(v[6], v[7]);
            ((GAS u32x4*)wcp)[e8] = w; }
    }
    if (part == 1) {
        bf16_t* wsp = (bf16_t*)(a.ws + WS_WS) + (size_t)g * 128 * 1024;
        for (int e8 = t; e8 < 128 * 128; e8 += NWAVES * 64) { const int k0 = (e8 & 127) * 8, q = e8 >> 7, i = k0 >> 4, h0 = k0 & 15, p = q & 63; const bool im = q >= 64;
            const float p1 = Pre[(63 - i) * PST + p], p2 = Pim[(63 - i) * PST + p];
            float v[8];
#pragma unroll
            for (int x = 0; x < 8; ++x) { const float b1 = Bre[p * 16 + h0 + x], b2 = Bim[p * 16 + h0 + x]; v[x] = im ? (p1 * b2 + p2 * b1) : (p1 * b1 - p2 * b2); }
            u32x4 w; w.x = pk2(v[0], v[1]); w.y = pk2(v[2], v[3]); w.z = pk2(v[4], v[5]); w.w = pk2(v[6], v[7]);
            ((GAS u32x4*)wsp)[e8] = w; }
    }
    __syncthreads();
}

typedef const __attribute__((address_space(4))) Args* KArgsT;
__device__ __forceinline__ void p0_prologue(Frame& F) {
    KArgsT ap0 = (KArgsT)__builtin_amdgcn_kernarg_segment_ptr(); asm volatile("" : "+s"(ap0)); Args a;
#pragma unroll
    for (int i = 0; i < N_IN; ++i) a.in[i] = ap0->in[i];
    a.out = ap0->out; a.ws = ap0->ws; a.ph_lo = 0; a.ph_hi = 0; a.li = 0; a.pad = 0;
#ifndef PRO_REP
#define PRO_REP 0
#endif
    for (int rp = 0; rp <= (PRO_REP & 1); ++rp)
    for (int w = F.vcu; w < 2 * SG; w += F.G) s5_tables_group(F, a, w & (SG - 1), w >> 7);
    __syncthreads();
    LAS TDesc* td = (LAS TDesc*)(F.lds + RING_OFF + RING_BYTES - 1024);
    if (F.tid == 0) {
        int first = 0, k = 0;
#define TD(SRC, DST, K_, N_, RS, RO, GAIN) do { td[k].src = (SRC); td[k].dst = (bf16_t*)(DST); td[k].gain = (GAIN); td[k].gain2 = nullptr; td[k].K = (K_); td[k].N = (N_); td[k].ld = (N_); td[k].pad2 = 0; td[k].rs = (RS); td[k].ro = (RO); td[k].first = first; td[k].pad = (k == 12) ? 1 : ((k == 10 || k == 11) ? 2 : ((k == 0 || k == 1) ? 3 : (((k == 2 && F16 && DOWN1_BF16) || ((k == 3 || k == 9) && F16 && MIX_BF16)) ? 4 : 0))); first += ((K_) / 128) * ((N_) / 256); ++k; } while (0)
        TD(a.in[I_G1], a.ws + WS_WGU1, D, FF, 256, 0, nullptr);
        TD(a.in[I_U1], a.ws + WS_WGU1, D, FF, 256, 128, nullptr);
        if (WD_TILED) TD(a.in[I_D1], a.ws + WS_WD1, FF, D, 0, D, nullptr); else TD(a.in[I_D1], a.ws + WS_WD1, FF, D, 128, 0, nullptr);
        if (POOL_PREMUL) { TD(a.in[I_WIN] + PW, a.ws + WS_WIN, D, SW, 128, PW, a.in[I_MIXN]); td[k - 1].ld = D; }
        else TD(a.in[I_WIN], a.ws + WS_WIN, D, D, 128, 0, a.in[I_MIXN]);
        TD(a.in[I_WPOOL] + 0 * PGW * PGW, a.ws + WS_WPOOL + 0 * PGW * PGW * 2, PGW, PGW, 128, 0, nullptr);
        TD(a.in[I_WPOOL] + 1 * PGW * PGW, a.ws + WS_WPOOL + 1 * PGW * PGW * 2, PGW, PGW, 128, 0, nullptr);
        TD(a.in[I_WPOOL] + 2 * PGW * PGW, a.ws + WS_WPOOL + 2 * PGW * PGW * 2, PGW, PGW, 128, 0, nullptr);
        TD(a.in[I_WPOOL] + 3 * PGW * PGW, a.ws + WS_WPOOL + 3 * PGW * PGW * 2, PGW, PGW, 128, 0, nullptr);
        TD(a.in[I_WGLU], a.ws + WS_WGLU, SW, SW, 128, 0, nullptr);
        TD(a.in[I_WOUT], a.ws + WS_WOUT, D, D, 128, 0, a.in[I_PON]); td[k - 1].gain2 = a.in[I_SON];
        TD(a.in[I_G2], a.ws + WS_WGU2, D, FF, 256, 0, a.in[I_N2]);
        TD(a.in[I_U2], a.ws + WS_WGU2, D, FF, 256, 128, a.in[I_N2]);
        if (WD_TILED && !FP8_DOWN2) TD(a.in[I_D2], a.ws + WS_WD2, FF, D, 0, D, nullptr); else TD(a.in[I_D2], a.ws + WS_WD2, FF, D, 128, 0, nullptr);
#undef TD
        ((LAS int*)(td + N_TDESC))[0] = first;
    }
    __syncthreads();
    const int nitems = ((LAS int*)(td + N_TDESC))[0];
    LAS unsigned* T = (LAS unsigned*)(F.lds + RING_OFF);
    for (int rp = 0; rp <= ((PRO_REP >> 1) & 1); ++rp) {
    f32x4 vn[16];
    int it = F.vcu;
#define TD_FIND(IT, KK) do { KK = 0; _Pragma("unroll") for (int q_ = 1; q_ < N_TDESC; ++q_) KK += ((IT) >= td[q_].first) ? 1 : 0; } while (0)
    if (it < nitems) { int k; TD_FIND(it, k); p0_item_load(td[k].src, td[k].ld, it - td[k].first, P0_DIM(td[k].K, td[k].N), F.wave, F.lane, vn); }
    for (; it < nitems; it += F.G) {
        f32x4 vc[16];
#pragma unroll
        for (int r = 0; r < 16; ++r) vc[r] = vn[r];
        const int nx = it + F.G;
        if (nx < nitems) { int k; TD_FIND(nx, k); p0_item_load(td[k].src, td[k].ld, nx - td[k].first, P0_DIM(td[k].K, td[k].N), F.wave, F.lane, vn); }
        int k; TD_FIND(it, k);
        if ((INT8_GU2 == 2 && td[k].pad == 2) || (INT8_GU1 && td[k].pad == 3)) p0_item_store_i8(vc, td[k].K, (unsigned char*)td[k].dst, td[k].gain, td[k].rs, td[k].ro, it - td[k].first, P0_DIM(td[k].K, td[k].N), T, F.tid, F.wave, F.lane);
        else if (FP8_DOWN2 && td[k].pad == 1) p0_item_store_fp8(vc, td[k].K, (unsigned char*)td[k].dst, it - td[k].first, P0_DIM(td[k].K, td[k].N), T, F.tid, F.wave, F.lane);
        else { const int itl = it - td[k].first, nblk = P0_DIM(td[k].K, td[k].N); const float* gn = td[k].gain; if (td[k].gain2 && 128 * (P0_KFAST ? itl % nblk : itl / nblk) >= td[k].K / 2) gn = td[k].gain2 - td[k].K / 2;
            p0_item_store(vc, td[k].K, td[k].dst, gn, td[k].rs, td[k].ro, itl, nblk, T, F.tid, F.wave, F.lane, td[k].pad); }
    }
    }
#undef TD_FIND
    for (int rp = 0; rp <= ((PRO_REP >> 2) & 1); ++rp)
    if (POOL_PREMUL) {
        const int gt = F.vcu * (NWAVES * 64) + F.tid, NT = F.G * NWAVES * 64; const float* wi = a.in[I_WIN]; bf16_t* wp = (bf16_t*)(a.ws + WS_WINP);
        for (int e = gt; e < D * (PW / 8); e += NT) { const int k = e >> 8, c8 = e & 255; const f32x4 v0 = __builtin_nontemporal_load((const f32x4*)(wi + (size_t)k * D + c8 * 8)), v1 = __builtin_nontemporal_load((const f32x4*)(wi + (size_t)k * D + c8 * 8 + 4));
            u32x4 w; w.x = cvt_pk_bf16(v0.x, v0.y); w.y = cvt_pk_bf16(v0.z, v0.w); w.z = cvt_pk_bf16(v1.x, v1.y); w.w = cvt_pk_bf16(v1.z, v1.w); *(GAS u32x4*)(wp + (size_t)k * PW + c8 * 8) = w; } }
    if (INT8_GU1) norm_phase_i8(F, a.in[I_X], a.in[I_N1], a.ws + WS_XN); else
    norm_phase_bf16(F, a.in[I_X], a.in[I_N1], (bf16_t*)(a.ws + WS_XN));
}

constexpr int N_PHASES = 14;
__global__ void __launch_bounds__(NWAVES * 64, 2) fwd_kernel(Args args) {
    extern __shared__ __attribute__((aligned(16))) unsigned char lds[];
    Frame F;
    F.lds = (LAS unsigned char*)lds;
    F.MISC = (volatile LAS unsigned*)(F.lds + MISC_OFF);
    F.tid = threadIdx.x; F.lane = F.tid & 63; F.wave = __builtin_amdgcn_readfirstlane(F.tid >> 6);
    F.G = gridDim.x; { const int bx = blockIdx.x; F.vcu = (F.G % 8 == 0) ? (bx % 8) * (F.G / 8) + bx / 8 : bx; }
    typedef const __attribute__((address_space(4))) Args* KArgs;
#define FRESH_ARGS() KArgs ap = (KArgs)__builtin_amdgcn_kernarg_segment_ptr(); asm volatile("" : "+s"(ap)); unsigned char* const ws = ap->ws; (void)ws
    int lo, hi;
    { FRESH_ARGS(); F.ctl = (unsigned*)(ws + WS_CTL); lo = ap->ph_lo; hi = ap->ph_hi; }
    for (int u = F.tid; u < (LDS_BYTES - LDSCTL_OFF) / 4; u += NWAVES * 64) ((LAS unsigned*)(F.lds + LDSCTL_OFF))[u] = 0u;
    __syncthreads();
    XcdBarrier bar; bar.bar = F.ctl + CW_BAR; bar.x = 0; bar.st = nullptr;
    if (MK_N_LAUNCHES == 1) bar = xcd_barrier_post(F.ctl + CW_BAR, F.MISC + 8);
#define GRID_BAR() do { if (MK_N_LAUNCHES == 1) xcd_barrier(bar); } while (0)
#ifndef PH_MASK
#define PH_MASK 0x3fff
#endif
#define IN(k) (((PH_MASK >> (k)) & 1) && lo <= (k) && (k) < hi)
#define BOTH(k) (IN(k) && IN((k) + 1))
#define XN ((bf16_t*)(ws + WS_XN))
#define HB ((bf16_t*)(ws + WS_H))
#define ZPOOL ((bf16_t*)(ws + WS_ZPOOL))
#define AS5 ((bf16_t*)(ws + WS_AS5))
#define DPOOL ((bf16_t*)(ws + WS_DPOOL))
#define YB ((bf16_t*)(ws + WS_Y))
#define YPOOL ((bf16_t*)(ws + WS_YPOOL))
#define YSSM ((bf16_t*)(ws + WS_YSSM))
#define X1 ((bf16_t*)(ws + WS_X1))
#define X2 ((bf16_t*)(ws + WS_X2))
#define PS ((float*)(ws + WS_PS))
    const int bx = (int)blockIdx.x;
#ifndef WGM_DOWN
#define WGM_DOWN 2
#endif
#ifndef WGM_GU
#define WGM_GU 8
#endif
#ifndef REP_MASK
#define REP_MASK 0
#endif
#define PHASE(k) if (IN(k)) for (int rep_ = 0; rep_ <= ((REP_MASK >> (k)) & 1); ++rep_)
#define SEAM(k) if (BOTH(k)) GRID_BAR()
    PHASE(0) { FRESH_ARGS(); p0_prologue(F); } SEAM(0);
    PHASE(1) { FRESH_ARGS(); pg8::PlainGemm P;
        if (INT8_GU1) P.init(XN, ws + WS_WGU1, M, 2 * FF, D / 2, D / 2, D / 2, F.G, bx, WGM_GU); else P.init(XN, ws + WS_WGU1, M, 2 * FF, D, D, D, F.G, bx);
        pg8::EpiSwiGLU<false, false, INT8_GU1 != 0, (F16 && DOWN1_BF16)> E{HB, nullptr, -1, INT8_GU1 ? 1.0f / (AQ1_SCALE * WQ_SCALE) : 1.0f};
        pg8::gemm_phase<pg8::EpiSwiGLU<false, false, INT8_GU1 != 0, (F16 && DOWN1_BF16)>, pg8::PlainGemm, PG8_ALIGN, PG8_SP2, INT8_GU1 ? 2 : 0>(F.lds + RING_OFF, P, E);
        if (POOL_PREMUL) {
            __syncthreads();
            const int half = F.G / 2; const bool tailidle = (F.G == 256);
            pg8::CombGemm C; C.init(ws + WS_WPOOL, ws + WS_WINP, tailidle ? half : F.G, tailidle ? (bx >= half ? bx - half : -1) : bx); pg8::EpiComb EC{(bf16_t*)(ws + WS_WIN), ap->in[I_MIXN]};
            pg8::gemm_phase<pg8::EpiComb, pg8::CombGemm, PG8_ALIGN, PG8_SP2>(F.lds + RING_OFF, C, EC); } } SEAM(1);
    PHASE(2) { FRESH_ARGS(); pg8::PlainGemm P; if (H_TILED && WD_TILED) P.init_tiledAB(HB, ws + WS_WD1, M, D, FF, F.G, bx, WGM_DOWN); else if (H_TILED) P.init_tiledA(HB, ws + WS_WD1, M, D, FF, FF, F.G, bx, WGM_DOWN); else P.init(HB, ws + WS_WD1, M, D, FF, FF, FF, F.G, bx, WGM_DOWN); if (DOWN_REVK) P.reverse_k(); pg8::EpiResNorm<true, 0, false, true> E{ap->in[I_X], 0.5f, X1, PS, nullptr};
        pg8::gemm_phase<pg8::EpiResNorm<true, 0, false, true>, pg8::PlainGemm, PG8_ALIGN, PG8_SP2, (F16 && DOWN1_BF16) ? 3 : 0>(F.lds + RING_OFF, P, E); } SEAM(2);
    PHASE(4) { FRESH_ARGS(); pg8::PlainGemm P; P.init(X1, ws + WS_WIN, M, D, D, D, D, F.G, bx); pg8::Unit u0; const int pm0 = P.next(0, u0) ? u0.pm : -1; pg8::rstd_table(PS, pm0, F.lds, F.tid); pg8::EpiZ E{ZPOOL, AS5, PS, pm0};
        pg8::gemm_phase<pg8::EpiZ, pg8::PlainGemm, PG8_ALIGN, PG8_SP2, (F16 && MIX_BF16) ? 3 : 0>(F.lds + RING_OFF, P, E); } SEAM(4);
    PHASE(5) { FRESH_ARGS();
        const bool split = (F.G == 2 * SG);
        if (POOL_PREMUL) { if (split) pool_out_phase(F, ZPOOL, XN, ap->in[I_PSCALE], (float*)(ws + WS_PS2), SG, F.G - SG); else pool_out_phase(F, ZPOOL, XN, ap->in[I_PSCALE], (float*)(ws + WS_PS2), 0, F.G); }
        else if (split) pool_diff_phase(F, ZPOOL, DPOOL, SG, F.G - SG); else pool_diff_phase(F, ZPOOL, DPOOL, 0, F.G);
        VM_WAIT(); __syncthreads();
        pg8::S5CarryGemm P; P.init(AS5, ws + WS_WS, split ? SG : F.G, split ? (F.vcu < SG ? F.vcu : SG) : bx); pg8::EpiCarry E{AS5, (const float*)(ws + WS_LP)};
        pg8::gemm_phase<pg8::EpiCarry, pg8::S5CarryGemm, false, PG8_SP2>(F.lds + RING_OFF, P, E); __syncthreads(); } SEAM(5);
    PHASE(6) { FRESH_ARGS(); if (!POOL_PREMUL) { pg8::PoolGemm P; P.init(DPOOL, ws + WS_WPOOL, F.G, bx); pg8::EpiPool E{XN, ap->in[I_PSCALE], (float*)(ws + WS_PS2)};
          pg8::gemm_phase<pg8::EpiPool, pg8::PoolGemm, PG8_ALIGN, PG8_SP2>(F.lds + RING_OFF, P, E); }
        { pg8::S5OutGemm P; P.init(AS5, ws + WS_KL, ws + WS_WC, F.G, bx); pg8::EpiS5Y E{YB};
          pg8::gemm_phase<pg8::EpiS5Y, pg8::S5OutGemm, PG8_ALIGN, PG8_SP2>(F.lds + RING_OFF, P, E); } } SEAM(6);
    PHASE(7) { FRESH_ARGS(); pg8::PlainGemm P; P.init(YB, ws + WS_WGLU, M, SW, SW, SW, SW, F.G, bx); pg8::EpiGLU E{YB, XN, ap->in[I_BGLU], (float*)(ws + WS_PS2)};
        pg8::gemm_phase<pg8::EpiGLU, pg8::PlainGemm, PG8_ALIGN, PG8_SP2>(F.lds + RING_OFF, P, E); } SEAM(7);
    PHASE(9) { FRESH_ARGS(); pg8::PlainGemm P; P.init(XN, ws + WS_WOUT, M, D, D, D, D, F.G, bx); P.tmid = PW / pg8::BK;
        pg8::Unit u0; const int pm0 = P.next(0, u0) ? u0.pm : -1; pg8::rstd2_table((const float*)(ws + WS_PS2), pm0, F.lds, F.tid);
        pg8::EpiResNorm<false, INT8_GU2, true, false, true> E{X1, 1.0f, X2, PS, ws + WS_X2Q};
        pg8::gemm_phase<pg8::EpiResNorm<false, INT8_GU2, true, false, true>, pg8::PlainGemm, PG8_ALIGN, PG8_SP2, (F16 && MIX_BF16) ? 3 : 0>(F.lds + RING_OFF, P, E); } SEAM(9);
    PHASE(11) { FRESH_ARGS(); pg8::PlainGemm P;
        if (INT8_GU2 == 2) P.init(ws + WS_X2Q, ws + WS_WGU2, M, 2 * FF, D / 2, D / 2, D / 2, F.G, bx, WGM_GU);
        else P.init(INT8_GU2 == 1 ? (bf16_t*)(ws + WS_X2Q) : X2, ws + WS_WGU2, M, 2 * FF, D, D, D, F.G, bx);
        pg8::Unit u0; const int pm0 = P.next(0, u0) ? u0.pm : -1; pg8::rstd_table(PS, pm0, F.lds, F.tid);
        pg8::EpiSwiGLU<true, FP8_DOWN2 != 0, INT8_GU2 == 2> E{HB, PS, pm0, INT8_GU2 ? 1.0f / (AQ_SCALE * WQ_SCALE) : 1.0f};
        pg8::gemm_phase<pg8::EpiSwiGLU<true, FP8_DOWN2 != 0, INT8_GU2 == 2>, pg8::PlainGemm, PG8_ALIGN, PG8_SP2, INT8_GU2 == 2 ? 2 : 0>(F.lds + RING_OFF, P, E); } SEAM(11);
#if FP8_DOWN2
    PHASE(12) { FRESH_ARGS(); pg8::PlainGemm P; P.init_tiledA(HB, ws + WS_WD2, M, D, FF / 2, FF / 2, F.G, bx, WGM_DOWN); pg8::EpiResNorm<false> E{X2, 0.5f / (H8_SCALE * W8_SCALE), X1, PS, nullptr};
        pg8::gemm_phase<pg8::EpiResNorm<false>, pg8::PlainGemm, PG8_ALIGN, PG8_SP2, 1>(F.lds + RING_OFF, P, E); } SEAM(12);
#else
    PHASE(12) { FRESH_ARGS(); pg8::PlainGemm P; if (H_TILED && WD_TILED) P.init_tiledAB(HB, ws + WS_WD2, M, D, FF, F.G, bx, WGM_DOWN); else if (H_TILED) P.init_tiledA(HB, ws + WS_WD2, M, D, FF, FF, F.G, bx, WGM_DOWN); else P.init(HB, ws + WS_WD2, M, D, FF, FF, FF, F.G, bx, WGM_DOWN); if (DOWN_REVK) P.reverse_k(); pg8::EpiResNorm<false> E{X2, 0.5f, X1, PS, nullptr};
        pg8::gemm_phase<pg8::EpiResNorm<false>, pg8::PlainGemm, PG8_ALIGN, PG8_SP2>(F.lds + RING_OFF, P, E); } SEAM(12);
#endif
    PHASE(13) { FRESH_ARGS(); norm_phase_final(F, X1, PS, ap->in[I_FN], ap->out); }
#undef PHASE
#undef SEAM
#undef IN
#undef BOTH
#undef FRESH_ARGS
#undef GRID_BAR
}

extern "C" void kernel_launch(void* const* d_in, const int* in_sizes, int n_in, void* d_out, int out_size, void* d_ws, size_t ws_size, hipStream_t stream) {
    static int grid = 0;
    if (grid == 0) {
        if (n_in != N_IN || in_sizes[0] != M * D || out_size != M * D || ws_size < WS_END) { fprintf(stderr, "kernel_launch: unexpected shapes (n_in %d, in0 %d, out %d, ws %zu)\n", n_in, n_in > 0 ? in_sizes[0] : -1, out_size, ws_size); grid = -1; return; }
        int dev = 0, cus = 0, per_cu = 0;
        if (hipGetDevice(&dev) != hipSuccess || hipDeviceGetAttribute(&cus, hipDeviceAttributeMultiprocessorCount, dev) != hipSuccess) { grid = -1; return; }
        if (hipFuncSetAttribute((const void*)fwd_kernel, hipFuncAttributeMaxDynamicSharedMemorySize, LDS_BYTES) != hipSuccess) { fprintf(stderr, "kernel_launch: hipFuncSetAttribute failed\n"); grid = -1; return; }
        if (hipOccupancyMaxActiveBlocksPerMultiprocessor(&per_cu, (const void*)fwd_kernel, NWAVES * 64, LDS_BYTES) != hipSuccess || per_cu < 1) fprintf(stderr, "kernel_launch: occupancy query says %d\n", per_cu);
        (void)hipGetLastError();
        grid = cus;
    }
    if (grid < 0) return;
    if (hipMemsetAsync((char*)d_ws + WS_CTL, 0, CTL_ZERO_BYTES, stream) != hipSuccess) return;
    Args a{};
    for (int i = 0; i < N_IN; ++i) a.in[i] = (const float*)d_in[i];
    a.out = (float*)d_out; a.ws = (unsigned char*)d_ws; a.pad = 0;
    if (MK_N_LAUNCHES == 1) { a.ph_lo = 0; a.ph_hi = N_PHASES; a.li = 0; hipLaunchKernelGGL(fwd_kernel, dim3(grid), dim3(NWAVES * 64), LDS_BYTES, stream, a); }
    else for (int p = 0; p < N_PHASES; ++p) { a.ph_lo = p; a.ph_hi = p + 1; a.li = p; hipLaunchKernelGGL(fwd_kernel, dim3(grid), dim3(NWAVES * 64), LDS_BYTES, stream, a); }
}
```
